# Optimizing an MI355X kernel written in HIP

```python
import math
import jax, jax.numpy as jnp
from jax import lax
import numpy as np

D_MODEL = 1024
BATCH = 8
SEQ = 2048
DEPTH = 1
DEC_BATCH = 128
DEC_SEQ = 4
PAST_LEN = 16384
PAGE_SIZE = 128

HG_WIDTH = D_MODEL // 2
HG_DK = 128
HG_DV = 128
HG_HEADS = HG_WIDTH // HG_DK
HG_CHUNK = 64
CM_WIDTH = D_MODEL - HG_WIDTH
CM_GROUPS = 4
CM_GROUP_DIM = CM_WIDTH // CM_GROUPS
CM_CHUNK = 128
IN_WIDTH = 4 * HG_WIDTH + 2 * CM_WIDTH
N_MEM = 256
X_HEADS = 4
X_HEAD_DIM = D_MODEL // X_HEADS
D_FF = 4 * D_MODEL
EPS = 1e-6

kernel_name = "hybrid_hgrn2_gmlp_memxattn_step"


def rmsnorm(x, g):
    xf = x.astype(jnp.float32)
    y = xf * lax.rsqrt(jnp.mean(xf * xf, axis=-1, keepdims=True) + EPS)
    return (y * g.astype(jnp.float32)).astype(x.dtype)


def layernorm(x, g, b):
    xf = x.astype(jnp.float32)
    mu = jnp.mean(xf, axis=-1, keepdims=True)
    var = jnp.mean(jnp.square(xf - mu), axis=-1, keepdims=True)
    y = (xf - mu) * lax.rsqrt(var + EPS)
    return (y * g.astype(jnp.float32) + b.astype(jnp.float32)).astype(x.dtype)


def hgrn2_chunk(S, inp):
    q, k, logf, v = inp
    C = q.shape[1]
    b = jnp.cumsum(logf, axis=1)
    causal = jnp.tril(jnp.ones((C, C), dtype=bool))
    diff = b[:, :, None] - b[:, None, :]
    decay = jnp.exp(jnp.where(causal[None, :, :, None, None], diff, -jnp.inf))
    A = jnp.einsum('bthk,bshk,btshk->bhts', q, k, decay)
    o = (jnp.einsum('bhts,bshv->bthv', A, v)
         + jnp.einsum('bthk,bhkv->bthv', q * jnp.exp(b), S))
    b_last = b[:, -1]
    k_dec = k * jnp.exp(b_last[:, None] - b)
    S_new = jnp.exp(b_last)[..., None] * S + jnp.einsum('bshk,bshv->bhkv', k_dec, v)
    return S_new, o


def hgrn2_scan(S0, q, k, logf, v):
    B, L = q.shape[0], q.shape[1]
    C = min(HG_CHUNK, L)
    n = L // C
    def to_chunks(a):
        return jnp.moveaxis(a.reshape(B, n, C, HG_HEADS, a.shape[-1]), 1, 0)
    S_last, o = lax.scan(hgrn2_chunk, S0, (to_chunks(q), to_chunks(k), to_chunks(logf), to_chunks(v)))
    o = jnp.moveaxis(o, 0, 1).reshape(B, L, HG_HEADS, HG_DV)
    return S_last, o


def chunk_gmlp(u, vn, w_s, b_s):
    B, L, _ = u.shape
    T = min(CM_CHUNK, L)
    n = L // T
    uu = u.reshape(B, n, T, CM_GROUPS, CM_GROUP_DIM)
    vv = vn.reshape(B, n, T, CM_GROUPS, CM_GROUP_DIM)
    wm = jnp.where(jnp.tril(jnp.ones((T, T), dtype=bool))[None], w_s[:, :T, :T], 0.0).astype(vn.dtype)
    mixed = jnp.einsum('gts,bnsgc->bntgc', wm, vv) + b_s[:, :T].T.astype(vn.dtype)[None, None, :, :, None]
    return (uu * mixed).reshape(B, L, CM_WIDTH)


def decoder_layer(x, S0, mem_k, mem_v, lb, g_mix, w_in, hg_norm_g, ln_v_g, ln_v_b, w_s, b_s,
                  w_out, g_cross, w_cq, w_co, g_mlp, w_up, w_down):
    B, L, _ = x.shape
    hn = rmsnorm(x, g_mix)
    z = hn @ w_in
    zq, zf, zi, zg, zu, zv = jnp.split(
        z, [HG_WIDTH, 2 * HG_WIDTH, 3 * HG_WIDTH, 4 * HG_WIDTH, 4 * HG_WIDTH + CM_WIDTH], axis=-1)
    hs = (B, L, HG_HEADS, HG_DK)
    zf32 = zf.astype(jnp.float32).reshape(hs)
    q = jax.nn.silu(zq.astype(jnp.float32)).reshape(hs)
    f = lb + (1.0 - lb) * jax.nn.sigmoid(zf32)
    logf = jnp.log(f)
    k = (1.0 - lb) * jax.nn.sigmoid(-zf32)
    v = zi.astype(jnp.float32).reshape(B, L, HG_HEADS, HG_DV)
    S_new, o = hgrn2_scan(S0.astype(jnp.float32), q, k, logf, v)
    o = o * lax.rsqrt(jnp.mean(o * o, axis=-1, keepdims=True) + EPS) * hg_norm_g.astype(jnp.float32).reshape(HG_HEADS, HG_DV)
    o_hg = (o.reshape(B, L, HG_WIDTH) * jax.nn.sigmoid(zg.astype(jnp.float32))).astype(x.dtype)
    u = jax.nn.gelu(zu)
    vn = layernorm(jax.nn.gelu(zv), ln_v_g, ln_v_b)
    o_cm = chunk_gmlp(u, vn, w_s, b_s)
    x = x + jnp.concatenate([o_hg, o_cm], axis=-1) @ w_out
    hq = (rmsnorm(x, g_cross) @ w_cq).reshape(B, L, X_HEADS, X_HEAD_DIM)
    s = jnp.einsum('blhd,bmhd->bhlm', hq.astype(jnp.float32), mem_k.astype(jnp.float32)) * (X_HEAD_DIM ** -0.5)
    p = jax.nn.softmax(s, axis=-1).astype(x.dtype)
    ca = jnp.einsum('bhlm,bmhd->blhd', p, mem_v.astype(x.dtype)).reshape(B, L, D_MODEL)
    x = x + ca @ w_co
    hm = rmsnorm(x, g_mlp) @ w_up
    x = x + jnp.square(jax.nn.relu(hm)) @ w_down
    return x, S_new, vn


def setup_inputs(seed: int = 0) -> dict:
    key = jax.random.key(seed)
    ks = jax.random.split(key, 32)
    def nrm(k, shape, scale):
        return jax.random.normal(k, shape, jnp.float32) * scale
    def gain(k, shape):
        return 1.0 + 0.02 * jax.random.normal(k, shape, jnp.float32)
    return {
        "x_prompt": nrm(ks[0], (BATCH, SEQ, D_MODEL), 1.0),
        "x_sample": nrm(ks[1], (DEC_BATCH, DEC_SEQ, D_MODEL), 1.0),
        "mem_prompt": nrm(ks[2], (BATCH, N_MEM, D_MODEL), 1.0),
        "state_hgrn": nrm(ks[3], (DEPTH, DEC_BATCH, HG_HEADS, HG_DK, HG_DV), 0.3),
        "cache_mem_k": nrm(ks[4], (DEPTH, DEC_BATCH, N_MEM, X_HEADS, X_HEAD_DIM), 1.0),
        "cache_mem_v": nrm(ks[5], (DEPTH, DEC_BATCH, N_MEM, X_HEADS, X_HEAD_DIM), 1.0),
        "lb_param": nrm(ks[6], (DEPTH + 1, HG_WIDTH), 0.5),
        "g_mix": gain(ks[7], (DEPTH, D_MODEL)),
        "w_in": nrm(ks[8], (DEPTH, D_MODEL, IN_WIDTH), D_MODEL ** -0.5),
        "hg_norm_g": gain(ks[9], (DEPTH, HG_WIDTH)),
        "ln_v_g": gain(ks[10], (DEPTH, CM_WIDTH)),
        "ln_v_b": nrm(ks[11], (DEPTH, CM_WIDTH), 0.02),
        "w_s": nrm(ks[12], (DEPTH, CM_GROUPS, CM_CHUNK, CM_CHUNK), CM_CHUNK ** -0.5),
        "b_s": gain(ks[13], (DEPTH, CM_GROUPS, CM_CHUNK)),
        "w_out": nrm(ks[14], (DEPTH, D_MODEL, D_MODEL), D_MODEL ** -0.5),
        "g_cross": gain(ks[15], (DEPTH, D_MODEL)),
        "g_mem": gain(ks[16], (DEPTH, D_MODEL)),
        "w_cq": nrm(ks[17], (DEPTH, D_MODEL, D_MODEL), D_MODEL ** -0.5),
        "w_ck": nrm(ks[18], (DEPTH, D_MODEL, D_MODEL), D_MODEL ** -0.5),
        "w_cv": nrm(ks[19], (DEPTH, D_MODEL, D_MODEL), D_MODEL ** -0.5),
        "w_co": nrm(ks[20], (DEPTH, D_MODEL, D_MODEL), D_MODEL ** -0.5),
        "g_mlp": gain(ks[21], (DEPTH, D_MODEL)),
        "w_up": nrm(ks[22], (DEPTH, D_MODEL, D_FF), D_MODEL ** -0.5),
        "w_down": nrm(ks[23], (DEPTH, D_FF, D_MODEL), D_FF ** -0.5),
        "g_final": gain(ks[24], (D_MODEL,)),
    }


def reference(x_prompt, x_sample, mem_prompt, state_hgrn, cache_mem_k, cache_mem_v,
              lb_param, g_mix, w_in, hg_norm_g, ln_v_g, ln_v_b, w_s, b_s, w_out,
              g_cross, g_mem, w_cq, w_ck, w_cv, w_co, g_mlp, w_up, w_down, g_final):
    lb_all = jnp.cumsum(jax.nn.softmax(lb_param.astype(jnp.float32), axis=0), axis=0)
    xp, xs = x_prompt, x_sample
    S_p_list, S_s_list, mk_list, mv_list, cmv_list = [], [], [], [], []
    for l in range(DEPTH):
        lb = lb_all[l].reshape(HG_HEADS, HG_DK)
        mem_n = rmsnorm(mem_prompt, g_mem[l])
        mk = (mem_n @ w_ck[l]).reshape(BATCH if False else mem_prompt.shape[0], N_MEM, X_HEADS, X_HEAD_DIM)
        mv = (mem_n @ w_cv[l]).reshape(mem_prompt.shape[0], N_MEM, X_HEADS, X_HEAD_DIM)
        S0_p = jnp.zeros((xp.shape[0], HG_HEADS, HG_DK, HG_DV), jnp.float32)
        xp, S_p, _ = decoder_layer(xp, S0_p, mk, mv, lb, g_mix[l], w_in[l], hg_norm_g[l], ln_v_g[l], ln_v_b[l],
                                   w_s[l], b_s[l], w_out[l], g_cross[l], w_cq[l], w_co[l], g_mlp[l], w_up[l], w_down[l])
        xs, S_s, vn_s = decoder_layer(xs, state_hgrn[l], cache_mem_k[l], cache_mem_v[l], lb, g_mix[l], w_in[l],
                                      hg_norm_g[l], ln_v_g[l], ln_v_b[l], w_s[l], b_s[l], w_out[l], g_cross[l],
                                      w_cq[l], w_co[l], g_mlp[l], w_up[l], w_down[l])
        S_p_list.append(S_p.astype(state_hgrn.dtype))
        S_s_list.append(S_s.astype(state_hgrn.dtype))
        mk_list.append(mk.astype(cache_mem_k.dtype))
        mv_list.append(mv.astype(cache_mem_v.dtype))
        cmv_list.append(vn_s)
    y_prompt = rmsnorm(xp, g_final)
    y_sample = rmsnorm(xs, g_final)
    state_hgrn_prompt = jnp.stack(S_p_list)
    state_hgrn_sample = jnp.stack(S_s_list)
    mem_k_prompt = jnp.stack(mk_list)
    mem_v_prompt = jnp.stack(mv_list)
    cm_v_sample = jnp.stack(cmv_list)
    return (y_prompt, y_sample, state_hgrn_prompt, state_hgrn_sample, mem_k_prompt, mem_v_prompt, cm_v_sample)
```

```cpp
#include <hip/hip_runtime.h>
#include <hip/hip_cooperative_groups.h>
#include <cstdio>
namespace cg = cooperative_groups;
namespace pg8 {
#define PG8_LAS __attribute__((address_space(3)))
typedef unsigned short bf16_t;
typedef short bf16x8 __attribute__((ext_vector_type(8)));
typedef float f32x4 __attribute__((ext_vector_type(4)));
typedef unsigned u32x4 __attribute__((ext_vector_type(4)));
constexpr int BM = 256, BK = 64, HALF = 128, HTB = HALF * BK * 2  , STAGE_BYTES = 8 * HTB, NXCD = 8, WGM = 8;

__host__ __device__ __forceinline__ int lds_byte(int r, int c) { const int st = (r >> 4) * 2 + (c >> 5), rr = r & 15, cc = c & 31, ob = rr * 64 + cc * 2; return st * 1024 + (ob ^ (((ob >> 9) & 1) << 5)); }
__host__ __device__ __forceinline__ void stage_rc(int b, int& R, int& C) { const int st = b / 1024, sb = b % 1024, swz = sb ^ (((sb >> 9) & 1) << 5); R = (st >> 1) * 16 + swz / 64; C = (st & 1) * 32 + (swz % 64) / 2; }
__host__ __device__ __forceinline__ int perm32(int rho) { const int n = rho >> 4, i = rho & 15; return 8 * (i >> 2) + 4 * n + (i & 3); }

struct Unit { int pm, pn; };
struct Gemm { const bf16_t* A; const bf16_t* Bt; int M, N, K; };

struct StaticOrder {
    int nM, nN, nwg, G, c;
    __host__ __device__ void init(int M, int N, int G_, int c_) { nM = M / BM; nN = N / BM; nwg = nM * nN; G = G_; c = c_; }
    __host__ __device__ bool next(int i, Unit& u) const {
        const long L = (long)i * G + c; if (L >= nwg) return false;
        int wgid = (int)L; { const int q = nwg / NXCD, r = nwg % NXCD, xcd = wgid % NXCD, off = wgid / NXCD; wgid = (xcd < r ? xcd * (q + 1) : r * (q + 1) + (xcd - r) * q) + off; }
        const int nig = WGM * nN, gid = wgid / nig, fm = gid * WGM, gsz = (nM - fm) < WGM ? (nM - fm) : WGM;
        u.pm = fm + ((wgid % nig) % gsz); u.pn = (wgid % nig) / gsz; return true;
    }
    __device__ __forceinline__ void a_ready(const Unit&) const {}
    __device__ __forceinline__ void done(const Unit&) const {}
};
template <class Epi, class Sched, bool STAMP = false>
__device__ __forceinline__ void gemm_phase(PG8_LAS unsigned char* lds, const Gemm g, const Sched& S, const Epi& E, unsigned long long* stamps) {
    const int tid = threadIdx.x, wid = __builtin_amdgcn_readfirstlane(tid >> 6), lane = tid & 63, wr = wid >> 2, wc = wid & 3, fr = lane & 15, fq = lane >> 4;
    const int K = g.K, nt = K / BK;
    int ts_lo = 0, ts_hi = 0, nts = 0; const unsigned long long rt_entry = STAMP ? (unsigned long long)wall_clock64() : 0ull;
#define PG8_STAMP() do { if (STAMP && wid == 0 && nts < 64) { const unsigned long long _c = (unsigned long long)clock64(); \
        ts_lo = (lane == nts) ? (int)(unsigned)_c : ts_lo; ts_hi = (lane == nts) ? (int)(unsigned)(_c >> 32) : ts_hi; ++nts; } } while (0)
    PG8_STAMP();
    unsigned voffA[2], voffB[2];
#pragma unroll
    for (int i = 0; i < 2; ++i) { int R, C; stage_rc(tid * 16 + i * 8192, R, C); const int Rb = Epi::PERM ? ((R & ~31) + perm32(R & 31)) : R;
        voffA[i] = (unsigned)(R * K + C) * 2u; voffB[i] = (unsigned)(Rb * K + C) * 2u; }
    const size_t kstep = (size_t)(BK * 2);
    const size_t hstep = (size_t)HALF * K * 2;
    const size_t tstep = 2 * hstep;
    const unsigned ldsw = (unsigned)wid * 1024u;
    const int aoff = lds_byte(wr * 64 + fr, fq * 8), boff = lds_byte(wc * 32 + fr, fq * 8);
#define PG8_SA(b, h) (((b) * 2 + (h)) * HTB)
#define PG8_SB(b, h) ((4 + (b) * 2 + (h)) * HTB)
#define PG8_STAGE(bufoff, gbase, voff) do { _Pragma("unroll") for (int _i = 0; _i < 2; ++_i) \
        __builtin_amdgcn_global_load_lds((const unsigned*)((const char*)(gbase) + (voff)[_i]), (PG8_LAS unsigned*)(lds + (bufoff) + ldsw + _i * 8192), 16, 0, 0); } while (0)
#define PG8_LDA(dst, b, h) do { _Pragma("unroll") for (int m = 0; m < 4; ++m) _Pragma("unroll") for (int k = 0; k < 2; ++k) dst[m][k] = *(const PG8_LAS bf16x8*)(lds + PG8_SA(b, h) + aoff + m * 2048 + k * 1024); } while (0)
#define PG8_LDB(dst, b, h) do { _Pragma("unroll") for (int n = 0; n < 2; ++n) _Pragma("unroll") for (int k = 0; k < 2; ++k) dst[n][k] = *(const PG8_LAS bf16x8*)(lds + PG8_SB(b, h) + boff + n * 2048 + k * 1024); } while (0)
#define PG8_MMA(ai, bj, At, Bt) do { __builtin_amdgcn_s_setprio(1); _Pragma("unroll") for (int m = 0; m < 4; ++m) _Pragma("unroll") for (int n = 0; n < 2; ++n) _Pragma("unroll") for (int k = 0; k < 2; ++k) \
        acc[ai][bj][m][n] = __builtin_amdgcn_mfma_f32_16x16x32_bf16(Bt[n][k], At[m][k], acc[ai][bj][m][n], 0, 0, 0); __builtin_amdgcn_s_setprio(0); } while (0)
#define PG8_WAIT_V(n) asm volatile("s_waitcnt vmcnt(" #n ")" ::: "memory")
#define PG8_WAIT_L(n) asm volatile("s_waitcnt lgkmcnt(" #n ")" ::: "memory")
#define PG8_BAR __builtin_amdgcn_s_barrier()
#define PG8_SCHED __builtin_amdgcn_sched_barrier(0)
    Unit cur, nxt; int ui = 0;
    if (!S.next(0, cur)) return;
    f32x4 acc[2][2][4][2];
#pragma unroll
    for (int a = 0; a < 2; ++a)
#pragma unroll
        for (int b = 0; b < 2; ++b)
#pragma unroll
            for (int m = 0; m < 4; ++m)
#pragma unroll
                for (int n = 0; n < 2; ++n) acc[a][b][m][n] = (f32x4){0.f, 0.f, 0.f, 0.f};
    bf16x8 At[4][2], B0[2][2], B1[2][2];
    const char* cA = (const char*)g.A + (size_t)cur.pm * tstep; const char* cB = (const char*)g.Bt + (size_t)cur.pn * tstep;
    S.a_ready(cur);
    PG8_STAGE(PG8_SB(0, 0), cB, voffB); PG8_STAGE(PG8_SA(0, 0), cA, voffA); PG8_STAGE(PG8_SB(0, 1), cB + hstep, voffB); PG8_STAGE(PG8_SA(0, 1), cA + hstep, voffA);
    if (wr == 1) PG8_BAR;
    PG8_WAIT_V(4); PG8_BAR;
    PG8_STAGE(PG8_SB(1, 0), cB + kstep, voffB); PG8_STAGE(PG8_SA(1, 0), cA + kstep, voffA); PG8_STAGE(PG8_SB(1, 1), cB + hstep + kstep, voffB);
    PG8_WAIT_V(6); PG8_BAR;
    PG8_STAMP();
    for (;;) {
        const bool has_next = S.next(ui + 1, nxt);
        const char* nA = has_next ? (const char*)g.A + (size_t)nxt.pm * tstep : cA; const char* nB = has_next ? (const char*)g.Bt + (size_t)nxt.pn * tstep : cB;
        for (int t = 0; t < nt; t += 2) {
            const bool last = (t == nt - 2);
            const char* a1 = cA + (size_t)(t + 1) * kstep;
            const char* a2 = last ? nA : cA + (size_t)(t + 2) * kstep; const char* b2 = last ? nB : cB + (size_t)(t + 2) * kstep;
            const char* a3 = a2 + kstep; const char* b3 = b2 + kstep;
            if (last && has_next) S.a_ready(nxt);
            PG8_LDB(B0, 0, 0); PG8_SCHED; PG8_LDA(At, 0, 0); PG8_STAGE(PG8_SA(1, 1), a1 + hstep, voffA);
            PG8_WAIT_L(8); PG8_BAR; PG8_WAIT_L(0); PG8_MMA(0, 0, At, B0); PG8_BAR; PG8_SCHED;
            PG8_LDB(B1, 0, 1); PG8_STAGE(PG8_SB(0, 0), b2, voffB);
            PG8_BAR; PG8_WAIT_L(0); PG8_MMA(0, 1, At, B1); PG8_BAR;
            PG8_LDA(At, 0, 1); PG8_STAGE(PG8_SA(0, 0), a2, voffA);
            PG8_BAR; PG8_WAIT_L(0); PG8_MMA(1, 0, At, B0); PG8_BAR; PG8_SCHED;
            PG8_STAGE(PG8_SB(0, 1), b2 + hstep, voffB);
            PG8_WAIT_V(6); PG8_BAR; PG8_MMA(1, 1, At, B1); PG8_BAR;
            PG8_LDB(B0, 1, 0); PG8_SCHED; PG8_LDA(At, 1, 0); PG8_STAGE(PG8_SA(0, 1), a2 + hstep, voffA);
            PG8_WAIT_L(8); PG8_BAR; PG8_WAIT_L(0); PG8_MMA(0, 0, At, B0); PG8_BAR; PG8_SCHED;
            PG8_LDB(B1, 1, 1); PG8_STAGE(PG8_SB(1, 0), b3, voffB);
            PG8_BAR; PG8_WAIT_L(0); PG8_MMA(0, 1, At, B1); PG8_BAR;
            PG8_LDA(At, 1, 1); PG8_STAGE(PG8_SA(1, 0), a3, voffA);
            PG8_BAR; PG8_WAIT_L(0); PG8_MMA(1, 0, At, B0); PG8_BAR; PG8_SCHED;
            PG8_STAGE(PG8_SB(1, 1), b3 + hstep, voffB);
            PG8_WAIT_V(6); PG8_BAR; PG8_MMA(1, 1, At, B1); PG8_BAR;
        }
        PG8_STAMP();
        if constexpr (!Epi::AFTER_DRAIN) { E(acc, cur, wr, wc, fr, fq); S.done(cur); }
        PG8_STAMP();
        if (!has_next) break;
#pragma unroll
        for (int a = 0; a < 2; ++a)
#pragma unroll
            for (int b = 0; b < 2; ++b)
#pragma unroll
                for (int m = 0; m < 4; ++m)
#pragma unroll
                    for (int n = 0; n < 2; ++n) acc[a][b][m][n] = (f32x4){0.f, 0.f, 0.f, 0.f};
        cur = nxt; cA = nA; cB = nB; ++ui;
    }
    PG8_WAIT_V(0);
    if (wr == 0) PG8_BAR;
    PG8_BAR;
    if constexpr (Epi::AFTER_DRAIN) { E.fused(acc, cur, wr, wc, fr, fq, lds, wid, lane); S.done(cur); }
    PG8_STAMP();
    if (STAMP && wid == 0) { stamps[lane] = lane < nts ? (((unsigned long long)(unsigned)ts_hi << 32) | (unsigned)ts_lo) : 0ull;
        if (lane == 62) stamps[62] = rt_entry; if (lane == 63) stamps[63] = (unsigned long long)wall_clock64(); }
#undef PG8_STAMP
#undef PG8_SA
#undef PG8_SB
#undef PG8_STAGE
#undef PG8_LDA
#undef PG8_LDB
#undef PG8_MMA
#undef PG8_WAIT_V
#undef PG8_WAIT_L
#undef PG8_BAR
#undef PG8_SCHED
}
}

#define LAS __attribute__((address_space(3)))
using pg8::bf16_t; using pg8::bf16x8; using pg8::f32x4; using pg8::u32x4;
typedef unsigned u32x2 __attribute__((ext_vector_type(2)));
constexpr int DM = 1024, MP = 16384, MS = 512, MT = MP + MS, NMR = 2048, DFF = 4096, NIN = 3072;
constexpr float EPS = 1e-6f;
constexpr int NTHR = 512;
constexpr int LDS_BYTES = 144 * 1024;
constexpr size_t MB = 1024 * 1024;
constexpr size_t WS_WIN = 0, WS_WOUT = 6 * MB, WS_WCQ = 8 * MB, WS_WCKV = 10 * MB, WS_WCO = 14 * MB, WS_WUP = 16 * MB, WS_WDN = 24 * MB;
constexpr size_t WS_HN = 32 * MB;
constexpr size_t SZ_ROWB = (size_t)MT * DM * 2;
constexpr size_t WS_Z = WS_HN + SZ_ROWB;
constexpr size_t ZSZ = (size_t)MT * 512;
constexpr size_t WS_H = WS_HN;
constexpr size_t WS_C = WS_Z + 7 * ZSZ * 2;
constexpr size_t WS_MEMN = WS_C, WS_KB = WS_C + 4 * MB, WS_VT = WS_C + 8 * MB;
constexpr size_t WS_D = WS_C + 12 * MB;
constexpr size_t WS_DS = WS_D, WS_SC = WS_D + 32 * MB, WS_OI = WS_D + 64 * MB, WS_DEC = WS_D + 80 * MB;
constexpr size_t WS_HQ = WS_D, WS_CA = WS_D + 36 * MB;
constexpr size_t WS_E = WS_D + 81 * MB;
constexpr size_t WS_O = WS_E, WS_X1 = WS_O + SZ_ROWB, WS_XB = WS_X1 + 2 * SZ_ROWB, WS_SS = WS_XB + SZ_ROWB, WS_END = WS_SS + 3 * MT * 4;
static_assert(SZ_ROWB * 4 >= (size_t)MT * DFF * 2 && WS_END < 512 * MB, "workspace map");
constexpr size_t OUT_YP = 0, OUT_YS = 16777216, OUT_SP = 17301504, OUT_SSMP = 17825792, OUT_MK = 26214400, OUT_MV = 28311552, OUT_CMV = 30408704;

struct Params { const float* in[25]; float* out; unsigned char* ws; int ph_lo, ph_hi;
    __device__ __forceinline__ bf16_t* wsb(size_t off) const { return (bf16_t*)(ws + off); }
    __device__ __forceinline__ float* wsf(size_t off) const { return (float*)(ws + off); }
    __device__ __forceinline__ bf16_t* Z(int a) const { return (bf16_t*)(ws + WS_Z) + (size_t)a * ZSZ; }
};
typedef Params Ctx;


__device__ __forceinline__ bf16_t f2bf(float f) { unsigned u = __float_as_uint(f); u += 0x7FFFu + ((u >> 16) & 1u); return (bf16_t)(u >> 16); }
__device__ __forceinline__ float bf2f(bf16_t b) { return __uint_as_float(((unsigned)b) << 16); }
__device__ __forceinline__ unsigned pk2(float lo, float hi) { unsigned r; asm volatile("v_cvt_pk_bf16_f32 %0, %1, %2" : "=v"(r) : "v"(lo), "v"(hi)); return r; }
__device__ __forceinline__ float sigm(float x) { return __builtin_amdgcn_rcpf(1.0f + __expf(-x)); }
__device__ __forceinline__ float bflo(unsigned w) { return __uint_as_float(w << 16); }
__device__ __forceinline__ float bfhi(unsigned w) { return __uint_as_float(w & 0xffff0000u); }

struct Epi1 {
    static constexpr bool PERM = true, AFTER_DRAIN = false;
    bf16_t* Zb; const float* lbp;
    __device__ __forceinline__ void operator()(const f32x4 (&acc)[2][2][4][2], const pg8::Unit& u, int wr, int wc, int fr, int fq) const {
        const int sec = u.pn >> 1;
        const int row0 = u.pm * 256 + wr * 64 + fr;
        const int cs0 = (u.pn & 1) * 256 + wc * 32 + 8 * fq;
        if (sec == 1) {
            bf16_t* Zk = Zb + ZSZ; bf16_t* Zl = Zb + 2 * ZSZ;
#pragma unroll
            for (int bj = 0; bj < 2; ++bj) {
                const int cs = cs0 + bj * 128;
                const f32x4 p0a = *(const f32x4*)(lbp + cs), p0b = *(const f32x4*)(lbp + cs + 4), p1a = *(const f32x4*)(lbp + 512 + cs), p1b = *(const f32x4*)(lbp + 512 + cs + 4);
                float lb[8];
#pragma unroll
                for (int j = 0; j < 4; ++j) { lb[j] = sigm(p0a[j] - p1a[j]); lb[4 + j] = sigm(p0b[j] - p1b[j]); }
#pragma unroll
                for (int ai = 0; ai < 2; ++ai)
#pragma unroll
                    for (int m = 0; m < 4; ++m) {
                        const size_t o = (size_t)(row0 + ai * 128 + m * 16) * 512 + cs;
                        float kk[8], lf[8];
#pragma unroll
                        for (int j = 0; j < 8; ++j) { const float z = (j < 4) ? acc[ai][bj][m][0][j] : acc[ai][bj][m][1][j - 4];
                            const float sg = sigm(z), oml = 1.0f - lb[j]; kk[j] = oml * (1.0f - sg); lf[j] = __logf(lb[j] + oml * sg); }
                        u32x4 w; w.x = pk2(kk[0], kk[1]); w.y = pk2(kk[2], kk[3]); w.z = pk2(kk[4], kk[5]); w.w = pk2(kk[6], kk[7]);
                        *(u32x4*)(Zk + o) = w;
                        w.x = pk2(lf[0], lf[1]); w.y = pk2(lf[2], lf[3]); w.z = pk2(lf[4], lf[5]); w.w = pk2(lf[6], lf[7]);
                        *(u32x4*)(Zl + o) = w;
                    }
            }
        } else {
            bf16_t* Zo = Zb + (size_t)(sec == 0 ? 0 : sec + 1) * ZSZ;
#pragma unroll
            for (int bj = 0; bj < 2; ++bj) {
                const int cs = cs0 + bj * 128;
#pragma unroll
                for (int ai = 0; ai < 2; ++ai)
#pragma unroll
                    for (int m = 0; m < 4; ++m) {
                        const size_t o = (size_t)(row0 + ai * 128 + m * 16) * 512 + cs;
                        float r[8];
#pragma unroll
                        for (int j = 0; j < 8; ++j) { const float z = (j < 4) ? acc[ai][bj][m][0][j] : acc[ai][bj][m][1][j - 4];
                            const float t = (sec >= 4) ? 1.5957691216f * (z + 0.044715f * z * z * z) : z;
                            const float sg = sigm(t);
                            r[j] = (sec == 2) ? z : ((sec == 3) ? sg : z * sg); }
                        u32x4 w; w.x = pk2(r[0], r[1]); w.y = pk2(r[2], r[3]); w.z = pk2(r[4], r[5]); w.w = pk2(r[6], r[7]);
                        *(u32x4*)(Zo + o) = w;
                    }
            }
        }
    }
};

struct EpiMem {
    static constexpr bool PERM = false, AFTER_DRAIN = false;
    float* outK; float* outV; bf16_t* KB; bf16_t* VT;
    __device__ __forceinline__ void operator()(const f32x4 (&acc)[2][2][4][2], const pg8::Unit& u, int wr, int wc, int fr, int fq) const {
        const int row0 = u.pm * 256 + wr * 64 + fr;
        const bool isV = u.pn >= 4;
        const int col0 = (u.pn & 3) * 256 + wc * 32 + 4 * fq;
        float* outp = isV ? outV : outK;
#pragma unroll
        for (int ai = 0; ai < 2; ++ai)
#pragma unroll
            for (int m = 0; m < 4; ++m) {
                const int row = row0 + ai * 128 + m * 16;
#pragma unroll
                for (int bj = 0; bj < 2; ++bj)
#pragma unroll
                    for (int n = 0; n < 2; ++n) {
                        const int c = col0 + bj * 128 + n * 16; const f32x4 v = acc[ai][bj][m][n];
                        *(f32x4*)(outp + (size_t)row * 1024 + c) = v;
                        if (!isV) { u32x2 w; w.x = pk2(v[0], v[1]); w.y = pk2(v[2], v[3]); *(u32x2*)(KB + (size_t)row * 1024 + c) = w; }
                        else { const int b = row >> 8, mm = row & 255;
#pragma unroll
                            for (int j = 0; j < 4; ++j) VT[((size_t)b * 1024 + c + j) * 256 + mm] = f2bf(v[j]); }
                    }
            }
    }
};

struct EpiRes {
    static constexpr bool PERM = false, AFTER_DRAIN = false;
    const float* resP; const float* resS;
    float* out; bf16_t* outb; float* ss;
    __device__ __forceinline__ void operator()(const f32x4 (&acc)[2][2][4][2], const pg8::Unit& u, int wr, int wc, int fr, int fq) const {
        const int row0 = u.pm * 256 + wr * 64 + fr, col0 = u.pn * 256 + wc * 32 + 4 * fq;
        const float* res = (u.pm < MP / 256) ? resP : resS;
#pragma unroll
        for (int ai = 0; ai < 2; ++ai)
#pragma unroll
            for (int m = 0; m < 4; ++m) {
                const int row = row0 + ai * 128 + m * 16; const size_t o = (size_t)row * 1024 + col0; float s = 0.f;
#pragma unroll
                for (int bj = 0; bj < 2; ++bj)
#pragma unroll
                    for (int n = 0; n < 2; ++n) {
                        const size_t oo = o + bj * 128 + n * 16;
                        const f32x4 v = *(const f32x4*)(res + oo) + acc[ai][bj][m][n];
                        *(f32x4*)(out + oo) = v;
                        if (outb) { u32x2 w; w.x = pk2(v[0], v[1]); w.y = pk2(v[2], v[3]); *(u32x2*)(outb + oo) = w; }
                        s += (v[0] * v[0] + v[1] * v[1]) + (v[2] * v[2] + v[3] * v[3]);
                    }
                s += __shfl_xor(s, 16); s += __shfl_xor(s, 32);
                if (fq == 0) atomicAdd(ss + row, s);
            }
    }
};

template <int ACT> struct EpiScale {
    static constexpr bool PERM = true, AFTER_DRAIN = false;
    bf16_t* O; int ldc; const float* ss; float scale;
    __device__ __forceinline__ void operator()(const f32x4 (&acc)[2][2][4][2], const pg8::Unit& u, int wr, int wc, int fr, int fq) const {
        const int row0 = u.pm * 256 + wr * 64 + fr, col0 = u.pn * 256 + wc * 32 + 8 * fq;
#pragma unroll
        for (int ai = 0; ai < 2; ++ai)
#pragma unroll
            for (int m = 0; m < 4; ++m) {
                const int row = row0 + ai * 128 + m * 16;
                const float rs = rsqrtf(ss[row] * (1.0f / 1024.0f) + EPS) * scale;
                bf16_t* rowp = O + (size_t)row * ldc + col0;
#pragma unroll
                for (int bj = 0; bj < 2; ++bj) {
                    f32x4 v0 = acc[ai][bj][m][0] * rs, v1 = acc[ai][bj][m][1] * rs;
                    if (ACT == 1) {
#pragma unroll
                        for (int j = 0; j < 4; ++j) { const float a = fmaxf(v0[j], 0.f), b = fmaxf(v1[j], 0.f); v0[j] = a * a; v1[j] = b * b; } }
                    u32x4 w; w.x = pk2(v0[0], v0[1]); w.y = pk2(v0[2], v0[3]); w.z = pk2(v1[0], v1[1]); w.w = pk2(v1[2], v1[3]);
                    *(u32x4*)(rowp + bj * 128) = w;
                }
            }
    }
};

__device__ __forceinline__ void cvt_tile(const float* W, int K, int N, bf16_t* Wt, const float* gain, int t, LAS float* tl) {
    const int tid = threadIdx.x;
    const int ntn = N >> 6; const int kt = t / ntn, nt = t - kt * ntn; const int k0 = kt * 64, n0 = nt * 64;
#pragma unroll
    for (int p = 0; p < 2; ++p) {
        const int k = p * 32 + (tid >> 4), n4 = (tid & 15) * 4;
        f32x4 v = *(const f32x4*)(W + (size_t)(k0 + k) * N + n0 + n4);
        if (gain) v *= gain[k0 + k];
        tl[k * 65 + n4 + 0] = v[0]; tl[k * 65 + n4 + 1] = v[1]; tl[k * 65 + n4 + 2] = v[2]; tl[k * 65 + n4 + 3] = v[3];
    }
    __syncthreads();
    {
        const int n = tid >> 3, k8 = (tid & 7) * 8;
        float r[8];
#pragma unroll
        for (int j = 0; j < 8; ++j) r[j] = tl[(k8 + j) * 65 + n];
        u32x4 w; w.x = pk2(r[0], r[1]); w.y = pk2(r[2], r[3]); w.z = pk2(r[4], r[5]); w.w = pk2(r[6], r[7]);
        *(u32x4*)(Wt + (size_t)(n0 + n) * K + k0 + k8) = w;
    }
    __syncthreads();
}

__device__ __forceinline__ void phase_prep(const Ctx& C, LAS unsigned char* lds) {
    const int tid = threadIdx.x, lane = tid & 63, wid = tid >> 6;
    LAS float* tl = (LAS float*)lds;
    for (int t = blockIdx.x; t < 4096; t += gridDim.x) {
        if (t < 768) cvt_tile(C.in[8], 1024, 3072, C.wsb(WS_WIN), nullptr, t, tl);
        else if (t < 1024) cvt_tile(C.in[14], 1024, 1024, C.wsb(WS_WOUT), nullptr, t - 768, tl);
        else if (t < 1280) cvt_tile(C.in[17], 1024, 1024, C.wsb(WS_WCQ), C.in[15], t - 1024, tl);
        else if (t < 1536) cvt_tile(C.in[18], 1024, 1024, C.wsb(WS_WCKV), nullptr, t - 1280, tl);
        else if (t < 1792) cvt_tile(C.in[19], 1024, 1024, C.wsb(WS_WCKV) + 1024 * 1024, nullptr, t - 1536, tl);
        else if (t < 2048) cvt_tile(C.in[20], 1024, 1024, C.wsb(WS_WCO), nullptr, t - 1792, tl);
        else if (t < 3072) cvt_tile(C.in[22], 1024, 4096, C.wsb(WS_WUP), C.in[21], t - 2048, tl);
        else cvt_tile(C.in[23], 4096, 1024, C.wsb(WS_WDN), nullptr, t - 3072, tl);
    }
    for (int r = blockIdx.x * 8 + wid; r < MT + NMR; r += gridDim.x * 8) {
        const float* src; const float* g; bf16_t* dst;
        if (r < MP) { src = C.in[0] + (size_t)r * 1024; g = C.in[7]; dst = C.wsb(WS_HN) + (size_t)r * 1024; }
        else if (r < MT) { src = C.in[1] + (size_t)(r - MP) * 1024; g = C.in[7]; dst = C.wsb(WS_HN) + (size_t)r * 1024; }
        else { src = C.in[2] + (size_t)(r - MT) * 1024; g = C.in[16]; dst = C.wsb(WS_MEMN) + (size_t)(r - MT) * 1024; }
        f32x4 v[4]; float s = 0.f;
#pragma unroll
        for (int i = 0; i < 4; ++i) { v[i] = *(const f32x4*)(src + i * 256 + lane * 4); s += (v[i][0] * v[i][0] + v[i][1] * v[i][1]) + (v[i][2] * v[i][2] + v[i][3] * v[i][3]); }
#pragma unroll
        for (int o = 32; o >= 1; o >>= 1) s += __shfl_xor(s, o);
        const float rs = rsqrtf(s * (1.0f / 1024.0f) + EPS);
#pragma unroll
        for (int i = 0; i < 4; ++i) { const f32x4 gg = *(const f32x4*)(g + i * 256 + lane * 4); const f32x4 y = v[i] * rs * gg;
            u32x2 w; w.x = pk2(y[0], y[1]); w.y = pk2(y[2], y[3]); *(u32x2*)(dst + i * 256 + lane * 4) = w; }
    }
    float* ss = C.wsf(WS_SS);
    for (int i = blockIdx.x * NTHR + tid; i < 3 * MT; i += gridDim.x * NTHR) ss[i] = 0.f;
}

__device__ __forceinline__ bf16x8 ld8(const LAS bf16_t* p) { return *(const LAS bf16x8*)p; }
__device__ __forceinline__ bf16x8 gld8(const bf16_t* p) { return *(const bf16x8*)p; }
#define MFMA16(a, b, c) __builtin_amdgcn_mfma_f32_16x16x32_bf16((a), (b), (c), 0, 0, 0)

__device__ __forceinline__ void hg_intra(const Ctx& C, LAS unsigned char* lds, int item) {
    const int tid = threadIdx.x, lane = tid & 63, wid = tid >> 6, r = lane & 15, qd = lane >> 4;
    const int b = item >> 7, c = (item >> 2) & 31, h = item & 3;
    const size_t row0 = (size_t)b * 2048 + c * 64; const int hc = h * 128;
    LAS bf16_t* sQV = (LAS bf16_t*)lds;
    LAS bf16_t* sKE = sQV + 7 * 2176;
    LAS bf16_t* sKD = sKE + 3 * 2176;
    LAS bf16_t* sKT = sKD + 4 * 2176;
    LAS bf16_t* sVT = sKT + 128 * 72;
    LAS bf16_t* sA = sVT + 128 * 72;
    LAS float* sTot = (LAS float*)(sA + 64 * 72);
    const int k = tid & 127, i = tid >> 7;
    float q[16], kk[16], bl[16];
    {
        const bf16_t* pq = C.Z(0) + (row0 + 16 * i) * 512 + hc + k;
        const bf16_t* pk = C.Z(1) + (row0 + 16 * i) * 512 + hc + k;
        const bf16_t* pl = C.Z(2) + (row0 + 16 * i) * 512 + hc + k;
        const bf16_t* pv = C.Z(3) + (row0 + 16 * i) * 512 + hc + k;
        float lf[16]; unsigned vv[16];
#pragma unroll
        for (int t = 0; t < 16; ++t) { q[t] = bf2f(pq[t * 512]); kk[t] = bf2f(pk[t * 512]); lf[t] = bf2f(pl[t * 512]); vv[t] = pv[t * 512]; }
        float cum = 0.f;
#pragma unroll
        for (int t = 0; t < 16; ++t) { cum += lf[t]; bl[t] = cum; }
        sTot[i * 128 + k] = cum;
        u32x4 w0, w1;
        w0.x = vv[0] | (vv[1] << 16); w0.y = vv[2] | (vv[3] << 16); w0.z = vv[4] | (vv[5] << 16); w0.w = vv[6] | (vv[7] << 16);
        w1.x = vv[8] | (vv[9] << 16); w1.y = vv[10] | (vv[11] << 16); w1.z = vv[12] | (vv[13] << 16); w1.w = vv[14] | (vv[15] << 16);
        *(LAS u32x4*)(sVT + k * 72 + 16 * i) = w0; *(LAS u32x4*)(sVT + k * 72 + 16 * i + 8) = w1;
    }
    __syncthreads();
    {
        const float t0 = sTot[k], t1 = sTot[128 + k], t2 = sTot[256 + k], t3 = sTot[384 + k];
        const float bend0 = t0, bend1 = t0 + t1, bend2 = bend1 + t2, blast = bend2 + t3;
        const float bstart = (i == 0) ? 0.f : ((i == 1) ? bend0 : ((i == 2) ? bend1 : bend2));
        const float cum = bl[15];
        const float cE = __expf(bstart), c0 = __expf(bstart - bend0), c1 = __expf(bstart - bend1), cdec = __expf(blast - (bstart + cum));
        const int idD = (i == 0) ? 0 : (1 + ((i - 1) * i) / 2 + (i - 1));
        const int id0 = 1 + ((i - 1) * i) / 2;
        bf16_t* pqe = C.Z(0) + (row0 + 16 * i) * 512 + hc + k;
        unsigned kd16[16];
#pragma unroll
        for (int t = 0; t < 16; ++t) {
            const float e = __expf(bl[t]), ei = __expf(-bl[t]), ek = __expf(cum - bl[t]);
            const float qdv = q[t] * e, kdv = kk[t] * ei, kev = kk[t] * ek;
            sQV[(idD * 16 + t) * 136 + k] = f2bf(qdv);
            if (i >= 2) sQV[(id0 * 16 + t) * 136 + k] = f2bf(qdv * c0);
            if (i == 3) sQV[(5 * 16 + t) * 136 + k] = f2bf(qdv * c1);
            sKD[(i * 16 + t) * 136 + k] = f2bf(kdv);
            if (i < 3) sKE[(i * 16 + t) * 136 + k] = f2bf(kev);
            kd16[t] = f2bf(kev * cdec);
            pqe[t * 512] = f2bf(qdv * cE);
        }
        u32x4 w0, w1;
        w0.x = kd16[0] | (kd16[1] << 16); w0.y = kd16[2] | (kd16[3] << 16); w0.z = kd16[4] | (kd16[5] << 16); w0.w = kd16[6] | (kd16[7] << 16);
        w1.x = kd16[8] | (kd16[9] << 16); w1.y = kd16[10] | (kd16[11] << 16); w1.z = kd16[12] | (kd16[13] << 16); w1.w = kd16[14] | (kd16[15] << 16);
        *(LAS u32x4*)(sKT + k * 72 + 16 * i) = w0; *(LAS u32x4*)(sKT + k * 72 + 16 * i + 8) = w1;
        if (i == 0) C.wsf(WS_DEC)[(size_t)item * 128 + k] = __expf(blast);
    }
    __syncthreads();
#pragma unroll
    for (int x = 0; x < 2; ++x) {
        const int tile = wid * 2 + x, ti = tile >> 2, tj = tile & 3;
        f32x4 d = {0.f, 0.f, 0.f, 0.f};
        if (tj <= ti) {
            const int ida = (ti == 0) ? 0 : (1 + ((ti - 1) * ti) / 2 + ((tj == ti) ? ti - 1 : tj));
            const LAS bf16_t* Aop = sQV + ida * 2176 + r * 136 + qd * 8;
            const LAS bf16_t* Bop = ((tj == ti) ? (sKD + ti * 2176) : (sKE + tj * 2176)) + r * 136 + qd * 8;
#pragma unroll
            for (int k4 = 0; k4 < 4; ++k4) d = MFMA16(ld8(Aop + k4 * 32), ld8(Bop + k4 * 32), d);
        }
#pragma unroll
        for (int jx = 0; jx < 4; ++jx) { const int t = 4 * qd + jx; const bool keep = (tj < ti) || (tj == ti && r <= t);
            sA[(16 * ti + t) * 72 + 16 * tj + r] = f2bf(keep ? d[jx] : 0.f); }
    }
    __syncthreads();
    {
        bf16_t* OI = C.wsb(WS_OI); bf16_t* DS = C.wsb(WS_DS) + (size_t)item * 16384;
        const bf16x8 v0 = ld8(sVT + (16 * wid + r) * 72 + qd * 8), v1 = ld8(sVT + (16 * wid + r) * 72 + 32 + qd * 8);
#pragma unroll
        for (int ti = 0; ti < 4; ++ti) {
            f32x4 d = {0.f, 0.f, 0.f, 0.f};
            d = MFMA16(ld8(sA + (16 * ti + r) * 72 + qd * 8), v0, d);
            d = MFMA16(ld8(sA + (16 * ti + r) * 72 + 32 + qd * 8), v1, d);
#pragma unroll
            for (int jx = 0; jx < 4; ++jx) OI[(row0 + 16 * ti + 4 * qd + jx) * 512 + hc + 16 * wid + r] = f2bf(d[jx]);
        }
#pragma unroll
        for (int kt = 0; kt < 8; ++kt) {
            f32x4 d = {0.f, 0.f, 0.f, 0.f};
            d = MFMA16(v0, ld8(sKT + (16 * kt + r) * 72 + qd * 8), d);
            d = MFMA16(v1, ld8(sKT + (16 * kt + r) * 72 + 32 + qd * 8), d);
#pragma unroll
            for (int jx = 0; jx < 4; ++jx) DS[(16 * wid + 4 * qd + jx) * 128 + 16 * kt + r] = f2bf(d[jx]);
        }
    }
    __syncthreads();
}

__device__ __forceinline__ void hg_scan(const Ctx& C) {
    const bf16_t* DS = C.wsb(WS_DS); bf16_t* SC = C.wsb(WS_SC); const float* DEC = C.wsf(WS_DEC);
    float* outS = C.out + OUT_SP;
    for (int g = blockIdx.x * NTHR + threadIdx.x; g < 32 * 4096; g += gridDim.x * NTHR) {
        const int bh = g >> 12, e = g & 4095, v = e >> 5, k4 = (e & 31) * 4, b = bh >> 2, h = bh & 3;
        float S0 = 0.f, S1 = 0.f, S2 = 0.f, S3 = 0.f;
#pragma unroll 4
        for (int c = 0; c < 32; ++c) {
            const int item = b * 128 + c * 4 + h; const size_t off = (size_t)item * 16384 + v * 128 + k4;
            u32x2 w; w.x = pk2(S0, S1); w.y = pk2(S2, S3); *(u32x2*)(SC + off) = w;
            const f32x4 dc = *(const f32x4*)(DEC + (size_t)item * 128 + k4); const u32x2 ds = *(const u32x2*)(DS + off);
            S0 = dc[0] * S0 + bflo(ds.x); S1 = dc[1] * S1 + bfhi(ds.x); S2 = dc[2] * S2 + bflo(ds.y); S3 = dc[3] * S3 + bfhi(ds.y);
        }
        float* o = outS + ((size_t)(b * 4 + h) * 128 + k4) * 128 + v;
        o[0] = S0; o[128] = S1; o[256] = S2; o[384] = S3;
    }
}

__device__ __forceinline__ void gmlp_item(const Ctx& C, LAS unsigned char* lds, int item) {
    const int tid = threadIdx.x, lane = tid & 63, wid = tid >> 6, r = lane & 15, qd = lane >> 4;
    const int n = item >> 2, g = item & 3; const size_t rb = (size_t)n * 128;
    LAS bf16_t* sW = (LAS bf16_t*)lds;
    LAS bf16_t* sVN = sW + 128 * 136;
    LAS float* sSt = (LAS float*)(sVN + 128 * 136);
    const bf16_t* Zgv = C.Z(6); const bf16_t* Zu = C.Z(5);
    {
        const int row = tid >> 2, qt = tid & 3; const bf16_t* p = Zgv + (rb + row) * 512 + qt * 128;
        float s = 0.f, s2 = 0.f;
#pragma unroll
        for (int i = 0; i < 16; ++i) { const u32x4 w = *(const u32x4*)(p + i * 8);
#pragma unroll
            for (int j = 0; j < 4; ++j) { const float a = bflo(w[j]), bb = bfhi(w[j]); s += a + bb; s2 += a * a + bb * bb; } }
        s += __shfl_xor(s, 1); s2 += __shfl_xor(s2, 1); s += __shfl_xor(s, 2); s2 += __shfl_xor(s2, 2);
        const float mean = s * (1.0f / 512.0f), var = fmaxf(s2 * (1.0f / 512.0f) - mean * mean, 0.f);
        if (qt == 0) { sSt[row * 2] = mean; sSt[row * 2 + 1] = rsqrtf(var + EPS); }
    }
    {
        const float* W = C.in[12] + (size_t)g * 16384;
#pragma unroll
        for (int it = 0; it < 8; ++it) { const int e = (it * NTHR + tid) * 4, t = e >> 7, s = e & 127; const f32x4 v = *(const f32x4*)(W + e);
            u32x2 w; w.x = pk2(s <= t ? v[0] : 0.f, s + 1 <= t ? v[1] : 0.f); w.y = pk2(s + 2 <= t ? v[2] : 0.f, s + 3 <= t ? v[3] : 0.f);
            *(LAS u32x2*)(sW + t * 136 + s) = w; }
    }
    __syncthreads();
    {
        const int c = tid & 127, sb = tid >> 7; const float lg = C.in[10][g * 128 + c], lbb = C.in[11][g * 128 + c];
        const bf16_t* p = Zgv + (rb + sb * 32) * 512 + g * 128 + c;
        unsigned vv[32];
#pragma unroll
        for (int s = 0; s < 32; ++s) { const float x = bf2f(p[s * 512]); const float mean = sSt[(sb * 32 + s) * 2], rs = sSt[(sb * 32 + s) * 2 + 1];
            vv[s] = f2bf((x - mean) * rs * lg + lbb); }
#pragma unroll
        for (int s8 = 0; s8 < 4; ++s8) { u32x4 w; w.x = vv[s8 * 8] | (vv[s8 * 8 + 1] << 16); w.y = vv[s8 * 8 + 2] | (vv[s8 * 8 + 3] << 16); w.z = vv[s8 * 8 + 4] | (vv[s8 * 8 + 5] << 16); w.w = vv[s8 * 8 + 6] | (vv[s8 * 8 + 7] << 16);
            *(LAS u32x4*)(sVN + c * 136 + sb * 32 + s8 * 8) = w; }
    }
    __syncthreads();
    {
        bf16_t* O = C.wsb(WS_O); const float* bs = C.in[13] + g * 128;
        bf16x8 bfr[4];
#pragma unroll
        for (int k4 = 0; k4 < 4; ++k4) bfr[k4] = ld8(sVN + (16 * wid + r) * 136 + k4 * 32 + qd * 8);
#pragma unroll
        for (int ti = 0; ti < 8; ++ti) {
            f32x4 d = {0.f, 0.f, 0.f, 0.f};
#pragma unroll
            for (int k4 = 0; k4 < 4; ++k4) if (k4 <= (ti >> 1)) d = MFMA16(ld8(sW + (16 * ti + r) * 136 + k4 * 32 + qd * 8), bfr[k4], d);
#pragma unroll
            for (int jx = 0; jx < 4; ++jx) { const int t = 16 * ti + 4 * qd + jx; const int cc = g * 128 + 16 * wid + r;
                const float uu = bf2f(Zu[(rb + t) * 512 + cc]);
                O[(rb + t) * 1024 + 512 + cc] = f2bf(uu * (d[jx] + bs[t])); }
        }
    }
    __syncthreads();
}

__device__ __forceinline__ void hg_sample_item(const Ctx& C, LAS unsigned char* lds, int item) {
    const int tid = threadIdx.x, lane = tid & 63, wid = tid >> 6;
    const int bs = item >> 2, h = item & 3, hc = h * 128; const size_t r0 = (size_t)MP + bs * 4;
    LAS float* sq = (LAS float*)lds; LAS float* sk = sq + 512; LAS float* sf = sk + 512;
    LAS float* sp = sf + 512;
    LAS float* sred = sp + 2048;
    {
        const int t = tid >> 7, k = tid & 127; const size_t o = (r0 + t) * 512 + hc + k;
        sq[tid] = bf2f(C.Z(0)[o]); sk[tid] = bf2f(C.Z(1)[o]); sf[tid] = __expf(bf2f(C.Z(2)[o]));
    }
    const int v = tid & 127, kq = tid >> 7;
    float S[32];
    const float* sin = C.in[3] + (size_t)item * 16384 + (size_t)(kq * 32) * 128 + v;
#pragma unroll
    for (int j = 0; j < 32; ++j) S[j] = sin[j * 128];
    float vt[4];
#pragma unroll
    for (int t = 0; t < 4; ++t) vt[t] = bf2f(C.Z(3)[(r0 + t) * 512 + hc + v]);
    __syncthreads();
#pragma unroll
    for (int t = 0; t < 4; ++t) {
        float po = 0.f;
#pragma unroll
        for (int j = 0; j < 32; ++j) { const int k = kq * 32 + j; S[j] = sf[t * 128 + k] * S[j] + sk[t * 128 + k] * vt[t]; po += S[j] * sq[t * 128 + k]; }
        sp[(kq * 4 + t) * 128 + v] = po;
    }
    float* sout = C.out + OUT_SSMP + (size_t)item * 16384 + (size_t)(kq * 32) * 128 + v;
#pragma unroll
    for (int j = 0; j < 32; ++j) sout[j * 128] = S[j];
    __syncthreads();
    {
        const int t = tid >> 7;
        const float o = sp[(0 * 4 + t) * 128 + v] + sp[(1 * 4 + t) * 128 + v] + sp[(2 * 4 + t) * 128 + v] + sp[(3 * 4 + t) * 128 + v];
        float s = o * o;
#pragma unroll
        for (int x = 32; x >= 1; x >>= 1) s += __shfl_xor(s, x);
        if (lane == 0) sred[wid] = s;
        __syncthreads();
        const float ms = (sred[2 * t] + sred[2 * t + 1]) * (1.0f / 128.0f);
        const float gg = bf2f(C.Z(4)[(r0 + t) * 512 + hc + v]);
        C.wsb(WS_O)[(r0 + t) * 1024 + hc + v] = f2bf(o * rsqrtf(ms + EPS) * C.in[9][hc + v] * gg);
    }
    __syncthreads();
}

__device__ __forceinline__ void gmlp_sample_item(const Ctx& C, LAS unsigned char* lds, int bs) {
    const int tid = threadIdx.x, lane = tid & 63, wid = tid >> 6; const size_t r0 = (size_t)MP + bs * 4;
    LAS float* sred = (LAS float*)lds;
    const int c = tid, g = c >> 7;
    float gv[4], s[4], s2[4];
#pragma unroll
    for (int t = 0; t < 4; ++t) { gv[t] = bf2f(C.Z(6)[(r0 + t) * 512 + c]); s[t] = gv[t]; s2[t] = gv[t] * gv[t]; }
#pragma unroll
    for (int t = 0; t < 4; ++t)
#pragma unroll
        for (int x = 32; x >= 1; x >>= 1) { s[t] += __shfl_xor(s[t], x); s2[t] += __shfl_xor(s2[t], x); }
    if (lane == 0) {
#pragma unroll
        for (int t = 0; t < 4; ++t) { sred[wid * 8 + t] = s[t]; sred[wid * 8 + 4 + t] = s2[t]; } }
    __syncthreads();
    float vn[4]; const float lg = C.in[10][c], lbb = C.in[11][c];
#pragma unroll
    for (int t = 0; t < 4; ++t) { float a = 0.f, a2 = 0.f;
#pragma unroll
        for (int w = 0; w < 8; ++w) { a += sred[w * 8 + t]; a2 += sred[w * 8 + 4 + t]; }
        const float mean = a * (1.0f / 512.0f), var = fmaxf(a2 * (1.0f / 512.0f) - mean * mean, 0.f);
        vn[t] = (gv[t] - mean) * rsqrtf(var + EPS) * lg + lbb;
        C.out[OUT_CMV + ((size_t)bs * 4 + t) * 512 + c] = vn[t]; }
    const float* W = C.in[12] + (size_t)g * 16384; const float* bsp = C.in[13] + g * 128;
#pragma unroll
    for (int t = 0; t < 4; ++t) { float mix = bsp[t];
#pragma unroll
        for (int sx = 0; sx < 4; ++sx) if (sx <= t) mix += W[t * 128 + sx] * vn[sx];
        const float uu = bf2f(C.Z(5)[(r0 + t) * 512 + c]);
        C.wsb(WS_O)[(r0 + t) * 1024 + 512 + c] = f2bf(uu * mix); }
    __syncthreads();
}

__device__ __forceinline__ void hg_out(const Ctx& C) {
    const int lane = threadIdx.x & 63, wid = threadIdx.x >> 6, r = lane & 15, qd = lane >> 4;
    const bf16_t* QE = C.Z(0); const bf16_t* SC = C.wsb(WS_SC); const bf16_t* OI = C.wsb(WS_OI); const bf16_t* Zg = C.Z(4); bf16_t* O = C.wsb(WS_O);
    const float* hgn = C.in[9];
    for (int sub = blockIdx.x * 8 + wid; sub < 4096; sub += gridDim.x * 8) {
        const int item = sub >> 2, ti = sub & 3; const int b = item >> 7, c = (item >> 2) & 31, h = item & 3, hc = h * 128;
        const size_t row0 = (size_t)b * 2048 + c * 64 + 16 * ti;
        bf16x8 a[4];
#pragma unroll
        for (int k4 = 0; k4 < 4; ++k4) a[k4] = gld8(QE + (row0 + r) * 512 + hc + k4 * 32 + qd * 8);
        f32x4 d[8];
#pragma unroll
        for (int vt = 0; vt < 8; ++vt) { d[vt] = (f32x4){0.f, 0.f, 0.f, 0.f};
#pragma unroll
            for (int k4 = 0; k4 < 4; ++k4) d[vt] = MFMA16(a[k4], gld8(SC + (size_t)item * 16384 + (16 * vt + r) * 128 + k4 * 32 + qd * 8), d[vt]); }
#pragma unroll
        for (int jx = 0; jx < 4; ++jx) {
            const size_t row = row0 + 4 * qd + jx; float s = 0.f;
#pragma unroll
            for (int vt = 0; vt < 8; ++vt) { const float o = d[vt][jx] + bf2f(OI[row * 512 + hc + 16 * vt + r]); d[vt][jx] = o; s += o * o; }
            s += __shfl_xor(s, 1); s += __shfl_xor(s, 2); s += __shfl_xor(s, 4); s += __shfl_xor(s, 8);
            const float rs = rsqrtf(s * (1.0f / 128.0f) + EPS);
#pragma unroll
            for (int vt = 0; vt < 8; ++vt) { const int cc = hc + 16 * vt + r;
                O[row * 1024 + cc] = f2bf(d[vt][jx] * rs * hgn[cc] * bf2f(Zg[row * 512 + cc])); }
        }
    }
}

__device__ __forceinline__ void attn_prompt_item(const Ctx& C, LAS unsigned char* lds, int item) {
    const int tid = threadIdx.x, lane = tid & 63, wid = tid >> 6, r = lane & 15, qd = lane >> 4;
    const int b = item >> 6, h = (item >> 4) & 3, qt = item & 15;
    LAS bf16_t* sK = (LAS bf16_t*)lds;
    const bf16_t* KB = C.wsb(WS_KB); const bf16_t* VT = C.wsb(WS_VT); const bf16_t* HQ = C.wsb(WS_HQ); bf16_t* CA = C.wsb(WS_CA);
    const size_t q0 = (size_t)b * 2048 + qt * 128 + wid * 16;
    {   const bf16_t* gsrc = KB + ((size_t)b * 256 + (tid >> 5)) * 1024 + h * 256 + (tid & 31) * 8; LAS bf16_t* ldst = sK + (tid >> 5) * 264 + (tid & 31) * 8;
#pragma unroll 4
        for (int it = 0; it < 16; ++it) *(LAS u32x4*)(ldst + it * 16 * 264) = *(const u32x4*)(gsrc + (size_t)it * 16 * 1024); }
    bf16x8 qf[8];
#pragma unroll
    for (int k8 = 0; k8 < 8; ++k8) qf[k8] = gld8(HQ + (q0 + r) * 1024 + h * 256 + k8 * 32 + qd * 8);
    __syncthreads();
    f32x4 s[16];
#pragma unroll
    for (int mt = 0; mt < 16; ++mt) { s[mt] = (f32x4){0.f, 0.f, 0.f, 0.f};
#pragma unroll
        for (int k8 = 0; k8 < 8; ++k8) s[mt] = MFMA16(ld8(sK + (16 * mt + r) * 264 + k8 * 32 + qd * 8), qf[k8], s[mt]); }
    float mx = -3.0e38f;
#pragma unroll
    for (int mt = 0; mt < 16; ++mt)
#pragma unroll
        for (int jx = 0; jx < 4; ++jx) mx = fmaxf(mx, s[mt][jx]);
    mx = fmaxf(mx, __shfl_xor(mx, 16)); mx = fmaxf(mx, __shfl_xor(mx, 32));
    float sum = 0.f;
#pragma unroll
    for (int mt = 0; mt < 16; ++mt)
#pragma unroll
        for (int jx = 0; jx < 4; ++jx) { const float e = __expf(s[mt][jx] - mx); s[mt][jx] = e; sum += e; }
    sum += __shfl_xor(sum, 16); sum += __shfl_xor(sum, 32);
    const float inv = __builtin_amdgcn_rcpf(sum);
    bf16x8 pf[8];
#pragma unroll
    for (int k8 = 0; k8 < 8; ++k8) { u32x4 w; w.x = pk2(s[2 * k8][0] * inv, s[2 * k8][1] * inv); w.y = pk2(s[2 * k8][2] * inv, s[2 * k8][3] * inv);
        w.z = pk2(s[2 * k8 + 1][0] * inv, s[2 * k8 + 1][1] * inv); w.w = pk2(s[2 * k8 + 1][2] * inv, s[2 * k8 + 1][3] * inv);
        pf[k8] = __builtin_bit_cast(bf16x8, w); }
    __syncthreads();
    {   const bf16_t* gsrc = VT + ((size_t)b * 1024 + h * 256 + (tid >> 5)) * 256 + (tid & 31) * 8; LAS bf16_t* ldst = sK + (tid >> 5) * 264 + (tid & 31) * 8;
#pragma unroll 4
        for (int it = 0; it < 16; ++it) *(LAS u32x4*)(ldst + it * 16 * 264) = *(const u32x4*)(gsrc + (size_t)it * 16 * 256); }
    __syncthreads();
#pragma unroll
    for (int dt = 0; dt < 16; ++dt) {
        f32x4 o = {0.f, 0.f, 0.f, 0.f};
#pragma unroll
        for (int k8 = 0; k8 < 8; ++k8) {
            const LAS bf16_t* vp = sK + (16 * dt + r) * 264 + 32 * k8 + 4 * qd;
            const u32x2 lo = *(const LAS u32x2*)vp, hi = *(const LAS u32x2*)(vp + 16);
            u32x4 w; w.x = lo.x; w.y = lo.y; w.z = hi.x; w.w = hi.y;
            o = MFMA16(pf[k8], __builtin_bit_cast(bf16x8, w), o);
        }
#pragma unroll
        for (int jx = 0; jx < 4; ++jx) CA[(q0 + 4 * qd + jx) * 1024 + h * 256 + 16 * dt + r] = f2bf(o[jx]);
    }
    __syncthreads();
}

__device__ __forceinline__ void attn_sample_item(const Ctx& C, LAS unsigned char* lds, int item) {
    const int tid = threadIdx.x, lane = tid & 63, wid = tid >> 6, r = lane & 15, qd = lane >> 4;
    const int bs = item >> 1, hp = item & 1, hl = wid & 1, h = 2 * hp + hl, kq = wid >> 1;
    LAS float* sP = (LAS float*)lds;
    LAS float* sMx = sP + 2048;
    LAS float* sSm = sMx + 32;
    LAS float* sO = sSm + 32;
    const bf16_t* HQ = C.wsb(WS_HQ); const size_t r0 = (size_t)MP + bs * 4;
    const float* Kc = C.in[4] + (size_t)bs * 262144; const float* Vc = C.in[5] + (size_t)bs * 262144;
    bf16x8 qf[8];
#pragma unroll
    for (int k8 = 0; k8 < 8; ++k8) { if (r < 4) qf[k8] = gld8(HQ + (r0 + r) * 1024 + h * 256 + k8 * 32 + qd * 8); else qf[k8] = (bf16x8){0, 0, 0, 0, 0, 0, 0, 0}; }
    f32x4 s[4];
#pragma unroll
    for (int mt = 0; mt < 4; ++mt) { s[mt] = (f32x4){0.f, 0.f, 0.f, 0.f};
        const float* kp = Kc + ((size_t)(kq * 64 + 16 * mt + r) * 4 + h) * 256 + qd * 8;
#pragma unroll
        for (int k8 = 0; k8 < 8; ++k8) { const f32x4 a0 = *(const f32x4*)(kp + k8 * 32), a1 = *(const f32x4*)(kp + k8 * 32 + 4);
            u32x4 w; w.x = pk2(a0[0], a0[1]); w.y = pk2(a0[2], a0[3]); w.z = pk2(a1[0], a1[1]); w.w = pk2(a1[2], a1[3]);
            s[mt] = MFMA16(__builtin_bit_cast(bf16x8, w), qf[k8], s[mt]); } }
    float mx = -3.0e38f;
#pragma unroll
    for (int mt = 0; mt < 4; ++mt)
#pragma unroll
        for (int jx = 0; jx < 4; ++jx) mx = fmaxf(mx, s[mt][jx]);
    mx = fmaxf(mx, __shfl_xor(mx, 16)); mx = fmaxf(mx, __shfl_xor(mx, 32));
    if (lane < 4) sMx[(hl * 4 + kq) * 4 + lane] = mx;
    __syncthreads();
    const int tt = r & 3;
    const float gm = fmaxf(fmaxf(sMx[(hl * 4 + 0) * 4 + tt], sMx[(hl * 4 + 1) * 4 + tt]), fmaxf(sMx[(hl * 4 + 2) * 4 + tt], sMx[(hl * 4 + 3) * 4 + tt]));
    float sum = 0.f;
#pragma unroll
    for (int mt = 0; mt < 4; ++mt)
#pragma unroll
        for (int jx = 0; jx < 4; ++jx) { const float e = __expf(s[mt][jx] - gm); s[mt][jx] = e; sum += e; }
    sum += __shfl_xor(sum, 16); sum += __shfl_xor(sum, 32);
    if (lane < 4) sSm[(hl * 4 + kq) * 4 + lane] = sum;
    if (r < 4) {
#pragma unroll
        for (int mt = 0; mt < 4; ++mt)
#pragma unroll
            for (int jx = 0; jx < 4; ++jx) sP[(hl * 4 + r) * 256 + kq * 64 + 16 * mt + 4 * qd + jx] = s[mt][jx];
    }
    __syncthreads();
    {
        float inv[4];
#pragma unroll
        for (int t = 0; t < 4; ++t) inv[t] = __builtin_amdgcn_rcpf(sSm[(hl * 4 + 0) * 4 + t] + sSm[(hl * 4 + 1) * 4 + t] + sSm[(hl * 4 + 2) * 4 + t] + sSm[(hl * 4 + 3) * 4 + t]);
        f32x4 acc[4];
#pragma unroll
        for (int t = 0; t < 4; ++t) acc[t] = (f32x4){0.f, 0.f, 0.f, 0.f};
        const float* vp = Vc + ((size_t)(kq * 64) * 4 + h) * 256 + lane * 4;
#pragma unroll 8
        for (int m = 0; m < 64; ++m) { const f32x4 v = *(const f32x4*)(vp + (size_t)m * 1024);
#pragma unroll
            for (int t = 0; t < 4; ++t) acc[t] += v * sP[(hl * 4 + t) * 256 + kq * 64 + m]; }
#pragma unroll
        for (int t = 0; t < 4; ++t) *(LAS f32x4*)(sO + ((hl * 4 + kq) * 4 + t) * 256 + lane * 4) = acc[t] * inv[t];
    }
    __syncthreads();
    {
        const int e = tid * 4, hl2 = e >> 10, t = (e >> 8) & 3, d = e & 255;
        f32x4 o = *(const LAS f32x4*)(sO + ((hl2 * 4 + 0) * 4 + t) * 256 + d) + *(const LAS f32x4*)(sO + ((hl2 * 4 + 1) * 4 + t) * 256 + d)
                + *(const LAS f32x4*)(sO + ((hl2 * 4 + 2) * 4 + t) * 256 + d) + *(const LAS f32x4*)(sO + ((hl2 * 4 + 3) * 4 + t) * 256 + d);
        u32x2 w; w.x = pk2(o[0], o[1]); w.y = pk2(o[2], o[3]);
        *(u32x2*)(C.wsb(WS_CA) + (r0 + t) * 1024 + (2 * hp + hl2) * 256 + d) = w;
    }
    __syncthreads();
}

constexpr int NPH = 12;
__global__ void __launch_bounds__(NTHR, 2) mega(Params P) {
    extern __shared__ __attribute__((aligned(16))) unsigned char smem[];
    LAS unsigned char* lds = (LAS unsigned char*)smem;
    cg::grid_group grid = cg::this_grid();
    const Ctx& C = P;
    const int lo = P.ph_lo, hi = P.ph_hi; const int G = gridDim.x, bx = blockIdx.x;
#define IN(k) (lo <= (k) && (k) < hi)
#define SEAM(k) do { if (IN(k) && IN((k) + 1)) grid.sync(); } while (0)
    if (IN(0)) phase_prep(C, lds);
    SEAM(0);
    if (IN(1)) {
        { pg8::Gemm g{C.wsb(WS_HN), C.wsb(WS_WIN), MT, NIN, DM}; pg8::StaticOrder S; S.init(MT, NIN, G, bx);
          Epi1 E{C.Z(0), C.in[6]}; pg8::gemm_phase<Epi1, pg8::StaticOrder>(lds, g, S, E, nullptr); }
        { pg8::Gemm g{C.wsb(WS_MEMN), C.wsb(WS_WCKV), NMR, 2048, DM}; pg8::StaticOrder S; S.init(NMR, 2048, G, (bx + G - 24) % G);
          EpiMem E{C.out + OUT_MK, C.out + OUT_MV, C.wsb(WS_KB), C.wsb(WS_VT)}; pg8::gemm_phase<EpiMem, pg8::StaticOrder>(lds, g, S, E, nullptr); }
    }
    SEAM(1);
    if (IN(2)) { for (int it = bx; it < 1024; it += G) hg_intra(C, lds, it); }
    SEAM(2);
    if (IN(3)) {
        hg_scan(C);
        for (int it = bx; it < 512; it += G) gmlp_item(C, lds, it);
        for (int it = bx; it < 512; it += G) hg_sample_item(C, lds, it);
        for (int it = bx; it < 128; it += G) gmlp_sample_item(C, lds, it);
    }
    SEAM(3);
    if (IN(4)) hg_out(C);
    SEAM(4);
    if (IN(5)) { pg8::Gemm g{C.wsb(WS_O), C.wsb(WS_WOUT), MT, DM, DM}; pg8::StaticOrder S; S.init(MT, DM, G, bx);
        EpiRes E{C.in[0], C.in[1] - (size_t)MP * 1024, C.wsf(WS_X1), C.wsb(WS_XB), C.wsf(WS_SS)}; pg8::gemm_phase<EpiRes, pg8::StaticOrder>(lds, g, S, E, nullptr); }
    SEAM(5);
    if (IN(6)) { pg8::Gemm g{C.wsb(WS_XB), C.wsb(WS_WCQ), MT, DM, DM}; pg8::StaticOrder S; S.init(MT, DM, G, bx);
        EpiScale<0> E{C.wsb(WS_HQ), DM, C.wsf(WS_SS), 0.0625f}; pg8::gemm_phase<EpiScale<0>, pg8::StaticOrder>(lds, g, S, E, nullptr); }
    SEAM(6);
    if (IN(7)) {
        for (int it = bx; it < 256; it += G) attn_sample_item(C, lds, it);
        for (int it = bx; it < 512; it += G) attn_prompt_item(C, lds, it);
    }
    SEAM(7);
    if (IN(8)) { pg8::Gemm g{C.wsb(WS_CA), C.wsb(WS_WCO), MT, DM, DM}; pg8::StaticOrder S; S.init(MT, DM, G, bx);
        EpiRes E{C.wsf(WS_X1), C.wsf(WS_X1), C.wsf(WS_X1), C.wsb(WS_XB), C.wsf(WS_SS) + MT}; pg8::gemm_phase<EpiRes, pg8::StaticOrder>(lds, g, S, E, nullptr); }
    SEAM(8);
    if (IN(9)) { pg8::Gemm g{C.wsb(WS_XB), C.wsb(WS_WUP), MT, DFF, DM}; pg8::StaticOrder S; S.init(MT, DFF, G, bx);
        EpiScale<1> E{C.wsb(WS_H), DFF, C.wsf(WS_SS) + MT, 1.0f}; pg8::gemm_phase<EpiScale<1>, pg8::StaticOrder>(lds, g, S, E, nullptr); }
    SEAM(9);
    if (IN(10)) { pg8::Gemm g{C.wsb(WS_H), C.wsb(WS_WDN), MT, DM, DFF}; pg8::StaticOrder S; S.init(MT, DM, G, bx);
        EpiRes E{C.wsf(WS_X1), C.wsf(WS_X1), C.wsf(WS_X1), nullptr, C.wsf(WS_SS) + 2 * MT}; pg8::gemm_phase<EpiRes, pg8::StaticOrder>(lds, g, S, E, nullptr); }
    SEAM(10);
    if (IN(11)) {
        const float* X = C.wsf(WS_X1); const float* ss = C.wsf(WS_SS) + 2 * MT; const float* gf = C.in[24];
        for (size_t i = (size_t)bx * NTHR + threadIdx.x; i < (size_t)MT * 256; i += (size_t)G * NTHR) {
            const size_t row = i >> 8; const int c4 = (int)(i & 255) * 4;
            const float rs = rsqrtf(ss[row] * (1.0f / 1024.0f) + EPS);
            const f32x4 v = *(const f32x4*)(X + row * 1024 + c4) * rs * *(const f32x4*)(gf + c4);
            *(f32x4*)(C.out + OUT_YP + row * 1024 + c4) = v;
        }
    }
#undef IN
#undef SEAM
}

#ifndef MULTI_LAUNCH
#define MULTI_LAUNCH 0
#endif
extern "C" void kernel_launch(void* const* d_in, const int* in_sizes, int n_in, void* d_out, int out_size, void* d_ws, size_t ws_size, hipStream_t stream) {
    static int grid = 0;
    if (grid == 0) {
        int dev = 0, cus = 0, per_cu = 0;
        (void)hipGetDevice(&dev);
        (void)hipDeviceGetAttribute(&cus, hipDeviceAttributeMultiprocessorCount, dev);
        if (hipFuncSetAttribute((const void*)mega, hipFuncAttributeMaxDynamicSharedMemorySize, LDS_BYTES) != hipSuccess) fprintf(stderr, "hipFuncSetAttribute failed\n");
        if (hipOccupancyMaxActiveBlocksPerMultiprocessor(&per_cu, (const void*)mega, NTHR, LDS_BYTES) != hipSuccess || per_cu < 1) { fprintf(stderr, "occupancy query: %d\n", per_cu); per_cu = 1; }
        (void)hipGetLastError();
        grid = cus * per_cu;
        if (grid <= 0) grid = 256;
    }
    Params p{};
    for (int i = 0; i < 25; ++i) p.in[i] = (const float*)d_in[i];
    p.out = (float*)d_out; p.ws = (unsigned char*)d_ws;
#if MULTI_LAUNCH
    for (int ph = 0; ph < NPH; ++ph) { p.ph_lo = ph; p.ph_hi = ph + 1; hipLaunchKernelGGL(mega, dim3(grid), dim3(NTHR), LDS_BYTES, stream, p); }
#else
    p.ph_lo = 0; p.ph_hi = NPH;
    void* args[] = {&p};
    hipError_t e = hipLaunchCooperativeKernel((const void*)mega, dim3(grid), dim3(NTHR), args, LDS_BYTES, stream);
    if (e != hipSuccess) fprintf(stderr, "cooperative launch failed: %s (grid %d)\n", hipGetErrorString(e), grid);
#endif
}
```

```cpp
#include <hip/hip_runtime.h>
#include <hip/hip_cooperative_groups.h>
#include <cstdio>
namespace cg = cooperative_groups;
namespace pg8 {
#define PG8_LAS __attribute__((address_space(3)))
typedef unsigned short bf16_t;
typedef short bf16x8 __attribute__((ext_vector_type(8)));
typedef float f32x4 __attribute__((ext_vector_type(4)));
typedef unsigned u32x4 __attribute__((ext_vector_type(4)));
constexpr int BM = 256, BK = 64, HALF = 128, HTB = HALF * BK * 2  , STAGE_BYTES = 8 * HTB, NXCD = 8, WGM = 8;

__host__ __device__ __forceinline__ int lds_byte(int r, int c) { const int st = (r >> 4) * 2 + (c >> 5), rr = r & 15, cc = c & 31, ob = rr * 64 + cc * 2; return st * 1024 + (ob ^ (((ob >> 9) & 1) << 5)); }
__host__ __device__ __forceinline__ void stage_rc(int b, int& R, int& C) { const int st = b / 1024, sb = b % 1024, swz = sb ^ (((sb >> 9) & 1) << 5); R = (st >> 1) * 16 + swz / 64; C = (st & 1) * 32 + (swz % 64) / 2; }
__host__ __device__ __forceinline__ int perm32(int rho) { const int n = rho >> 4, i = rho & 15; return 8 * (i >> 2) + 4 * n + (i & 3); }

struct Unit { int pm, pn; };
struct Gemm { const bf16_t* A; const bf16_t* Bt; int M, N, K; };

struct StaticOrder {
    int nM, nN, nwg, G, c;
    __host__ __device__ void init(int M, int N, int G_, int c_) { nM = M / BM; nN = N / BM; nwg = nM * nN; G = G_; c = c_; }
    __host__ __device__ bool next(int i, Unit& u) const {
        const long L = (long)i * G + c; if (L >= nwg) return false;
        int wgid = (int)L; { const int q = nwg / NXCD, r = nwg % NXCD, xcd = wgid % NXCD, off = wgid / NXCD; wgid = (xcd < r ? xcd * (q + 1) : r * (q + 1) + (xcd - r) * q) + off; }
        const int nig = WGM * nN, gid = wgid / nig, fm = gid * WGM, gsz = (nM - fm) < WGM ? (nM - fm) : WGM;
        u.pm = fm + ((wgid % nig) % gsz); u.pn = (wgid % nig) / gsz; return true;
    }
    __device__ __forceinline__ void a_ready(const Unit&) const {}
    __device__ __forceinline__ void done(const Unit&) const {}
};
template <class Epi, class Sched, bool STAMP = false>
__device__ __forceinline__ void gemm_phase(PG8_LAS unsigned char* lds, const Gemm g, const Sched& S, const Epi& E, unsigned long long* stamps) {
    const int tid = threadIdx.x, wid = __builtin_amdgcn_readfirstlane(tid >> 6), lane = tid & 63, wr = wid >> 2, wc = wid & 3, fr = lane & 15, fq = lane >> 4;
    const int K = g.K, nt = K / BK;
    int ts_lo = 0, ts_hi = 0, nts = 0; const unsigned long long rt_entry = STAMP ? (unsigned long long)wall_clock64() : 0ull;
#define PG8_STAMP() do { if (STAMP && wid == 0 && nts < 64) { const unsigned long long _c = (unsigned long long)clock64(); \
        ts_lo = (lane == nts) ? (int)(unsigned)_c : ts_lo; ts_hi = (lane == nts) ? (int)(unsigned)(_c >> 32) : ts_hi; ++nts; } } while (0)
    PG8_STAMP();
    unsigned voffA[2], voffB[2];
#pragma unroll
    for (int i = 0; i < 2; ++i) { int R, C; stage_rc(tid * 16 + i * 8192, R, C); const int Rb = Epi::PERM ? ((R & ~31) + perm32(R & 31)) : R;
        voffA[i] = (unsigned)(R * K + C) * 2u; voffB[i] = (unsigned)(Rb * K + C) * 2u; }
    const size_t kstep = (size_t)(BK * 2);
    const size_t hstep = (size_t)HALF * K * 2;
    const size_t tstep = 2 * hstep;
    const unsigned ldsw = (unsigned)wid * 1024u;
    const int aoff = lds_byte(wr * 64 + fr, fq * 8), boff = lds_byte(wc * 32 + fr, fq * 8);
#define PG8_SA(b, h) (((b) * 2 + (h)) * HTB)
#define PG8_SB(b, h) ((4 + (b) * 2 + (h)) * HTB)
#define PG8_STAGE(bufoff, gbase, voff) do { _Pragma("unroll") for (int _i = 0; _i < 2; ++_i) \
        __builtin_amdgcn_global_load_lds((const unsigned*)((const char*)(gbase) + (voff)[_i]), (PG8_LAS unsigned*)(lds + (bufoff) + ldsw + _i * 8192), 16, 0, 0); } while (0)
#define PG8_LDA(dst, b, h) do { _Pragma("unroll") for (int m = 0; m < 4; ++m) _Pragma("unroll") for (int k = 0; k < 2; ++k) dst[m][k] = *(const PG8_LAS bf16x8*)(lds + PG8_SA(b, h) + aoff + m * 2048 + k * 1024); } while (0)
#define PG8_LDB(dst, b, h) do { _Pragma("unroll") for (int n = 0; n < 2; ++n) _Pragma("unroll") for (int k = 0; k < 2; ++k) dst[n][k] = *(const PG8_LAS bf16x8*)(lds + PG8_SB(b, h) + boff + n * 2048 + k * 1024); } while (0)
#define PG8_MMA(ai, bj, At, Bt) do { __builtin_amdgcn_s_setprio(1); _Pragma("unroll") for (int m = 0; m < 4; ++m) _Pragma("unroll") for (int n = 0; n < 2; ++n) _Pragma("unroll") for (int k = 0; k < 2; ++k) \
        acc[ai][bj][m][n] = __builtin_amdgcn_mfma_f32_16x16x32_bf16(Bt[n][k], At[m][k], acc[ai][bj][m][n], 0, 0, 0); __builtin_amdgcn_s_setprio(0); } while (0)
#define PG8_WAIT_V(n) asm volatile("s_waitcnt vmcnt(" #n ")" ::: "memory")
#define PG8_WAIT_L(n) asm volatile("s_waitcnt lgkmcnt(" #n ")" ::: "memory")
#define PG8_BAR __builtin_amdgcn_s_barrier()
#define PG8_SCHED __builtin_amdgcn_sched_barrier(0)
    Unit cur, nxt; int ui = 0;
    if (!S.next(0, cur)) return;
    f32x4 acc[2][2][4][2];
#pragma unroll
    for (int a = 0; a < 2; ++a)
#pragma unroll
        for (int b = 0; b < 2; ++b)
#pragma unroll
            for (int m = 0; m < 4; ++m)
#pragma unroll
                for (int n = 0; n < 2; ++n) acc[a][b][m][n] = (f32x4){0.f, 0.f, 0.f, 0.f};
    bf16x8 At[4][2], B0[2][2], B1[2][2];
    const char* cA = (const char*)g.A + (size_t)cur.pm * tstep; const char* cB = (const char*)g.Bt + (size_t)cur.pn * tstep;
    S.a_ready(cur);
    PG8_STAGE(PG8_SB(0, 0), cB, voffB); PG8_STAGE(PG8_SA(0, 0), cA, voffA); PG8_STAGE(PG8_SB(0, 1), cB + hstep, voffB); PG8_STAGE(PG8_SA(0, 1), cA + hstep, voffA);
    if (wr == 1) PG8_BAR;
    PG8_WAIT_V(4); PG8_BAR;
    PG8_STAGE(PG8_SB(1, 0), cB + kstep, voffB); PG8_STAGE(PG8_SA(1, 0), cA + kstep, voffA); PG8_STAGE(PG8_SB(1, 1), cB + hstep + kstep, voffB);
    PG8_WAIT_V(6); PG8_BAR;
    PG8_STAMP();
    for (;;) {
        const bool has_next = S.next(ui + 1, nxt);
        const char* nA = has_next ? (const char*)g.A + (size_t)nxt.pm * tstep : cA; const char* nB = has_next ? (const char*)g.Bt + (size_t)nxt.pn * tstep : cB;
        for (int t = 0; t < nt; t += 2) {
            const bool last = (t == nt - 2);
            const char* a1 = cA + (size_t)(t + 1) * kstep;
            const char* a2 = last ? nA : cA + (size_t)(t + 2) * kstep; const char* b2 = last ? nB : cB + (size_t)(t + 2) * kstep;
            const char* a3 = a2 + kstep; const char* b3 = b2 + kstep;
            if (last && has_next) S.a_ready(nxt);
            PG8_LDB(B0, 0, 0); PG8_SCHED; PG8_LDA(At, 0, 0); PG8_STAGE(PG8_SA(1, 1), a1 + hstep, voffA);
            PG8_WAIT_L(8); PG8_BAR; PG8_WAIT_L(0); PG8_MMA(0, 0, At, B0); PG8_BAR; PG8_SCHED;
            PG8_LDB(B1, 0, 1); PG8_STAGE(PG8_SB(0, 0), b2, voffB);
            PG8_BAR; PG8_WAIT_L(0); PG8_MMA(0, 1, At, B1); PG8_BAR;
            PG8_LDA(At, 0, 1); PG8_STAGE(PG8_SA(0, 0), a2, voffA);
            PG8_BAR; PG8_WAIT_L(0); PG8_MMA(1, 0, At, B0); PG8_BAR; PG8_SCHED;
            PG8_STAGE(PG8_SB(0, 1), b2 + hstep, voffB);
            PG8_WAIT_V(6); PG8_BAR; PG8_MMA(1, 1, At, B1); PG8_BAR;
            PG8_LDB(B0, 1, 0); PG8_SCHED; PG8_LDA(At, 1, 0); PG8_STAGE(PG8_SA(0, 1), a2 + hstep, voffA);
            PG8_WAIT_L(8); PG8_BAR; PG8_WAIT_L(0); PG8_MMA(0, 0, At, B0); PG8_BAR; PG8_SCHED;
            PG8_LDB(B1, 1, 1); PG8_STAGE(PG8_SB(1, 0), b3, voffB);
            PG8_BAR; PG8_WAIT_L(0); PG8_MMA(0, 1, At, B1); PG8_BAR;
            PG8_LDA(At, 1, 1); PG8_STAGE(PG8_SA(1, 0), a3, voffA);
            PG8_BAR; PG8_WAIT_L(0); PG8_MMA(1, 0, At, B0); PG8_BAR; PG8_SCHED;
            PG8_STAGE(PG8_SB(1, 1), b3 + hstep, voffB);
            PG8_WAIT_V(6); PG8_BAR; PG8_MMA(1, 1, At, B1); PG8_BAR;
        }
        PG8_STAMP();
        if constexpr (!Epi::AFTER_DRAIN) { E(acc, cur, wr, wc, fr, fq); S.done(cur); }
        PG8_STAMP();
        if (!has_next) break;
#pragma unroll
        for (int a = 0; a < 2; ++a)
#pragma unroll
            for (int b = 0; b < 2; ++b)
#pragma unroll
                for (int m = 0; m < 4; ++m)
#pragma unroll
                    for (int n = 0; n < 2; ++n) acc[a][b][m][n] = (f32x4){0.f, 0.f, 0.f, 0.f};
        cur = nxt; cA = nA; cB = nB; ++ui;
    }
    PG8_WAIT_V(0);
    if (wr == 0) PG8_BAR;
    PG8_BAR;
    if constexpr (Epi::AFTER_DRAIN) { E.fused(acc, cur, wr, wc, fr, fq, lds, wid, lane); S.done(cur); }
    PG8_STAMP();
    if (STAMP && wid == 0) { stamps[lane] = lane < nts ? (((unsigned long long)(unsigned)ts_hi << 32) | (unsigned)ts_lo) : 0ull;
        if (lane == 62) stamps[62] = rt_entry; if (lane == 63) stamps[63] = (unsigned long long)wall_clock64(); }
#undef PG8_STAMP
#undef PG8_SA
#undef PG8_SB
#undef PG8_STAGE
#undef PG8_LDA
#undef PG8_LDB
#undef PG8_MMA
#undef PG8_WAIT_V
#undef PG8_WAIT_L
#undef PG8_BAR
#undef PG8_SCHED
}
}

#define LAS __attribute__((address_space(3)))
using pg8::bf16_t; using pg8::bf16x8; using pg8::f32x4; using pg8::u32x4;
typedef unsigned u32x2 __attribute__((ext_vector_type(2)));
constexpr int DM = 1024, MP = 16384, MS = 512, MT = MP + MS, NMR = 2048, DFF = 4096, NIN = 3072;
constexpr float EPS = 1e-6f;
constexpr int NTHR = 512;
constexpr int LDS_BYTES = 144 * 1024;
constexpr size_t MB = 1024 * 1024;
constexpr size_t WS_WIN = 0, WS_WOUT = 6 * MB, WS_WCQ = 8 * MB, WS_WCKV = 10 * MB, WS_WCO = 14 * MB, WS_WUP = 16 * MB, WS_WDN = 24 * MB;
constexpr size_t WS_HN = 32 * MB;
constexpr size_t SZ_ROWB = (size_t)MT * DM * 2;
constexpr size_t WS_Z = WS_HN + SZ_ROWB;
constexpr size_t ZSZ = (size_t)MT * 512;
constexpr size_t WS_H = WS_HN;
constexpr size_t WS_C = WS_Z + 8 * ZSZ * 2;
constexpr size_t WS_MEMN = WS_C, WS_KB = WS_C + 4 * MB, WS_VT = WS_C + 8 * MB;
constexpr size_t WS_D = WS_C + 12 * MB;
constexpr size_t WS_DS = WS_D, WS_SC = WS_D + 32 * MB, WS_OI = WS_D + 64 * MB, WS_DEC = WS_D + 80 * MB;
constexpr size_t WS_HQ = WS_D, WS_CA = WS_D + 36 * MB;
constexpr size_t WS_E = WS_D + 81 * MB;
constexpr size_t WS_O = WS_E, WS_X1 = WS_O + SZ_ROWB, WS_XB = WS_X1 + 2 * SZ_ROWB, WS_SS = WS_XB + SZ_ROWB, WS_END = WS_SS + 3 * MT * 4;
static_assert(SZ_ROWB * 4 >= (size_t)MT * DFF * 2 && WS_END < 512 * MB, "workspace map");
constexpr size_t OUT_YP = 0, OUT_YS = 16777216, OUT_SP = 17301504, OUT_SSMP = 17825792, OUT_MK = 26214400, OUT_MV = 28311552, OUT_CMV = 30408704;

struct Params { const float* in[25]; float* out; unsigned char* ws; int ph_lo, ph_hi;
    __device__ __forceinline__ bf16_t* wsb(size_t off) const { return (bf16_t*)(ws + off); }
    __device__ __forceinline__ float* wsf(size_t off) const { return (float*)(ws + off); }
    __device__ __forceinline__ bf16_t* Z(int a) const { return (bf16_t*)(ws + WS_Z) + (size_t)a * ZSZ; }
};
typedef Params Ctx;


__device__ __forceinline__ float bf2f(bf16_t b) { return __uint_as_float(((unsigned)b) << 16); }
typedef float f32x2c __attribute__((ext_vector_type(2)));
typedef __bf16 bf16x2c __attribute__((ext_vector_type(2)));
__device__ __forceinline__ unsigned pk2(float lo, float hi) { const f32x2c v = {lo, hi}; const bf16x2c b = __builtin_convertvector(v, bf16x2c); return __builtin_bit_cast(unsigned, b); }
__device__ __forceinline__ bf16_t f2bf(float f) { return (bf16_t)(pk2(f, f) & 0xffffu); }
__device__ __forceinline__ float sigm(float x) { return __builtin_amdgcn_rcpf(1.0f + __expf(-x)); }
__device__ __forceinline__ float bflo(unsigned w) { return __uint_as_float(w << 16); }
__device__ __forceinline__ float bfhi(unsigned w) { return __uint_as_float(w & 0xffff0000u); }

struct Epi1 {
    static constexpr bool PERM = true, AFTER_DRAIN = false;
    bf16_t* Zb; const float* lbp;
    __device__ __forceinline__ void operator()(const f32x4 (&acc)[2][2][4][2], const pg8::Unit& u, int wr, int wc, int fr, int fq) const {
        const int sec = u.pn >> 1;
        const int row0 = u.pm * 256 + wr * 64 + fr;
        const int cs0 = (u.pn & 1) * 256 + wc * 32 + 8 * fq;
        if (sec == 1) {
            bf16_t* Zk = Zb + ZSZ; bf16_t* Zl = Zb + 2 * ZSZ;
            f32x4 pp[2][4];
#pragma unroll
            for (int bj = 0; bj < 2; ++bj) { const int cs = cs0 + bj * 128; pp[bj][0] = *(const f32x4*)(lbp + cs); pp[bj][1] = *(const f32x4*)(lbp + cs + 4); pp[bj][2] = *(const f32x4*)(lbp + 512 + cs); pp[bj][3] = *(const f32x4*)(lbp + 512 + cs + 4); }
#pragma unroll
            for (int bj = 0; bj < 2; ++bj) {
                const int cs = cs0 + bj * 128;
                const f32x4 p0a = pp[bj][0], p0b = pp[bj][1], p1a = pp[bj][2], p1b = pp[bj][3];
                float lb[8];
#pragma unroll
                for (int j = 0; j < 4; ++j) { lb[j] = sigm(p0a[j] - p1a[j]); lb[4 + j] = sigm(p0b[j] - p1b[j]); }
#pragma unroll
                for (int ai = 0; ai < 2; ++ai)
#pragma unroll
                    for (int m = 0; m < 4; ++m) {
                        const size_t o = (size_t)(row0 + ai * 128 + m * 16) * 512 + cs;
                        float kk[8], lf[8];
#pragma unroll
                        for (int j = 0; j < 8; ++j) { const float z = (j < 4) ? acc[ai][bj][m][0][j] : acc[ai][bj][m][1][j - 4];
                            const float sg = sigm(z), oml = 1.0f - lb[j]; kk[j] = oml * (1.0f - sg); lf[j] = __logf(lb[j] + oml * sg); }
                        u32x4 w; w.x = pk2(kk[0], kk[1]); w.y = pk2(kk[2], kk[3]); w.z = pk2(kk[4], kk[5]); w.w = pk2(kk[6], kk[7]);
                        *(u32x4*)(Zk + o) = w;
                        w.x = pk2(lf[0], lf[1]); w.y = pk2(lf[2], lf[3]); w.z = pk2(lf[4], lf[5]); w.w = pk2(lf[6], lf[7]);
                        *(u32x4*)(Zl + o) = w;
                    }
            }
        } else {
            bf16_t* Zo = Zb + (size_t)(sec == 0 ? 0 : sec + 1) * ZSZ;
#pragma unroll
            for (int bj = 0; bj < 2; ++bj) {
                const int cs = cs0 + bj * 128;
#pragma unroll
                for (int ai = 0; ai < 2; ++ai)
#pragma unroll
                    for (int m = 0; m < 4; ++m) {
                        const size_t o = (size_t)(row0 + ai * 128 + m * 16) * 512 + cs;
                        float r[8];
#pragma unroll
                        for (int j = 0; j < 8; ++j) { const float z = (j < 4) ? acc[ai][bj][m][0][j] : acc[ai][bj][m][1][j - 4];
                            const float t = (sec >= 4) ? 1.5957691216f * (z + 0.044715f * z * z * z) : z;
                            const float sg = sigm(t);
                            r[j] = (sec == 2) ? z : ((sec == 3) ? sg : z * sg); }
                        u32x4 w; w.x = pk2(r[0], r[1]); w.y = pk2(r[2], r[3]); w.z = pk2(r[4], r[5]); w.w = pk2(r[6], r[7]);
                        *(u32x4*)(Zo + o) = w;
                    }
            }
        }
    }
};

struct EpiMem {
    static constexpr bool PERM = false, AFTER_DRAIN = false;
    float* outK; float* outV; bf16_t* KB; bf16_t* VT;
    __device__ __forceinline__ void operator()(const f32x4 (&acc)[2][2][4][2], const pg8::Unit& u, int wr, int wc, int fr, int fq) const {
        const int row0 = u.pm * 256 + wr * 64 + fr;
        const bool isV = u.pn >= 4;
        const int col0 = (u.pn & 3) * 256 + wc * 32 + 4 * fq;
        float* outp = isV ? outV : outK;
#pragma unroll
        for (int ai = 0; ai < 2; ++ai)
#pragma unroll
            for (int m = 0; m < 4; ++m) {
                const int row = row0 + ai * 128 + m * 16;
#pragma unroll
                for (int bj = 0; bj < 2; ++bj)
#pragma unroll
                    for (int n = 0; n < 2; ++n) {
                        const int c = col0 + bj * 128 + n * 16; const f32x4 v = acc[ai][bj][m][n];
                        *(f32x4*)(outp + (size_t)row * 1024 + c) = v;
                        if (!isV) { u32x2 w; w.x = pk2(v[0], v[1]); w.y = pk2(v[2], v[3]); *(u32x2*)(KB + (size_t)row * 1024 + c) = w; }
                        else { const int b = row >> 8, mm = row & 255;
#pragma unroll
                            for (int j = 0; j < 4; ++j) VT[((size_t)b * 1024 + c + j) * 256 + mm] = f2bf(v[j]); }
                    }
            }
    }
};

template <bool RB> struct EpiRes {
    static constexpr bool PERM = false, AFTER_DRAIN = false;
    const float* resf; bf16_t* xb; float* ss;
    __device__ __forceinline__ void operator()(const f32x4 (&acc)[2][2][4][2], const pg8::Unit& u, int wr, int wc, int fr, int fq) const {
        const int row0 = u.pm * 256 + wr * 64 + fr, col0 = u.pn * 256 + wc * 32 + 4 * fq;
#pragma unroll
        for (int ai = 0; ai < 2; ++ai) {
            f32x4 rv[4][2][2];
#pragma unroll
            for (int m = 0; m < 4; ++m)
#pragma unroll
                for (int bj = 0; bj < 2; ++bj)
#pragma unroll
                    for (int n = 0; n < 2; ++n) { const size_t oo = (size_t)(row0 + ai * 128 + m * 16) * 1024 + col0 + bj * 128 + n * 16;
                        if (RB) { const u32x2 rr = *(const u32x2*)(xb + oo); rv[m][bj][n] = (f32x4){bflo(rr.x), bfhi(rr.x), bflo(rr.y), bfhi(rr.y)}; }
                        else rv[m][bj][n] = *(const f32x4*)(resf + oo); }
#pragma unroll
            for (int m = 0; m < 4; ++m) {
                const int row = row0 + ai * 128 + m * 16; const size_t o = (size_t)row * 1024 + col0; float s = 0.f;
#pragma unroll
                for (int bj = 0; bj < 2; ++bj)
#pragma unroll
                    for (int n = 0; n < 2; ++n) {
                        const size_t oo = o + bj * 128 + n * 16; const f32x4 v = rv[m][bj][n] + acc[ai][bj][m][n];
                        u32x2 w; w.x = pk2(v[0], v[1]); w.y = pk2(v[2], v[3]); *(u32x2*)(xb + oo) = w;
                        s += (v[0] * v[0] + v[1] * v[1]) + (v[2] * v[2] + v[3] * v[3]);
                    }
                s += __shfl_xor(s, 16); s += __shfl_xor(s, 32);
                if (fq == 0) atomicAdd(ss + row, s);
            }
        }
    }
};

template <int ACT> struct EpiScale {
    static constexpr bool PERM = true, AFTER_DRAIN = false;
    bf16_t* O; int ldc; const float* ss; float scale;
    __device__ __forceinline__ void operator()(const f32x4 (&acc)[2][2][4][2], const pg8::Unit& u, int wr, int wc, int fr, int fq) const {
        const int row0 = u.pm * 256 + wr * 64 + fr, col0 = u.pn * 256 + wc * 32 + 8 * fq;
        float ssv[2][4];
#pragma unroll
        for (int ai = 0; ai < 2; ++ai)
#pragma unroll
            for (int m = 0; m < 4; ++m) ssv[ai][m] = ss[row0 + ai * 128 + m * 16];
#pragma unroll
        for (int ai = 0; ai < 2; ++ai)
#pragma unroll
            for (int m = 0; m < 4; ++m) {
                const int row = row0 + ai * 128 + m * 16;
                const float rs = rsqrtf(ssv[ai][m] * (1.0f / 1024.0f) + EPS) * scale;
                bf16_t* rowp = O + (size_t)row * ldc + col0;
#pragma unroll
                for (int bj = 0; bj < 2; ++bj) {
                    f32x4 v0 = acc[ai][bj][m][0] * rs, v1 = acc[ai][bj][m][1] * rs;
                    if (ACT == 1) {
#pragma unroll
                        for (int j = 0; j < 4; ++j) { const float a = fmaxf(v0[j], 0.f), b = fmaxf(v1[j], 0.f); v0[j] = a * a; v1[j] = b * b; } }
                    u32x4 w; w.x = pk2(v0[0], v0[1]); w.y = pk2(v0[2], v0[3]); w.z = pk2(v1[0], v1[1]); w.w = pk2(v1[2], v1[3]);
                    *(u32x4*)(rowp + bj * 128) = w;
                }
            }
    }
};

struct WDesc { const float* W; const float* gain; bf16_t* Wt; int K, N, t; };
__device__ __forceinline__ WDesc wdesc(const Ctx& C, int t) {
    WDesc d;
    if (t < 768) d = WDesc{C.in[8], nullptr, C.wsb(WS_WIN), 1024, 3072, t};
    else if (t < 1024) d = WDesc{C.in[14], nullptr, C.wsb(WS_WOUT), 1024, 1024, t - 768};
    else if (t < 1280) d = WDesc{C.in[17], C.in[15], C.wsb(WS_WCQ), 1024, 1024, t - 1024};
    else if (t < 1536) d = WDesc{C.in[18], nullptr, C.wsb(WS_WCKV), 1024, 1024, t - 1280};
    else if (t < 1792) d = WDesc{C.in[19], nullptr, C.wsb(WS_WCKV) + 1024 * 1024, 1024, 1024, t - 1536};
    else if (t < 2048) d = WDesc{C.in[20], nullptr, C.wsb(WS_WCO), 1024, 1024, t - 1792};
    else if (t < 3072) d = WDesc{C.in[22], C.in[21], C.wsb(WS_WUP), 1024, 4096, t - 2048};
    else d = WDesc{C.in[23], nullptr, C.wsb(WS_WDN), 4096, 1024, t - 3072};
    return d;
}
__device__ __forceinline__ void cvt_load(const WDesc& d, f32x4 (&v)[2], float (&gq)[2]) {
    const int tid = threadIdx.x; const int ntn = d.N >> 6; const int kt = d.t / ntn, nt = d.t - kt * ntn; const int k0 = kt * 64, n0 = nt * 64;
#pragma unroll
    for (int p = 0; p < 2; ++p) { const int k = p * 32 + (tid >> 4), n4 = (tid & 15) * 4;
        v[p] = *(const f32x4*)(d.W + (size_t)(k0 + k) * d.N + n0 + n4); gq[p] = d.gain ? d.gain[k0 + k] : 1.0f; }
}
__device__ __forceinline__ void cvt_store(const WDesc& d, const f32x4 (&v)[2], const float (&gq)[2], LAS float* tl) {
    const int tid = threadIdx.x; const int ntn = d.N >> 6; const int kt = d.t / ntn, nt = d.t - kt * ntn; const int k0 = kt * 64, n0 = nt * 64;
#pragma unroll
    for (int p = 0; p < 2; ++p) { const int k = p * 32 + (tid >> 4), n4 = (tid & 15) * 4; const f32x4 x = v[p] * gq[p];
        tl[k * 65 + n4 + 0] = x[0]; tl[k * 65 + n4 + 1] = x[1]; tl[k * 65 + n4 + 2] = x[2]; tl[k * 65 + n4 + 3] = x[3]; }
    __syncthreads();
    {
        const int n = tid >> 3, k8 = (tid & 7) * 8; float r[8];
#pragma unroll
        for (int j = 0; j < 8; ++j) r[j] = tl[(k8 + j) * 65 + n];
        u32x4 w; w.x = pk2(r[0], r[1]); w.y = pk2(r[2], r[3]); w.z = pk2(r[4], r[5]); w.w = pk2(r[6], r[7]);
        *(u32x4*)(d.Wt + (size_t)(n0 + n) * d.K + k0 + k8) = w;
    }
    __syncthreads();
}

__device__ __forceinline__ void phase_prep(const Ctx& C, LAS unsigned char* lds) {
    const int tid = threadIdx.x, lane = tid & 63, wid = tid >> 6;
    LAS float* tl = (LAS float*)lds;
    {
        int t = blockIdx.x; WDesc d = wdesc(C, t < 4096 ? t : 0); f32x4 v[2]; float gq[2];
        if (t < 4096) cvt_load(d, v, gq);
        for (; t < 4096; t += gridDim.x) {
            const int tn = t + gridDim.x; WDesc dn = wdesc(C, tn < 4096 ? tn : 0); f32x4 vn[2]; float gn[2];
            if (tn < 4096) cvt_load(dn, vn, gn); else { vn[0] = v[0]; vn[1] = v[1]; gn[0] = gq[0]; gn[1] = gq[1]; }
            cvt_store(d, v, gq, tl);
            d = dn; v[0] = vn[0]; v[1] = vn[1]; gq[0] = gn[0]; gq[1] = gn[1];
        }
    }
    {
        const int NR = MT + NMR, stride = gridDim.x * 8; int r = blockIdx.x * 8 + wid;
        f32x4 v[4];
#define ROWSRC(rr) ((rr) < MP ? C.in[0] + (size_t)(rr) * 1024 : ((rr) < MT ? C.in[1] + (size_t)((rr) - MP) * 1024 : C.in[2] + (size_t)((rr) - MT) * 1024))
        if (r < NR) { const float* src = ROWSRC(r);
#pragma unroll
            for (int i = 0; i < 4; ++i) v[i] = *(const f32x4*)(src + i * 256 + lane * 4); }
        for (; r < NR; r += stride) {
            const int rn = r + stride; f32x4 vn[4];
            if (rn < NR) { const float* src = ROWSRC(rn);
#pragma unroll
                for (int i = 0; i < 4; ++i) vn[i] = *(const f32x4*)(src + i * 256 + lane * 4); }
            else {
#pragma unroll
                for (int i = 0; i < 4; ++i) vn[i] = v[i]; }
            const float* g = (r < MT) ? C.in[7] : C.in[16]; bf16_t* dst = (r < MT) ? C.wsb(WS_HN) + (size_t)r * 1024 : C.wsb(WS_MEMN) + (size_t)(r - MT) * 1024;
            f32x4 gg[4];
#pragma unroll
            for (int i = 0; i < 4; ++i) gg[i] = *(const f32x4*)(g + i * 256 + lane * 4);
            float s = 0.f;
#pragma unroll
            for (int i = 0; i < 4; ++i) s += (v[i][0] * v[i][0] + v[i][1] * v[i][1]) + (v[i][2] * v[i][2] + v[i][3] * v[i][3]);
#pragma unroll
            for (int o = 32; o >= 1; o >>= 1) s += __shfl_xor(s, o);
            const float rs = rsqrtf(s * (1.0f / 1024.0f) + EPS);
#pragma unroll
            for (int i = 0; i < 4; ++i) { const f32x4 y = v[i] * rs * gg[i]; u32x2 w; w.x = pk2(y[0], y[1]); w.y = pk2(y[2], y[3]); *(u32x2*)(dst + i * 256 + lane * 4) = w; }
#pragma unroll
            for (int i = 0; i < 4; ++i) v[i] = vn[i];
        }
#undef ROWSRC
    }
    float* ss = C.wsf(WS_SS);
    for (int i = blockIdx.x * NTHR + tid; i < 3 * MT; i += gridDim.x * NTHR) ss[i] = 0.f;
}

__device__ __forceinline__ bf16x8 ld8(const LAS bf16_t* p) { return *(const LAS bf16x8*)p; }
__device__ __forceinline__ bf16x8 gld8(const bf16_t* p) { return *(const bf16x8*)p; }
#define MFMA16(a, b, c) __builtin_amdgcn_mfma_f32_16x16x32_bf16((a), (b), (c), 0, 0, 0)

__device__ __forceinline__ void hg_load(const Ctx& C, int item, unsigned (&rq)[16], unsigned (&rk)[16], unsigned (&rl)[16], unsigned (&rv)[16]) {
    const int tid = threadIdx.x; const int b = item >> 7, c = (item >> 2) & 31, h = item & 3; const int k = tid & 127, i = tid >> 7;
    const size_t o = ((size_t)b * 2048 + c * 64 + 16 * i) * 512 + h * 128 + k;
    const bf16_t* pq = C.Z(0) + o; const bf16_t* pk = C.Z(1) + o; const bf16_t* pl = C.Z(2) + o; const bf16_t* pv = C.Z(3) + o;
#pragma unroll
    for (int t = 0; t < 16; ++t) { rq[t] = pq[t * 512]; rk[t] = pk[t * 512]; rl[t] = pl[t * 512]; rv[t] = pv[t * 512]; }
}
__device__ __forceinline__ void hg_intra(const Ctx& C, LAS unsigned char* lds, int item, int next_item, unsigned (&rq)[16], unsigned (&rk)[16], unsigned (&rl)[16], unsigned (&rv)[16]) {
    const int tid = threadIdx.x, lane = tid & 63, wid = tid >> 6, r = lane & 15, qd = lane >> 4;
    const int b = item >> 7, c = (item >> 2) & 31, h = item & 3;
    const size_t row0 = (size_t)b * 2048 + c * 64; const int hc = h * 128;
    LAS bf16_t* sQV = (LAS bf16_t*)lds;
    LAS bf16_t* sKE = sQV + 7 * 2176;
    LAS bf16_t* sKD = sKE + 3 * 2176;
    LAS bf16_t* sKT = sKD + 4 * 2176;
    LAS bf16_t* sVT = sKT + 128 * 72;
    LAS bf16_t* sA = sVT + 128 * 72;
    LAS float* sTot = (LAS float*)(sA + 64 * 72);
    const int k = tid & 127, i = tid >> 7;
    float q[16], kk[16], bl[16];
    {
        float lf[16]; unsigned vv[16];
#pragma unroll
        for (int t = 0; t < 16; ++t) { q[t] = __uint_as_float(rq[t] << 16); kk[t] = __uint_as_float(rk[t] << 16); lf[t] = __uint_as_float(rl[t] << 16); vv[t] = rv[t]; }
        if (next_item < 1024) hg_load(C, next_item, rq, rk, rl, rv);
        float cum = 0.f;
#pragma unroll
        for (int t = 0; t < 16; ++t) { cum += lf[t]; bl[t] = cum; }
        sTot[i * 128 + k] = cum;
        u32x4 w0, w1;
        w0.x = vv[0] | (vv[1] << 16); w0.y = vv[2] | (vv[3] << 16); w0.z = vv[4] | (vv[5] << 16); w0.w = vv[6] | (vv[7] << 16);
        w1.x = vv[8] | (vv[9] << 16); w1.y = vv[10] | (vv[11] << 16); w1.z = vv[12] | (vv[13] << 16); w1.w = vv[14] | (vv[15] << 16);
        *(LAS u32x4*)(sVT + k * 72 + 16 * i) = w0; *(LAS u32x4*)(sVT + k * 72 + 16 * i + 8) = w1;
    }
    __syncthreads();
    {
        const float t0 = sTot[k], t1 = sTot[128 + k], t2 = sTot[256 + k], t3 = sTot[384 + k];
        const float bend0 = t0, bend1 = t0 + t1, bend2 = bend1 + t2, blast = bend2 + t3;
        const float bstart = (i == 0) ? 0.f : ((i == 1) ? bend0 : ((i == 2) ? bend1 : bend2));
        const float cum = bl[15];
        const float cE = __expf(bstart), c0 = __expf(bstart - bend0), c1 = __expf(bstart - bend1), cdec = __expf(blast - (bstart + cum));
        const int idD = (i == 0) ? 0 : (1 + ((i - 1) * i) / 2 + (i - 1));
        const int id0 = 1 + ((i - 1) * i) / 2;
        bf16_t* pqe = C.Z(7) + (row0 + 16 * i) * 512 + hc + k;
        unsigned kd16[16];
#pragma unroll
        for (int t = 0; t < 16; ++t) {
            const float e = __expf(bl[t]), ei = __expf(-bl[t]), ek = __expf(cum - bl[t]);
            const float qdv = q[t] * e, kdv = kk[t] * ei, kev = kk[t] * ek;
            sQV[(idD * 16 + t) * 136 + k] = f2bf(qdv);
            if (i >= 2) sQV[(id0 * 16 + t) * 136 + k] = f2bf(qdv * c0);
            if (i == 3) sQV[(5 * 16 + t) * 136 + k] = f2bf(qdv * c1);
            sKD[(i * 16 + t) * 136 + k] = f2bf(kdv);
            if (i < 3) sKE[(i * 16 + t) * 136 + k] = f2bf(kev);
            kd16[t] = f2bf(kev * cdec);
            pqe[t * 512] = f2bf(qdv * cE);
        }
        u32x4 w0, w1;
        w0.x = kd16[0] | (kd16[1] << 16); w0.y = kd16[2] | (kd16[3] << 16); w0.z = kd16[4] | (kd16[5] << 16); w0.w = kd16[6] | (kd16[7] << 16);
        w1.x = kd16[8] | (kd16[9] << 16); w1.y = kd16[10] | (kd16[11] << 16); w1.z = kd16[12] | (kd16[13] << 16); w1.w = kd16[14] | (kd16[15] << 16);
        *(LAS u32x4*)(sKT + k * 72 + 16 * i) = w0; *(LAS u32x4*)(sKT + k * 72 + 16 * i + 8) = w1;
        if (i == 0) C.wsf(WS_DEC)[(size_t)item * 128 + k] = __expf(blast);
    }
    __syncthreads();
#pragma unroll
    for (int x = 0; x < 2; ++x) {
        const int tile = wid * 2 + x, ti = tile >> 2, tj = tile & 3;
        f32x4 d = {0.f, 0.f, 0.f, 0.f};
        if (tj <= ti) {
            const int ida = (ti == 0) ? 0 : (1 + ((ti - 1) * ti) / 2 + ((tj == ti) ? ti - 1 : tj));
            const LAS bf16_t* Aop = sQV + ida * 2176 + r * 136 + qd * 8;
            const LAS bf16_t* Bop = ((tj == ti) ? (sKD + ti * 2176) : (sKE + tj * 2176)) + r * 136 + qd * 8;
#pragma unroll
            for (int k4 = 0; k4 < 4; ++k4) d = MFMA16(ld8(Aop + k4 * 32), ld8(Bop + k4 * 32), d);
        }
#pragma unroll
        for (int jx = 0; jx < 4; ++jx) { const int t = 4 * qd + jx; const bool keep = (tj < ti) || (tj == ti && r <= t);
            sA[(16 * ti + t) * 72 + 16 * tj + r] = f2bf(keep ? d[jx] : 0.f); }
    }
    __syncthreads();
    {
        bf16_t* OI = C.wsb(WS_OI); bf16_t* DS = C.wsb(WS_DS) + (size_t)item * 16384;
        const bf16x8 v0 = ld8(sVT + (16 * wid + r) * 72 + qd * 8), v1 = ld8(sVT + (16 * wid + r) * 72 + 32 + qd * 8);
#pragma unroll
        for (int ti = 0; ti < 4; ++ti) {
            f32x4 d = {0.f, 0.f, 0.f, 0.f};
            d = MFMA16(v0, ld8(sA + (16 * ti + r) * 72 + qd * 8), d);
            d = MFMA16(v1, ld8(sA + (16 * ti + r) * 72 + 32 + qd * 8), d);
            u32x2 w; w.x = pk2(d[0], d[1]); w.y = pk2(d[2], d[3]);
            *(u32x2*)(OI + (row0 + 16 * ti + r) * 512 + hc + 16 * wid + 4 * qd) = w;
        }
#pragma unroll
        for (int kt = 0; kt < 8; ++kt) {
            f32x4 d = {0.f, 0.f, 0.f, 0.f};
            d = MFMA16(ld8(sKT + (16 * kt + r) * 72 + qd * 8), v0, d);
            d = MFMA16(ld8(sKT + (16 * kt + r) * 72 + 32 + qd * 8), v1, d);
            u32x2 w; w.x = pk2(d[0], d[1]); w.y = pk2(d[2], d[3]);
            *(u32x2*)(DS + (16 * wid + r) * 128 + 16 * kt + 4 * qd) = w;
        }
    }
    __syncthreads();
}

__device__ __forceinline__ void hg_scan(const Ctx& C) {
    const bf16_t* __restrict__ DS = C.wsb(WS_DS); bf16_t* __restrict__ SC = C.wsb(WS_SC); const float* __restrict__ DEC = C.wsf(WS_DEC);
    float* __restrict__ outS = C.out + OUT_SP;
    for (int g = blockIdx.x * NTHR + threadIdx.x; g < 32 * 4096; g += gridDim.x * NTHR) {
        const int bh = g >> 12, e = g & 4095, v = e >> 5, k4 = (e & 31) * 4, b = bh >> 2, h = bh & 3;
        float S0 = 0.f, S1 = 0.f, S2 = 0.f, S3 = 0.f;
#pragma unroll 16
        for (int c = 0; c < 32; ++c) {
            const int item = b * 128 + c * 4 + h; const size_t off = (size_t)item * 16384 + v * 128 + k4;
            u32x2 w; w.x = pk2(S0, S1); w.y = pk2(S2, S3); *(u32x2*)(SC + off) = w;
            const f32x4 dc = *(const f32x4*)(DEC + (size_t)item * 128 + k4); const u32x2 ds = *(const u32x2*)(DS + off);
            S0 = dc[0] * S0 + bflo(ds.x); S1 = dc[1] * S1 + bfhi(ds.x); S2 = dc[2] * S2 + bflo(ds.y); S3 = dc[3] * S3 + bfhi(ds.y);
        }
        float* o = outS + ((size_t)(b * 4 + h) * 128 + k4) * 128 + v;
        o[0] = S0; o[128] = S1; o[256] = S2; o[384] = S3;
    }
}

__device__ __forceinline__ void gmlp_item(const Ctx& C, LAS unsigned char* lds, int item) {
    const int tid = threadIdx.x, lane = tid & 63, wid = tid >> 6, r = lane & 15, qd = lane >> 4;
    const int n = item >> 2, g = item & 3; const size_t rb = (size_t)n * 128;
    LAS bf16_t* sW = (LAS bf16_t*)lds;
    LAS bf16_t* sVN = sW + 128 * 136;
    LAS float* sSt = (LAS float*)(sVN + 128 * 136);
    const bf16_t* Zgv = C.Z(6); const bf16_t* Zu = C.Z(5);
    u32x4 gvt[4]; u32x2 uu8[8]; float bb8[8];
#pragma unroll
    for (int it = 0; it < 4; ++it) { const int e = it * NTHR + tid; gvt[it] = *(const u32x4*)(Zgv + (rb + (e >> 4)) * 512 + g * 128 + (e & 15) * 8); }
#pragma unroll
    for (int ti = 0; ti < 8; ++ti) { uu8[ti] = *(const u32x2*)(Zu + (rb + 16 * ti + r) * 512 + g * 128 + 16 * wid + 4 * qd); bb8[ti] = C.in[13][g * 128 + 16 * ti + r]; }
    {
        const int row = tid >> 2, qt = tid & 3; const bf16_t* p = Zgv + (rb + row) * 512 + qt * 128;
        float s = 0.f, s2 = 0.f;
#pragma unroll
        for (int i = 0; i < 16; ++i) { const u32x4 w = *(const u32x4*)(p + i * 8);
#pragma unroll
            for (int j = 0; j < 4; ++j) { const float a = bflo(w[j]), bb = bfhi(w[j]); s += a + bb; s2 += a * a + bb * bb; } }
        s += __shfl_xor(s, 1); s2 += __shfl_xor(s2, 1); s += __shfl_xor(s, 2); s2 += __shfl_xor(s2, 2);
        const float mean = s * (1.0f / 512.0f), var = fmaxf(s2 * (1.0f / 512.0f) - mean * mean, 0.f);
        if (qt == 0) { sSt[row * 2] = mean; sSt[row * 2 + 1] = rsqrtf(var + EPS); }
    }
    {
        const float* W = C.in[12] + (size_t)g * 16384;
#pragma unroll
        for (int it = 0; it < 8; ++it) { const int e = (it * NTHR + tid) * 4, t = e >> 7, s = e & 127; const f32x4 v = *(const f32x4*)(W + e);
            u32x2 w; w.x = pk2(s <= t ? v[0] : 0.f, s + 1 <= t ? v[1] : 0.f); w.y = pk2(s + 2 <= t ? v[2] : 0.f, s + 3 <= t ? v[3] : 0.f);
            *(LAS u32x2*)(sW + t * 136 + s) = w; }
    }
    __syncthreads();
    {
        const float* lgp = C.in[10] + g * 128; const float* lbp2 = C.in[11] + g * 128;
#pragma unroll
        for (int it = 0; it < 4; ++it) { const int e = it * NTHR + tid, sx = e >> 4, c8 = (e & 15) * 8;
            const u32x4 w = gvt[it]; const float mean = sSt[sx * 2], rs = sSt[sx * 2 + 1];
            const f32x4 g0 = *(const f32x4*)(lgp + c8), g1 = *(const f32x4*)(lgp + c8 + 4), b0 = *(const f32x4*)(lbp2 + c8), b1 = *(const f32x4*)(lbp2 + c8 + 4);
            u32x4 o;
            o.x = pk2((bflo(w.x) - mean) * rs * g0[0] + b0[0], (bfhi(w.x) - mean) * rs * g0[1] + b0[1]);
            o.y = pk2((bflo(w.y) - mean) * rs * g0[2] + b0[2], (bfhi(w.y) - mean) * rs * g0[3] + b0[3]);
            o.z = pk2((bflo(w.z) - mean) * rs * g1[0] + b1[0], (bfhi(w.z) - mean) * rs * g1[1] + b1[1]);
            o.w = pk2((bflo(w.w) - mean) * rs * g1[2] + b1[2], (bfhi(w.w) - mean) * rs * g1[3] + b1[3]);
            *(LAS u32x4*)(sVN + sx * 136 + c8) = o; }
    }
    __syncthreads();
    {
        bf16_t* O = C.wsb(WS_O);
        bf16x8 bfr[4];
#pragma unroll
        for (int k4 = 0; k4 < 4; ++k4) { unsigned x[8];
#pragma unroll
            for (int j = 0; j < 8; ++j) x[j] = sVN[(k4 * 32 + qd * 8 + j) * 136 + 16 * wid + r];
            u32x4 w; w.x = x[0] | (x[1] << 16); w.y = x[2] | (x[3] << 16); w.z = x[4] | (x[5] << 16); w.w = x[6] | (x[7] << 16);
            bfr[k4] = __builtin_bit_cast(bf16x8, w); }
#pragma unroll
        for (int ti = 0; ti < 8; ++ti) {
            f32x4 d = {0.f, 0.f, 0.f, 0.f};
#pragma unroll
            for (int k4 = 0; k4 < 4; ++k4) if (k4 <= (ti >> 1)) d = MFMA16(bfr[k4], ld8(sW + (16 * ti + r) * 136 + k4 * 32 + qd * 8), d);
            const int t = 16 * ti + r, cc = g * 128 + 16 * wid + 4 * qd; const float bb = bb8[ti];
            const u32x2 uu = uu8[ti];
            u32x2 w; w.x = pk2(bflo(uu.x) * (d[0] + bb), bfhi(uu.x) * (d[1] + bb)); w.y = pk2(bflo(uu.y) * (d[2] + bb), bfhi(uu.y) * (d[3] + bb));
            *(u32x2*)(O + (rb + t) * 1024 + 512 + cc) = w;
        }
    }
    __syncthreads();
}

__device__ __forceinline__ void hg_sample_item(const Ctx& C, LAS unsigned char* lds, int item) {
    const int tid = threadIdx.x, lane = tid & 63, wid = tid >> 6;
    const int bs = item >> 2, h = item & 3, hc = h * 128; const size_t r0 = (size_t)MP + bs * 4;
    LAS float* sq = (LAS float*)lds; LAS float* sk = sq + 512; LAS float* sf = sk + 512;
    LAS float* sp = sf + 512;
    LAS float* sred = sp + 2048;
    {
        const int t = tid >> 7, k = tid & 127; const size_t o = (r0 + t) * 512 + hc + k;
        sq[tid] = bf2f(C.Z(0)[o]); sk[tid] = bf2f(C.Z(1)[o]); sf[tid] = __expf(bf2f(C.Z(2)[o]));
    }
    const int v = tid & 127, kq = tid >> 7;
    const float gg_pre = bf2f(C.Z(4)[(r0 + (tid >> 7)) * 512 + hc + v]), hgn_pre = C.in[9][hc + v];
    float S[32];
    const float* sin = C.in[3] + (size_t)item * 16384 + (size_t)(kq * 32) * 128 + v;
#pragma unroll
    for (int j = 0; j < 32; ++j) S[j] = sin[j * 128];
    float vt[4];
#pragma unroll
    for (int t = 0; t < 4; ++t) vt[t] = bf2f(C.Z(3)[(r0 + t) * 512 + hc + v]);
    __syncthreads();
#pragma unroll
    for (int t = 0; t < 4; ++t) {
        float po = 0.f;
#pragma unroll
        for (int j = 0; j < 32; ++j) { const int k = kq * 32 + j; S[j] = sf[t * 128 + k] * S[j] + sk[t * 128 + k] * vt[t]; po += S[j] * sq[t * 128 + k]; }
        sp[(kq * 4 + t) * 128 + v] = po;
    }
    float* sout = C.out + OUT_SSMP + (size_t)item * 16384 + (size_t)(kq * 32) * 128 + v;
#pragma unroll
    for (int j = 0; j < 32; ++j) sout[j * 128] = S[j];
    __syncthreads();
    {
        const int t = tid >> 7;
        const float o = sp[(0 * 4 + t) * 128 + v] + sp[(1 * 4 + t) * 128 + v] + sp[(2 * 4 + t) * 128 + v] + sp[(3 * 4 + t) * 128 + v];
        float s = o * o;
#pragma unroll
        for (int x = 32; x >= 1; x >>= 1) s += __shfl_xor(s, x);
        if (lane == 0) sred[wid] = s;
        __syncthreads();
        const float ms = (sred[2 * t] + sred[2 * t + 1]) * (1.0f / 128.0f);
        C.wsb(WS_O)[(r0 + t) * 1024 + hc + v] = f2bf(o * rsqrtf(ms + EPS) * hgn_pre * gg_pre);
    }
    __syncthreads();
}

__device__ __forceinline__ void gmlp_sample_item(const Ctx& C, LAS unsigned char* lds, int bs) {
    const int tid = threadIdx.x, lane = tid & 63, wid = tid >> 6; const size_t r0 = (size_t)MP + bs * 4;
    LAS float* sred = (LAS float*)lds;
    const int c = tid, g = c >> 7;
    float gv[4], s[4], s2[4], uuv[4], bsv[4], wv[10];
    const float lg = C.in[10][c], lbb = C.in[11][c];
    { const float* W = C.in[12] + (size_t)g * 16384; const float* bsp = C.in[13] + g * 128; int q = 0;
#pragma unroll
      for (int t = 0; t < 4; ++t) { bsv[t] = bsp[t]; uuv[t] = bf2f(C.Z(5)[(r0 + t) * 512 + c]);
#pragma unroll
          for (int sx = 0; sx < 4; ++sx) if (sx <= t) wv[q++] = W[t * 128 + sx]; } }
#pragma unroll
    for (int t = 0; t < 4; ++t) { gv[t] = bf2f(C.Z(6)[(r0 + t) * 512 + c]); s[t] = gv[t]; s2[t] = gv[t] * gv[t]; }
#pragma unroll
    for (int t = 0; t < 4; ++t)
#pragma unroll
        for (int x = 32; x >= 1; x >>= 1) { s[t] += __shfl_xor(s[t], x); s2[t] += __shfl_xor(s2[t], x); }
    if (lane == 0) {
#pragma unroll
        for (int t = 0; t < 4; ++t) { sred[wid * 8 + t] = s[t]; sred[wid * 8 + 4 + t] = s2[t]; } }
    __syncthreads();
    float vn[4];
#pragma unroll
    for (int t = 0; t < 4; ++t) { float a = 0.f, a2 = 0.f;
#pragma unroll
        for (int w = 0; w < 8; ++w) { a += sred[w * 8 + t]; a2 += sred[w * 8 + 4 + t]; }
        const float mean = a * (1.0f / 512.0f), var = fmaxf(a2 * (1.0f / 512.0f) - mean * mean, 0.f);
        vn[t] = (gv[t] - mean) * rsqrtf(var + EPS) * lg + lbb;
        C.out[OUT_CMV + ((size_t)bs * 4 + t) * 512 + c] = vn[t]; }
    { int q = 0;
#pragma unroll
      for (int t = 0; t < 4; ++t) { float mix = bsv[t];
#pragma unroll
          for (int sx = 0; sx < 4; ++sx) if (sx <= t) mix += wv[q++] * vn[sx];
          C.wsb(WS_O)[(r0 + t) * 1024 + 512 + c] = f2bf(uuv[t] * mix); } }
    __syncthreads();
}

__device__ __forceinline__ void hg_out(const Ctx& C, LAS unsigned char* lds) {
    const int tid = threadIdx.x, lane = tid & 63, wid = tid >> 6, r = lane & 15, qd = lane >> 4;
    const bf16_t* __restrict__ QE = C.Z(7); const bf16_t* __restrict__ SC = C.wsb(WS_SC); const bf16_t* __restrict__ OI = C.wsb(WS_OI); const bf16_t* __restrict__ Zg = C.Z(4); bf16_t* __restrict__ O = C.wsb(WS_O);
    const float* hgn = C.in[9];
    LAS bf16_t* sS = (LAS bf16_t*)lds;
    const int sv = (tid >> 4) & 127, sk8 = (tid & 15) * 8;
    u32x4 st[8];
    int p = blockIdx.x;
#define HGO_LOAD(pp) do { _Pragma("unroll") for (int it = 0; it < 8; ++it) { const int e = it * NTHR + tid; \
        st[it] = *(const u32x4*)(SC + (size_t)(2 * (pp) + (e >> 11)) * 16384 + ((e & 2047) >> 4) * 128 + (e & 15) * 8); } } while (0)
    if (p < 512) HGO_LOAD(p);
    for (; p < 512; p += gridDim.x) {
        const int item = 2 * p + (wid >> 2), ti = wid & 3; const int b = item >> 7, c = (item >> 2) & 31, h = item & 3, hc = h * 128;
        const size_t row = (size_t)b * 2048 + c * 64 + 16 * ti + r;
        bf16x8 a[4];
#pragma unroll
        for (int k4 = 0; k4 < 4; ++k4) a[k4] = gld8(QE + row * 512 + hc + k4 * 32 + qd * 8);
        u32x2 oi[8], gg[8];
#pragma unroll
        for (int vt = 0; vt < 8; ++vt) { oi[vt] = *(const u32x2*)(OI + row * 512 + hc + 16 * vt + 4 * qd); gg[vt] = *(const u32x2*)(Zg + row * 512 + hc + 16 * vt + 4 * qd); }
        __syncthreads();
#pragma unroll
        for (int it = 0; it < 8; ++it) { const int e = it * NTHR + tid; *(LAS u32x4*)(sS + (e >> 11) * (128 * 136) + ((e & 2047) >> 4) * 136 + (e & 15) * 8) = st[it]; }
        __syncthreads();
        if (p + (int)gridDim.x < 512) HGO_LOAD(p + gridDim.x);
        const LAS bf16_t* sT = sS + (wid >> 2) * (128 * 136);
        f32x4 d[8];
#pragma unroll
        for (int vt = 0; vt < 8; ++vt) { d[vt] = (f32x4){0.f, 0.f, 0.f, 0.f};
#pragma unroll
            for (int k4 = 0; k4 < 4; ++k4) d[vt] = MFMA16(ld8(sT + (16 * vt + r) * 136 + k4 * 32 + qd * 8), a[k4], d[vt]); }
        float sq = 0.f;
#pragma unroll
        for (int vt = 0; vt < 8; ++vt) {
            d[vt][0] += bflo(oi[vt].x); d[vt][1] += bfhi(oi[vt].x); d[vt][2] += bflo(oi[vt].y); d[vt][3] += bfhi(oi[vt].y);
            sq += (d[vt][0] * d[vt][0] + d[vt][1] * d[vt][1]) + (d[vt][2] * d[vt][2] + d[vt][3] * d[vt][3]); }
        sq += __shfl_xor(sq, 16); sq += __shfl_xor(sq, 32);
        const float rs = rsqrtf(sq * (1.0f / 128.0f) + EPS);
#pragma unroll
        for (int vt = 0; vt < 8; ++vt) { const int cc = hc + 16 * vt + 4 * qd; const f32x4 gn = *(const f32x4*)(hgn + cc);
            u32x2 w; w.x = pk2(d[vt][0] * rs * gn[0] * bflo(gg[vt].x), d[vt][1] * rs * gn[1] * bfhi(gg[vt].x)); w.y = pk2(d[vt][2] * rs * gn[2] * bflo(gg[vt].y), d[vt][3] * rs * gn[3] * bfhi(gg[vt].y));
            *(u32x2*)(O + row * 1024 + cc) = w; }
    }
#undef HGO_LOAD
    __syncthreads();
    (void)sv; (void)sk8;
}

__device__ __forceinline__ void attn_prompt_item(const Ctx& C, LAS unsigned char* lds, int item) {
    const int tid = threadIdx.x, lane = tid & 63, wid = tid >> 6, r = lane & 15, qd = lane >> 4;
    const int b = item >> 5, h = (item >> 3) & 3, qt = item & 7;
    int opq = 0; asm volatile("" : "+v"(opq));
    LAS bf16_t* sK = (LAS bf16_t*)lds + opq;
    const bf16_t* KB = C.wsb(WS_KB); const bf16_t* VT = C.wsb(WS_VT); const bf16_t* HQ = C.wsb(WS_HQ); bf16_t* CA = C.wsb(WS_CA);
    const size_t q0 = (size_t)b * 2048 + qt * 256 + wid * 32;
    {   const bf16_t* gsrc = KB + ((size_t)b * 256 + (tid >> 5)) * 1024 + h * 256 + (tid & 31) * 8; LAS bf16_t* ldst = sK + (tid >> 5) * 264 + (tid & 31) * 8;
        u32x4 stg[16];
#pragma unroll
        for (int it = 0; it < 16; ++it) stg[it] = *(const u32x4*)(gsrc + (size_t)it * 16 * 1024);
#pragma unroll
        for (int it = 0; it < 16; ++it) *(LAS u32x4*)(ldst + it * 16 * 264) = stg[it]; }
    bf16x8 qf[2][8];
#pragma unroll
    for (int x = 0; x < 2; ++x)
#pragma unroll
        for (int k8 = 0; k8 < 8; ++k8) qf[x][k8] = gld8(HQ + (q0 + x * 16 + r) * 1024 + h * 256 + k8 * 32 + qd * 8);
    __syncthreads();
    bf16x8 pf[2][8];
    {
        f32x4 s[2][16];
#pragma unroll
        for (int mt = 0; mt < 16; ++mt) { s[0][mt] = (f32x4){0.f, 0.f, 0.f, 0.f}; s[1][mt] = (f32x4){0.f, 0.f, 0.f, 0.f};
#pragma unroll
            for (int k8 = 0; k8 < 8; ++k8) { const bf16x8 kf = ld8(sK + (16 * mt + r) * 264 + k8 * 32 + qd * 8);
                s[0][mt] = MFMA16(kf, qf[0][k8], s[0][mt]); s[1][mt] = MFMA16(kf, qf[1][k8], s[1][mt]); } }
#pragma unroll
        for (int x = 0; x < 2; ++x) {
            float mx = -3.0e38f;
#pragma unroll
            for (int mt = 0; mt < 16; ++mt)
#pragma unroll
                for (int jx = 0; jx < 4; ++jx) mx = fmaxf(mx, s[x][mt][jx]);
            mx = fmaxf(mx, __shfl_xor(mx, 16)); mx = fmaxf(mx, __shfl_xor(mx, 32));
            float sum = 0.f;
#pragma unroll
            for (int mt = 0; mt < 16; ++mt)
#pragma unroll
                for (int jx = 0; jx < 4; ++jx) { const float e = __expf(s[x][mt][jx] - mx); s[x][mt][jx] = e; sum += e; }
            sum += __shfl_xor(sum, 16); sum += __shfl_xor(sum, 32);
            const float inv = __builtin_amdgcn_rcpf(sum);
#pragma unroll
            for (int k8 = 0; k8 < 8; ++k8) { u32x4 w; w.x = pk2(s[x][2 * k8][0] * inv, s[x][2 * k8][1] * inv); w.y = pk2(s[x][2 * k8][2] * inv, s[x][2 * k8][3] * inv);
                w.z = pk2(s[x][2 * k8 + 1][0] * inv, s[x][2 * k8 + 1][1] * inv); w.w = pk2(s[x][2 * k8 + 1][2] * inv, s[x][2 * k8 + 1][3] * inv);
                pf[x][k8] = __builtin_bit_cast(bf16x8, w); }
        }
    }
    __syncthreads();
    {   const bf16_t* gsrc = VT + ((size_t)b * 1024 + h * 256 + (tid >> 5)) * 256 + (tid & 31) * 8; LAS bf16_t* ldst = sK + (tid >> 5) * 264 + (tid & 31) * 8;
        u32x4 stg[16];
#pragma unroll
        for (int it = 0; it < 16; ++it) stg[it] = *(const u32x4*)(gsrc + (size_t)it * 16 * 256);
#pragma unroll
        for (int it = 0; it < 16; ++it) *(LAS u32x4*)(ldst + it * 16 * 264) = stg[it]; }
    __syncthreads();
#pragma unroll 2
    for (int dt = 0; dt < 16; ++dt) {
        f32x4 o0 = {0.f, 0.f, 0.f, 0.f}, o1 = {0.f, 0.f, 0.f, 0.f};
        bf16x8 vf[8];
#pragma unroll
        for (int k8 = 0; k8 < 8; ++k8) {
            const LAS bf16_t* vp = sK + (16 * dt + r) * 264 + 32 * k8 + 4 * qd;
            const u32x2 lo = *(const LAS u32x2*)vp, hi = *(const LAS u32x2*)(vp + 16);
            u32x4 w; w.x = lo.x; w.y = lo.y; w.z = hi.x; w.w = hi.y; vf[k8] = __builtin_bit_cast(bf16x8, w);
        }
#pragma unroll
        for (int k8 = 0; k8 < 8; ++k8) { o0 = MFMA16(vf[k8], pf[0][k8], o0); o1 = MFMA16(vf[k8], pf[1][k8], o1); }
        u32x2 w0, w1; w0.x = pk2(o0[0], o0[1]); w0.y = pk2(o0[2], o0[3]); w1.x = pk2(o1[0], o1[1]); w1.y = pk2(o1[2], o1[3]);
        *(u32x2*)(CA + (q0 + r) * 1024 + h * 256 + 16 * dt + 4 * qd) = w0;
        *(u32x2*)(CA + (q0 + 16 + r) * 1024 + h * 256 + 16 * dt + 4 * qd) = w1;
    }
    __syncthreads();
}

__device__ __forceinline__ void attn_sample_item(const Ctx& C, LAS unsigned char* lds, int item) {
    const int tid = threadIdx.x, lane = tid & 63, wid = tid >> 6, r = lane & 15, qd = lane >> 4;
    const int bs = item >> 1, hp = item & 1, hl = wid & 1, h = 2 * hp + hl, kq = wid >> 1;
    LAS float* sP = (LAS float*)lds;
    LAS float* sMx = sP + 2048;
    LAS float* sSm = sMx + 32;
    LAS float* sO = sSm + 32;
    const bf16_t* HQ = C.wsb(WS_HQ); const size_t r0 = (size_t)MP + bs * 4;
    const float* Kc = C.in[4] + (size_t)bs * 262144; const float* Vc = C.in[5] + (size_t)bs * 262144;
    bf16x8 qf[8];
#pragma unroll
    for (int k8 = 0; k8 < 8; ++k8) { if (r < 4) qf[k8] = gld8(HQ + (r0 + r) * 1024 + h * 256 + k8 * 32 + qd * 8); else qf[k8] = (bf16x8){0, 0, 0, 0, 0, 0, 0, 0}; }
    f32x4 s[4];
    const float* kp = Kc + ((size_t)(kq * 64 + r) * 4 + h) * 256 + qd * 8;
    const float* vp = Vc + ((size_t)(kq * 64) * 4 + h) * 256 + lane * 4;
    f32x4 ka[16], kb[16];
#define LOADK(dst, mt) do { _Pragma("unroll") for (int k8 = 0; k8 < 8; ++k8) { dst[2 * k8] = *(const f32x4*)(kp + (size_t)(mt) * 16384 + k8 * 32); dst[2 * k8 + 1] = *(const f32x4*)(kp + (size_t)(mt) * 16384 + k8 * 32 + 4); } } while (0)
#define MMAK(src, mt) do { s[mt] = (f32x4){0.f, 0.f, 0.f, 0.f}; _Pragma("unroll") for (int k8 = 0; k8 < 8; ++k8) { u32x4 w; w.x = pk2(src[2 * k8][0], src[2 * k8][1]); w.y = pk2(src[2 * k8][2], src[2 * k8][3]); \
        w.z = pk2(src[2 * k8 + 1][0], src[2 * k8 + 1][1]); w.w = pk2(src[2 * k8 + 1][2], src[2 * k8 + 1][3]); s[mt] = MFMA16(__builtin_bit_cast(bf16x8, w), qf[k8], s[mt]); } } while (0)
#define LOADV(dst, m0) do { _Pragma("unroll") for (int m = 0; m < 16; ++m) dst[m] = *(const f32x4*)(vp + (size_t)((m0) + m) * 1024); } while (0)
#define FMAV(src, m0) do { _Pragma("unroll") for (int m = 0; m < 16; ++m) { _Pragma("unroll") for (int t = 0; t < 4; ++t) acc[t] += src[m] * sP[(wid * 4 + t) * 64 + (m0) + m]; } } while (0)
    LOADK(ka, 0); LOADK(kb, 1);
    MMAK(ka, 0); LOADK(ka, 2);
    MMAK(kb, 1); LOADK(kb, 3);
    MMAK(ka, 2); LOADV(ka, 0);
    MMAK(kb, 3); LOADV(kb, 16);
    float mx = -3.0e38f;
#pragma unroll
    for (int mt = 0; mt < 4; ++mt)
#pragma unroll
        for (int jx = 0; jx < 4; ++jx) mx = fmaxf(mx, s[mt][jx]);
    mx = fmaxf(mx, __shfl_xor(mx, 16)); mx = fmaxf(mx, __shfl_xor(mx, 32));
    float sum = 0.f;
#pragma unroll
    for (int mt = 0; mt < 4; ++mt)
#pragma unroll
        for (int jx = 0; jx < 4; ++jx) { const float e = __expf(s[mt][jx] - mx); s[mt][jx] = e; sum += e; }
    sum += __shfl_xor(sum, 16); sum += __shfl_xor(sum, 32);
    if (lane < 4) { sMx[(hl * 4 + kq) * 4 + lane] = mx; sSm[(hl * 4 + kq) * 4 + lane] = sum; }
    if (r < 4) {
#pragma unroll
        for (int mt = 0; mt < 4; ++mt)
#pragma unroll
            for (int jx = 0; jx < 4; ++jx) sP[(wid * 4 + r) * 64 + 16 * mt + 4 * qd + jx] = s[mt][jx];
    }
    {
        f32x4 acc[4];
#pragma unroll
        for (int t = 0; t < 4; ++t) acc[t] = (f32x4){0.f, 0.f, 0.f, 0.f};
        FMAV(ka, 0); LOADV(ka, 32);
        FMAV(kb, 16); LOADV(kb, 48);
        FMAV(ka, 32); FMAV(kb, 48);
#pragma unroll
        for (int t = 0; t < 4; ++t) *(LAS f32x4*)(sO + ((hl * 4 + kq) * 4 + t) * 256 + lane * 4) = acc[t];
    }
#undef LOADK
#undef MMAK
#undef LOADV
#undef FMAV
    __syncthreads();
    {
        const int e = tid * 4, hl2 = e >> 10, t = (e >> 8) & 3, d = e & 255;
        float m4[4], w4[4]; float gm = -3.0e38f, den = 0.f;
#pragma unroll
        for (int q4 = 0; q4 < 4; ++q4) { m4[q4] = sMx[(hl2 * 4 + q4) * 4 + t]; gm = fmaxf(gm, m4[q4]); }
#pragma unroll
        for (int q4 = 0; q4 < 4; ++q4) { w4[q4] = __expf(m4[q4] - gm); den += w4[q4] * sSm[(hl2 * 4 + q4) * 4 + t]; }
        const float inv = __builtin_amdgcn_rcpf(den);
        f32x4 o = {0.f, 0.f, 0.f, 0.f};
#pragma unroll
        for (int q4 = 0; q4 < 4; ++q4) o += *(const LAS f32x4*)(sO + ((hl2 * 4 + q4) * 4 + t) * 256 + d) * (w4[q4] * inv);
        u32x2 w; w.x = pk2(o[0], o[1]); w.y = pk2(o[2], o[3]);
        *(u32x2*)(C.wsb(WS_CA) + (r0 + t) * 1024 + (2 * hp + hl2) * 256 + d) = w;
    }
    __syncthreads();
}

template <class F> __device__ __forceinline__ void sgemm_tile(const bf16_t* A, const bf16_t* Bt, int K, int N, int tile, LAS unsigned char* lds, const F& epi) {
    const int tid = threadIdx.x, lane = tid & 63, wid = tid >> 6, r = lane & 15, qd = lane >> 4;
    const int ntn = N >> 6; const int mt = tile / ntn, nt = tile - mt * ntn;
    const int row0 = MP + 32 * mt, n0 = 64 * nt; const int KW = K >> 3;
    f32x4 acc[2][4];
#pragma unroll
    for (int mi = 0; mi < 2; ++mi)
#pragma unroll
        for (int ni = 0; ni < 4; ++ni) acc[mi][ni] = (f32x4){0.f, 0.f, 0.f, 0.f};
    const bf16_t* ap = A + (size_t)(row0 + r) * K + wid * KW + qd * 8;
    const bf16_t* bp = Bt + (size_t)(n0 + r) * K + wid * KW + qd * 8;
#pragma unroll 1
    for (int kc = 0; kc < KW; kc += 128) {
        bf16x8 a[2][4], b[4][4];
#pragma unroll
        for (int ks = 0; ks < 4; ++ks) {
#pragma unroll
            for (int mi = 0; mi < 2; ++mi) a[mi][ks] = gld8(ap + (size_t)mi * 16 * K + kc + ks * 32);
#pragma unroll
            for (int ni = 0; ni < 4; ++ni) b[ni][ks] = gld8(bp + (size_t)ni * 16 * K + kc + ks * 32);
        }
#pragma unroll
        for (int ks = 0; ks < 4; ++ks)
#pragma unroll
            for (int mi = 0; mi < 2; ++mi)
#pragma unroll
                for (int ni = 0; ni < 4; ++ni) acc[mi][ni] = MFMA16(a[mi][ks], b[ni][ks], acc[mi][ni]);
    }
    LAS float* red = (LAS float*)lds;
#pragma unroll
    for (int mi = 0; mi < 2; ++mi)
#pragma unroll
        for (int ni = 0; ni < 4; ++ni)
#pragma unroll
            for (int jx = 0; jx < 4; ++jx) red[(wid * 32 + 16 * mi + 4 * qd + jx) * 68 + 16 * ni + r] = acc[mi][ni][jx];
    __syncthreads();
    {
        const int row = tid >> 4, c4 = (tid & 15) * 4;
        f32x4 v = *(const LAS f32x4*)(red + row * 68 + c4);
#pragma unroll
        for (int w = 1; w < 8; ++w) v += *(const LAS f32x4*)(red + (w * 32 + row) * 68 + c4);
        epi(row0 + row, n0 + c4, v);
    }
    __syncthreads();
}
struct SEpi1 {
    bf16_t* Zb; const float* lbp;
    __device__ __forceinline__ void operator()(int row, int col, const f32x4& v) const {
        const int sec = col >> 9, cs = col & 511; const size_t o = (size_t)row * 512 + cs;
        if (sec == 1) {
            const f32x4 p0 = *(const f32x4*)(lbp + cs), p1 = *(const f32x4*)(lbp + 512 + cs); float kk[4], lf[4];
#pragma unroll
            for (int j = 0; j < 4; ++j) { const float lb = sigm(p0[j] - p1[j]), sg = sigm(v[j]), oml = 1.0f - lb; kk[j] = oml * (1.0f - sg); lf[j] = __logf(lb + oml * sg); }
            u32x2 w; w.x = pk2(kk[0], kk[1]); w.y = pk2(kk[2], kk[3]); *(u32x2*)(Zb + ZSZ + o) = w;
            w.x = pk2(lf[0], lf[1]); w.y = pk2(lf[2], lf[3]); *(u32x2*)(Zb + 2 * ZSZ + o) = w;
        } else {
            float rr[4];
#pragma unroll
            for (int j = 0; j < 4; ++j) { const float z = v[j]; const float t = (sec >= 4) ? 1.5957691216f * (z + 0.044715f * z * z * z) : z; const float sg = sigm(t);
                rr[j] = (sec == 2) ? z : ((sec == 3) ? sg : z * sg); }
            u32x2 w; w.x = pk2(rr[0], rr[1]); w.y = pk2(rr[2], rr[3]); *(u32x2*)(Zb + (size_t)(sec == 0 ? 0 : sec + 1) * ZSZ + o) = w;
        }
    }
};
template <bool RB> struct SEpiRes {
    const float* resf; bf16_t* xb; float* ss;
    __device__ __forceinline__ void operator()(int row, int col, const f32x4& a) const {
        const size_t o = (size_t)row * 1024 + col; f32x4 v;
        if (RB) { const u32x2 rr = *(const u32x2*)(xb + o); v = (f32x4){bflo(rr.x), bfhi(rr.x), bflo(rr.y), bfhi(rr.y)} + a; }
        else v = *(const f32x4*)(resf + o) + a;
        u32x2 w; w.x = pk2(v[0], v[1]); w.y = pk2(v[2], v[3]); *(u32x2*)(xb + o) = w;
        float s = (v[0] * v[0] + v[1] * v[1]) + (v[2] * v[2] + v[3] * v[3]);
        s += __shfl_xor(s, 1); s += __shfl_xor(s, 2); s += __shfl_xor(s, 4); s += __shfl_xor(s, 8);
        if ((threadIdx.x & 15) == 0) atomicAdd(ss + row, s);
    }
};
template <int ACT> struct SEpiScale {
    bf16_t* O; int ldc; const float* ss; float scale;
    __device__ __forceinline__ void operator()(int row, int col, const f32x4& a) const {
        const float rs = rsqrtf(ss[row] * (1.0f / 1024.0f) + EPS) * scale; f32x4 v = a * rs;
        if (ACT == 1) {
#pragma unroll
            for (int j = 0; j < 4; ++j) { const float x = fmaxf(v[j], 0.f); v[j] = x * x; } }
        u32x2 w; w.x = pk2(v[0], v[1]); w.y = pk2(v[2], v[3]); *(u32x2*)(O + (size_t)row * ldc + col) = w;
    }
};


__device__ __forceinline__ void panel_wait(unsigned* cnt, unsigned want) {
    if (threadIdx.x == 0) {
        __hip_atomic_fetch_add(cnt, 1u, __ATOMIC_RELAXED, __HIP_MEMORY_SCOPE_AGENT);
        unsigned sp = 0;
        while (__hip_atomic_load(cnt, __ATOMIC_RELAXED, __HIP_MEMORY_SCOPE_AGENT) < want) { __builtin_amdgcn_s_sleep(2); if (++sp > (1u << 22)) break; }
        __builtin_amdgcn_fence(__ATOMIC_ACQUIRE, "agent");
        asm volatile("s_waitcnt vmcnt(0)" ::: "memory");
    }
}
struct EpiFinal {
    static constexpr bool PERM = false, AFTER_DRAIN = true;
    const bf16_t* res; float* out; float* ss; unsigned* cnt; const float* gfin;
    __device__ __forceinline__ void fused(f32x4 (&acc)[2][2][4][2], const pg8::Unit& u, int wr, int wc, int fr, int fq, LAS unsigned char* lds, int wid, int lane) const {
        const int row0 = u.pm * 256 + wr * 64 + fr, col0 = u.pn * 256 + wc * 32 + 4 * fq;
#pragma unroll
        for (int ai = 0; ai < 2; ++ai)
#pragma unroll
            for (int m = 0; m < 4; ++m) {
                const int row = row0 + ai * 128 + m * 16; const size_t o = (size_t)row * 1024 + col0; float s = 0.f;
#pragma unroll
                for (int bj = 0; bj < 2; ++bj)
#pragma unroll
                    for (int n = 0; n < 2; ++n) { const u32x2 rr = *(const u32x2*)(res + o + bj * 128 + n * 16); const f32x4 v = (f32x4){bflo(rr.x), bfhi(rr.x), bflo(rr.y), bfhi(rr.y)} + acc[ai][bj][m][n]; acc[ai][bj][m][n] = v;
                        s += (v[0] * v[0] + v[1] * v[1]) + (v[2] * v[2] + v[3] * v[3]); }
                s += __shfl_xor(s, 16); s += __shfl_xor(s, 32);
                if (fq == 0) atomicAdd(ss + row, s);
            }
        asm volatile("s_waitcnt vmcnt(0)" ::: "memory");
        __syncthreads();
        panel_wait(cnt + 64 * u.pm, 4u);
        __syncthreads();
        f32x4 gv[2][2];
#pragma unroll
        for (int bj = 0; bj < 2; ++bj)
#pragma unroll
            for (int n = 0; n < 2; ++n) gv[bj][n] = *(const f32x4*)(gfin + col0 + bj * 128 + n * 16);
        float ssv[2][4];
#pragma unroll
        for (int ai = 0; ai < 2; ++ai)
#pragma unroll
            for (int m = 0; m < 4; ++m) ssv[ai][m] = __hip_atomic_load(ss + row0 + ai * 128 + m * 16, __ATOMIC_RELAXED, __HIP_MEMORY_SCOPE_AGENT);
#pragma unroll
        for (int ai = 0; ai < 2; ++ai)
#pragma unroll
            for (int m = 0; m < 4; ++m) {
                const int row = row0 + ai * 128 + m * 16; const size_t o = (size_t)row * 1024 + col0;
                const float rs = rsqrtf(ssv[ai][m] * (1.0f / 1024.0f) + EPS);
#pragma unroll
                for (int bj = 0; bj < 2; ++bj)
#pragma unroll
                    for (int n = 0; n < 2; ++n) *(f32x4*)(out + o + bj * 128 + n * 16) = acc[ai][bj][m][n] * rs * gv[bj][n];
            }
    }
};
struct SEpiFinal {
    const bf16_t* res; float* out; float* ss; unsigned* cnt; const float* gfin;
    __device__ __forceinline__ void operator()(int row, int col, const f32x4& a) const {
        const size_t o = (size_t)row * 1024 + col; const u32x2 rr = *(const u32x2*)(res + o); const f32x4 v = (f32x4){bflo(rr.x), bfhi(rr.x), bflo(rr.y), bfhi(rr.y)} + a;
        float s = (v[0] * v[0] + v[1] * v[1]) + (v[2] * v[2] + v[3] * v[3]);
        s += __shfl_xor(s, 1); s += __shfl_xor(s, 2); s += __shfl_xor(s, 4); s += __shfl_xor(s, 8);
        if ((threadIdx.x & 15) == 0) atomicAdd(ss + row, s);
        asm volatile("s_waitcnt vmcnt(0)" ::: "memory");
        __syncthreads();
        panel_wait(cnt + 64 * ((row - MP) >> 5), 16u);
        __syncthreads();
        const float rs = rsqrtf(__hip_atomic_load(ss + row, __ATOMIC_RELAXED, __HIP_MEMORY_SCOPE_AGENT) * (1.0f / 1024.0f) + EPS);
        *(f32x4*)(out + o) = v * rs * *(const f32x4*)(gfin + col);
    }
};

#define XB_TMO      128
#define XB_XCNT(j)  (256  + 64 * (j))
#define XB_XSUB(j)  (1280 + 64 * (j))
#define XB_XGEN(j)  (2304 + 64 * (j))
#define XB_TOP      3328
#define XB_TOPGEN   3392
#define XCD_BAR_WORDS 3456
#define XB_SPIN_CAP (1u << 18)

__device__ __forceinline__ unsigned xb_ld(unsigned* p)              { return __hip_atomic_load(p, __ATOMIC_RELAXED, __HIP_MEMORY_SCOPE_AGENT); }
__device__ __forceinline__ unsigned xb_add(unsigned* p, unsigned v) { return __hip_atomic_fetch_add(p, v, __ATOMIC_RELAXED, __HIP_MEMORY_SCOPE_AGENT); }
__device__ __forceinline__ unsigned xb_xcc_id() { return (unsigned)__builtin_amdgcn_s_getreg((3 << 11) | 20) & 0xFu; }
#define XB_SPIN(cond, bar) do { unsigned _sp = 0; while (cond) { __builtin_amdgcn_s_sleep(1); \
    if ((++_sp & 255u) == 0u) { if (xb_ld(&(bar)[XB_TMO])) break; if (_sp > XB_SPIN_CAP) { atomicAdd(&(bar)[XB_TMO], 1u); break; } } } } while (0)

struct XcdBarrier {
    unsigned* bar; unsigned x;
    volatile LAS unsigned* st;
};

__device__ __forceinline__ XcdBarrier xcd_barrier_post(unsigned* bar, volatile LAS unsigned* st) {
    XcdBarrier b; b.bar = bar; b.x = xb_xcc_id(); b.st = st;
    if (threadIdx.x == 0) (void)xb_add(&bar[XB_XCNT(b.x)], 1u);
    return b;
}
__device__ __forceinline__ void xcd_barrier_complete(unsigned* bar, unsigned x, unsigned& nloc, unsigned& nx) {
    const unsigned G = gridDim.x * gridDim.y * gridDim.z;
    unsigned sum, cnt, mine, sp = 0u;
    for (;;) {
        sum = 0u; cnt = 0u; mine = 0u;
#pragma unroll
        for (unsigned j = 0; j < 16; ++j) { const unsigned c = xb_ld(&bar[XB_XCNT(j)]); sum += c; cnt += (c > 0u) ? 1u : 0u; mine = (j == x) ? c : mine; }
        if (sum == G) break;
        __builtin_amdgcn_s_sleep(1);
        if ((++sp & 255u) == 0u) { if (xb_ld(&bar[XB_TMO])) break; if (sp > XB_SPIN_CAP) { atomicAdd(&bar[XB_TMO], 1u); break; } }
    }
    nloc = mine > 0u ? mine : 1u; nx = cnt > 0u ? cnt : 1u;
}

__device__ __forceinline__ void xcd_barrier(const XcdBarrier& b) {
    asm volatile("s_waitcnt vmcnt(0)" ::: "memory");
    __syncthreads();
    if (threadIdx.x == 0) {
        unsigned* bar = b.bar;
        __builtin_amdgcn_s_waitcnt(0);
        unsigned nloc = b.st[0], nx = b.st[1];
        if (nloc == 0u) { xcd_barrier_complete(bar, b.x, nloc, nx); b.st[0] = nloc; b.st[1] = nx; }
        const unsigned old = xb_add(&bar[XB_XSUB(b.x)], 1u);
        const unsigned gen = old / nloc;
        if (old + 1u == (gen + 1u) * nloc) {
            __builtin_amdgcn_fence(__ATOMIC_RELEASE, "agent");
            asm volatile("s_waitcnt vmcnt(0)" ::: "memory");
            const unsigned og = xb_add(&bar[XB_TOP], 1u);
            const unsigned tg = og / nx;
            if (og + 1u == (tg + 1u) * nx) xb_add(&bar[XB_TOPGEN], 1u);
            else XB_SPIN(xb_ld(&bar[XB_TOPGEN]) == tg, bar);
            __builtin_amdgcn_fence(__ATOMIC_ACQUIRE, "agent");
            xb_add(&bar[XB_XGEN(b.x)], 1u);
            asm volatile("s_waitcnt vmcnt(0)" ::: "memory");
        } else {
            XB_SPIN(xb_ld(&bar[XB_XGEN(b.x)]) == gen, bar);
            __builtin_amdgcn_fence(__ATOMIC_ACQUIRE, "agent");
            asm volatile("s_waitcnt vmcnt(0)" ::: "memory");
        }
    }
    __syncthreads();
}


constexpr int NPH = 11;
constexpr size_t WS_BAR = WS_END + 4096 - (WS_END % 4096);
constexpr int BAR_BYTES = 65536;
constexpr int LDS_ST_OFF = LDS_BYTES - 16;
static_assert(WS_BAR + BAR_BYTES < 512 * MB && XCD_BAR_WORDS <= 4096 && (4096 + 80 * 64) * 4 <= BAR_BYTES, "barrier words");
__global__ void __launch_bounds__(NTHR, 2) mega(Params P) {
    extern __shared__ __attribute__((aligned(16))) unsigned char smem[];
    LAS unsigned char* lds = (LAS unsigned char*)smem;
    cg::grid_group grid = cg::this_grid();
    const Ctx& C = P;
    const int lo = P.ph_lo, hi = P.ph_hi; const int G = gridDim.x, bx = blockIdx.x;
    if (threadIdx.x < 4) ((LAS unsigned*)(lds + LDS_ST_OFF))[threadIdx.x] = 0u;
    __syncthreads();
    XcdBarrier bar = xcd_barrier_post((unsigned*)(P.ws + WS_BAR), (volatile LAS unsigned*)(lds + LDS_ST_OFF));
    if (lo < 0) grid.sync();
#define IN(k) (lo <= (k) && (k) < hi)
#ifndef REP_PHASE
#define REP_PHASE -1
#endif
#define REPEAT(k) for (int rep_ = 0; rep_ < ((REP_PHASE == (k)) ? 2 : 1); ++rep_, (REP_PHASE == (k) && rep_ == 1) ? xcd_barrier(bar) : (void)0)
#define SEAM(k) do { if (IN(k) && IN((k) + 1)) xcd_barrier(bar); } while (0)
    if (IN(0)) REPEAT(0) phase_prep(C, lds);
    SEAM(0);
#define P1_MEM() do { pg8::Gemm g{C.wsb(WS_MEMN), C.wsb(WS_WCKV), NMR, 2048, DM}; pg8::StaticOrder S; S.init(NMR, 2048, G, bx); \
          EpiMem E{C.out + OUT_MK, C.out + OUT_MV, C.wsb(WS_KB), C.wsb(WS_VT)}; pg8::gemm_phase<EpiMem, pg8::StaticOrder>(lds, g, S, E, nullptr); } while (0)
#define P1_BIG() do { pg8::Gemm g{C.wsb(WS_HN), C.wsb(WS_WIN), MP, NIN, DM}; pg8::StaticOrder S; S.init(MP, NIN, G, bx); \
        Epi1 E{C.Z(0), C.in[6]}; pg8::gemm_phase<Epi1, pg8::StaticOrder>(lds, g, S, E, nullptr); } while (0)
    if (IN(1)) {
        const int grp = (bx >> 3) & 3; SEpi1 SE{C.Z(0), C.in[6]};
        const int t0 = (G > 128) ? bx - 64 : bx, tstep = (G > 128) ? G - 64 : G; const bool tiles = (G <= 128) || bx >= 64;
        int t = t0, k = 0;
        if (tiles) for (; t < 768 && k < grp; t += tstep, ++k) sgemm_tile(C.wsb(WS_HN), C.wsb(WS_WIN), DM, NIN, t, lds, SE);
        if (grp & 1) { P1_MEM(); P1_BIG(); } else { P1_BIG(); P1_MEM(); }
        if (tiles) for (; t < 768; t += tstep) sgemm_tile(C.wsb(WS_HN), C.wsb(WS_WIN), DM, NIN, t, lds, SE);
    }
    SEAM(1);
    if (IN(2)) {
        unsigned rq[16], rk[16], rl[16], rv[16];
        if (bx < 1024) hg_load(C, bx, rq, rk, rl, rv);
        for (int it = bx; it < 1024; it += G) hg_intra(C, lds, it, it + G, rq, rk, rl, rv);
    }
    SEAM(2);
    if (IN(3)) REPEAT(3) {
        hg_scan(C);
        for (int it = bx; it < 512; it += G) gmlp_item(C, lds, it);
        for (int it = bx; it < 512; it += G) hg_sample_item(C, lds, it);
        for (int it = bx; it < 128; it += G) gmlp_sample_item(C, lds, it);
    }
    SEAM(3);
    if (IN(4)) REPEAT(4) hg_out(C, lds);
    SEAM(4);
    if (IN(5)) {
#define PBIG() do { pg8::Gemm g{C.wsb(WS_O), C.wsb(WS_WOUT), MP, DM, DM}; pg8::StaticOrder S; S.init(MP, DM, G, bx); EpiRes<false> E{C.in[0], C.wsb(WS_XB), C.wsf(WS_SS)}; pg8::gemm_phase<EpiRes<false>, pg8::StaticOrder>(lds, g, S, E, nullptr); } while (0)
#define PTILE() do { SEpiRes<false> SE{C.in[1] - (size_t)MP * 1024, C.wsb(WS_XB), C.wsf(WS_SS)}; for (int t = bx; t < 256; t += G) sgemm_tile(C.wsb(WS_O), C.wsb(WS_WOUT), DM, DM, t, lds, SE); } while (0)
        if ((bx >> 3) & 1) { PTILE(); PBIG(); } else { PBIG(); PTILE(); }
#undef PBIG
#undef PTILE
    }
    SEAM(5);
    if (IN(6)) {
#define PBIG() do { pg8::Gemm g{C.wsb(WS_XB), C.wsb(WS_WCQ), MP, DM, DM}; pg8::StaticOrder S; S.init(MP, DM, G, bx); EpiScale<0> E{C.wsb(WS_HQ), DM, C.wsf(WS_SS), 0.0625f}; pg8::gemm_phase<EpiScale<0>, pg8::StaticOrder>(lds, g, S, E, nullptr); } while (0)
#define PTILE() do { SEpiScale<0> SE{C.wsb(WS_HQ), DM, C.wsf(WS_SS), 0.0625f}; for (int t = bx; t < 256; t += G) sgemm_tile(C.wsb(WS_XB), C.wsb(WS_WCQ), DM, DM, t, lds, SE); } while (0)
        if ((bx >> 3) & 1) { PTILE(); PBIG(); } else { PBIG(); PTILE(); }
#undef PBIG
#undef PTILE
    }
    SEAM(6);
    if (IN(7)) REPEAT(7) {
        if (bx & 1) { for (int it = bx; it < 256; it += G) attn_sample_item(C, lds, it); for (int it = bx; it < 256; it += G) attn_prompt_item(C, lds, it); }
        else { for (int it = bx; it < 256; it += G) attn_prompt_item(C, lds, it); for (int it = bx; it < 256; it += G) attn_sample_item(C, lds, it); }
    }
    SEAM(7);
    if (IN(8)) {
#define PBIG() do { pg8::Gemm g{C.wsb(WS_CA), C.wsb(WS_WCO), MP, DM, DM}; pg8::StaticOrder S; S.init(MP, DM, G, bx); EpiRes<true> E{nullptr, C.wsb(WS_XB), C.wsf(WS_SS) + MT}; pg8::gemm_phase<EpiRes<true>, pg8::StaticOrder>(lds, g, S, E, nullptr); } while (0)
#define PTILE() do { SEpiRes<true> SE{nullptr, C.wsb(WS_XB), C.wsf(WS_SS) + MT}; for (int t = bx; t < 256; t += G) sgemm_tile(C.wsb(WS_CA), C.wsb(WS_WCO), DM, DM, t, lds, SE); } while (0)
        if ((bx >> 3) & 1) { PTILE(); PBIG(); } else { PBIG(); PTILE(); }
#undef PBIG
#undef PTILE
    }
    SEAM(8);
    if (IN(9)) {
        const int grp = (bx >> 3) & 3; SEpiScale<1> SE{C.wsb(WS_H), DFF, C.wsf(WS_SS) + MT, 1.0f};
        int t = bx, k = 0;
        for (; t < 1024 && k < grp; t += G, ++k) sgemm_tile(C.wsb(WS_XB), C.wsb(WS_WUP), DM, DFF, t, lds, SE);
        { pg8::Gemm g{C.wsb(WS_XB), C.wsb(WS_WUP), MP, DFF, DM}; pg8::StaticOrder S; S.init(MP, DFF, G, bx);
          EpiScale<1> E{C.wsb(WS_H), DFF, C.wsf(WS_SS) + MT, 1.0f}; pg8::gemm_phase<EpiScale<1>, pg8::StaticOrder>(lds, g, S, E, nullptr); }
        for (; t < 1024; t += G) sgemm_tile(C.wsb(WS_XB), C.wsb(WS_WUP), DM, DFF, t, lds, SE);
    }
    SEAM(9);
    if (IN(10)) { pg8::Gemm g{C.wsb(WS_H), C.wsb(WS_WDN), MP, DM, DFF}; pg8::StaticOrder S; S.init(MP, DM, G, bx);
        unsigned* pc = (unsigned*)(P.ws + WS_BAR) + 4096;
        EpiFinal E{C.wsb(WS_XB), C.out + OUT_YP, C.wsf(WS_SS) + 2 * MT, pc, C.in[24]}; pg8::gemm_phase<EpiFinal, pg8::StaticOrder>(lds, g, S, E, nullptr);
        SEpiFinal SE{C.wsb(WS_XB), C.out + OUT_YP, C.wsf(WS_SS) + 2 * MT, pc + 64 * 64, C.in[24]};
        for (int t = bx; t < 256; t += G) sgemm_tile(C.wsb(WS_H), C.wsb(WS_WDN), DFF, DM, t, lds, SE); }
#undef IN
#undef SEAM
}

#ifndef MULTI_LAUNCH
#define MULTI_LAUNCH 0
#endif
extern "C" void kernel_launch(void* const* d_in, const int* in_sizes, int n_in, void* d_out, int out_size, void* d_ws, size_t ws_size, hipStream_t stream) {
    static int grid = 0;
    if (grid == 0) {
        int dev = 0, cus = 0, per_cu = 0;
        (void)hipGetDevice(&dev);
        (void)hipDeviceGetAttribute(&cus, hipDeviceAttributeMultiprocessorCount, dev);
        if (hipFuncSetAttribute((const void*)mega, hipFuncAttributeMaxDynamicSharedMemorySize, LDS_BYTES) != hipSuccess) fprintf(stderr, "hipFuncSetAttribute failed\n");
        if (hipOccupancyMaxActiveBlocksPerMultiprocessor(&per_cu, (const void*)mega, NTHR, LDS_BYTES) != hipSuccess || per_cu < 1) { fprintf(stderr, "occupancy query: %d\n", per_cu); per_cu = 1; }
        (void)hipGetLastError();
        grid = cus * per_cu;
        if (grid <= 0) grid = 256;
    }
    Params p{};
    for (int i = 0; i < 25; ++i) p.in[i] = (const float*)d_in[i];
    p.out = (float*)d_out; p.ws = (unsigned char*)d_ws;
    (void)hipMemsetAsync((unsigned char*)d_ws + WS_BAR, 0, BAR_BYTES, stream);
#if MULTI_LAUNCH
    for (int ph = 0; ph < NPH; ++ph) { p.ph_lo = ph; p.ph_hi = ph + 1; hipLaunchKernelGGL(mega, dim3(grid), dim3(NTHR), LDS_BYTES, stream, p); }
#else
    p.ph_lo = 0; p.ph_hi = NPH;
    void* args[] = {&p};
    hipError_t e = hipLaunchCooperativeKernel((const void*)mega, dim3(grid), dim3(NTHR), args, LDS_BYTES, stream);
    if (e != hipSuccess) fprintf(stderr, "cooperative launch failed: %s (grid %d)\n", hipGetErrorString(e), grid);
#endif
}
```

```cpp
#include <hip/hip_runtime.h>
#include <hip/hip_cooperative_groups.h>
#include <cstdio>
namespace cg = cooperative_groups;
namespace pg8 {
#define PG8_LAS __attribute__((address_space(3)))
typedef unsigned short bf16_t;
typedef short bf16x8 __attribute__((ext_vector_type(8)));
typedef float f32x4 __attribute__((ext_vector_type(4)));
typedef unsigned u32x4 __attribute__((ext_vector_type(4)));
constexpr int BM = 256, BK = 64, HALF = 128, HTB = HALF * BK * 2  , STAGE_BYTES = 8 * HTB, NXCD = 8, WGM = 8;

__host__ __device__ __forceinline__ int lds_byte(int r, int c) { const int st = (r >> 4) * 2 + (c >> 5), rr = r & 15, cc = c & 31, ob = rr * 64 + cc * 2; return st * 1024 + (ob ^ (((ob >> 9) & 1) << 5)); }
__host__ __device__ __forceinline__ void stage_rc(int b, int& R, int& C) { const int st = b / 1024, sb = b % 1024, swz = sb ^ (((sb >> 9) & 1) << 5); R = (st >> 1) * 16 + swz / 64; C = (st & 1) * 32 + (swz % 64) / 2; }
__host__ __device__ __forceinline__ int perm32(int rho) { const int n = rho >> 4, i = rho & 15; return 8 * (i >> 2) + 4 * n + (i & 3); }

struct Unit { int pm, pn; };
struct Gemm { const bf16_t* A; const bf16_t* Bt; int M, N, K; };

struct StaticOrder {
    int nM, nN, nwg, G, c;
    __host__ __device__ void init(int M, int N, int G_, int c_) { nM = M / BM; nN = N / BM; nwg = nM * nN; G = G_; c = c_; }
    __host__ __device__ bool next(int i, Unit& u) const {
        const long L = (long)i * G + c; if (L >= nwg) return false;
        int wgid = (int)L; { const int q = nwg / NXCD, r = nwg % NXCD, xcd = wgid % NXCD, off = wgid / NXCD; wgid = (xcd < r ? xcd * (q + 1) : r * (q + 1) + (xcd - r) * q) + off; }
        const int nig = WGM * nN, gid = wgid / nig, fm = gid * WGM, gsz = (nM - fm) < WGM ? (nM - fm) : WGM;
        u.pm = fm + ((wgid % nig) % gsz); u.pn = (wgid % nig) / gsz; return true;
    }
    __device__ __forceinline__ void a_ready(const Unit&) const {}
    __device__ __forceinline__ void done(const Unit&) const {}
};
template <class Epi, class Sched, bool STAMP = false>
__device__ __forceinline__ void gemm_phase(PG8_LAS unsigned char* lds, const Gemm g, const Sched& S, const Epi& E, unsigned long long* stamps) {
    const int tid = threadIdx.x, wid = __builtin_amdgcn_readfirstlane(tid >> 6), lane = tid & 63, wr = wid >> 2, wc = wid & 3, fr = lane & 15, fq = lane >> 4;
    const int K = g.K, nt = K / BK;
    int ts_lo = 0, ts_hi = 0, nts = 0; const unsigned long long rt_entry = STAMP ? (unsigned long long)wall_clock64() : 0ull;
#define PG8_STAMP() do { if (STAMP && wid == 0 && nts < 64) { const unsigned long long _c = (unsigned long long)clock64(); \
        ts_lo = (lane == nts) ? (int)(unsigned)_c : ts_lo; ts_hi = (lane == nts) ? (int)(unsigned)(_c >> 32) : ts_hi; ++nts; } } while (0)
    PG8_STAMP();
    unsigned voffA[2], voffB[2];
#pragma unroll
    for (int i = 0; i < 2; ++i) { int R, C; stage_rc(tid * 16 + i * 8192, R, C); const int Rb = Epi::PERM ? ((R & ~31) + perm32(R & 31)) : R;
        voffA[i] = (unsigned)(R * K + C) * 2u; voffB[i] = (unsigned)(Rb * K + C) * 2u; }
    const size_t kstep = (size_t)(BK * 2);
    const size_t hstep = (size_t)HALF * K * 2;
    const size_t tstep = 2 * hstep;
    const unsigned ldsw = (unsigned)wid * 1024u;
    const int aoff = lds_byte(wr * 64 + fr, fq * 8), boff = lds_byte(wc * 32 + fr, fq * 8);
#define PG8_SA(b, h) (((b) * 2 + (h)) * HTB)
#define PG8_SB(b, h) ((4 + (b) * 2 + (h)) * HTB)
#define PG8_STAGE(bufoff, gbase, voff) do { _Pragma("unroll") for (int _i = 0; _i < 2; ++_i) \
        __builtin_amdgcn_global_load_lds((const unsigned*)((const char*)(gbase) + (voff)[_i]), (PG8_LAS unsigned*)(lds + (bufoff) + ldsw + _i * 8192), 16, 0, 0); } while (0)
#define PG8_LDA(dst, b, h) do { _Pragma("unroll") for (int m = 0; m < 4; ++m) _Pragma("unroll") for (int k = 0; k < 2; ++k) dst[m][k] = *(const PG8_LAS bf16x8*)(lds + PG8_SA(b, h) + aoff + m * 2048 + k * 1024); } while (0)
#define PG8_LDB(dst, b, h) do { _Pragma("unroll") for (int n = 0; n < 2; ++n) _Pragma("unroll") for (int k = 0; k < 2; ++k) dst[n][k] = *(const PG8_LAS bf16x8*)(lds + PG8_SB(b, h) + boff + n * 2048 + k * 1024); } while (0)
#define PG8_MMA(ai, bj, At, Bt) do { __builtin_amdgcn_s_setprio(1); _Pragma("unroll") for (int m = 0; m < 4; ++m) _Pragma("unroll") for (int n = 0; n < 2; ++n) _Pragma("unroll") for (int k = 0; k < 2; ++k) \
        acc[ai][bj][m][n] = __builtin_amdgcn_mfma_f32_16x16x32_bf16(Bt[n][k], At[m][k], acc[ai][bj][m][n], 0, 0, 0); __builtin_amdgcn_s_setprio(0); } while (0)
#define PG8_WAIT_V(n) asm volatile("s_waitcnt vmcnt(" #n ")" ::: "memory")
#define PG8_WAIT_L(n) asm volatile("s_waitcnt lgkmcnt(" #n ")" ::: "memory")
#define PG8_BAR __builtin_amdgcn_s_barrier()
#define PG8_SCHED __builtin_amdgcn_sched_barrier(0)
    Unit cur, nxt; int ui = 0;
    if (!S.next(0, cur)) return;
    f32x4 acc[2][2][4][2];
#pragma unroll
    for (int a = 0; a < 2; ++a)
#pragma unroll
        for (int b = 0; b < 2; ++b)
#pragma unroll
            for (int m = 0; m < 4; ++m)
#pragma unroll
                for (int n = 0; n < 2; ++n) acc[a][b][m][n] = (f32x4){0.f, 0.f, 0.f, 0.f};
    bf16x8 At[4][2], B0[2][2], B1[2][2];
    const char* cA = (const char*)g.A + (size_t)cur.pm * tstep; const char* cB = (const char*)g.Bt + (size_t)cur.pn * tstep;
    S.a_ready(cur);
    PG8_STAGE(PG8_SB(0, 0), cB, voffB); PG8_STAGE(PG8_SA(0, 0), cA, voffA); PG8_STAGE(PG8_SB(0, 1), cB + hstep, voffB); PG8_STAGE(PG8_SA(0, 1), cA + hstep, voffA);
    if (wr == 1) PG8_BAR;
    PG8_WAIT_V(4); PG8_BAR;
    PG8_STAGE(PG8_SB(1, 0), cB + kstep, voffB); PG8_STAGE(PG8_SA(1, 0), cA + kstep, voffA); PG8_STAGE(PG8_SB(1, 1), cB + hstep + kstep, voffB);
    PG8_WAIT_V(6); PG8_BAR;
    PG8_STAMP();
    for (;;) {
        const bool has_next = S.next(ui + 1, nxt);
        const char* nA = has_next ? (const char*)g.A + (size_t)nxt.pm * tstep : cA; const char* nB = has_next ? (const char*)g.Bt + (size_t)nxt.pn * tstep : cB;
        for (int t = 0; t < nt; t += 2) {
            const bool last = (t == nt - 2);
            const char* a1 = cA + (size_t)(t + 1) * kstep;
            const char* a2 = last ? nA : cA + (size_t)(t + 2) * kstep; const char* b2 = last ? nB : cB + (size_t)(t + 2) * kstep;
            const char* a3 = a2 + kstep; const char* b3 = b2 + kstep;
            if (last && has_next) S.a_ready(nxt);
            PG8_LDB(B0, 0, 0); PG8_SCHED; PG8_LDA(At, 0, 0); PG8_STAGE(PG8_SA(1, 1), a1 + hstep, voffA);
            PG8_WAIT_L(8); PG8_BAR; PG8_WAIT_L(0); PG8_MMA(0, 0, At, B0); PG8_BAR; PG8_SCHED;
            PG8_LDB(B1, 0, 1); PG8_STAGE(PG8_SB(0, 0), b2, voffB);
            PG8_BAR; PG8_WAIT_L(0); PG8_MMA(0, 1, At, B1); PG8_BAR;
            PG8_LDA(At, 0, 1); PG8_STAGE(PG8_SA(0, 0), a2, voffA);
            PG8_BAR; PG8_WAIT_L(0); PG8_MMA(1, 0, At, B0); PG8_BAR; PG8_SCHED;
            PG8_STAGE(PG8_SB(0, 1), b2 + hstep, voffB);
            PG8_WAIT_V(6); PG8_BAR; PG8_MMA(1, 1, At, B1); PG8_BAR;
            PG8_LDB(B0, 1, 0); PG8_SCHED; PG8_LDA(At, 1, 0); PG8_STAGE(PG8_SA(0, 1), a2 + hstep, voffA);
            PG8_WAIT_L(8); PG8_BAR; PG8_WAIT_L(0); PG8_MMA(0, 0, At, B0); PG8_BAR; PG8_SCHED;
            PG8_LDB(B1, 1, 1); PG8_STAGE(PG8_SB(1, 0), b3, voffB);
            PG8_BAR; PG8_WAIT_L(0); PG8_MMA(0, 1, At, B1); PG8_BAR;
            PG8_LDA(At, 1, 1); PG8_STAGE(PG8_SA(1, 0), a3, voffA);
            PG8_BAR; PG8_WAIT_L(0); PG8_MMA(1, 0, At, B0); PG8_BAR; PG8_SCHED;
            PG8_STAGE(PG8_SB(1, 1), b3 + hstep, voffB);
            PG8_WAIT_V(6); PG8_BAR; PG8_MMA(1, 1, At, B1); PG8_BAR;
        }
        PG8_STAMP();
        if constexpr (!Epi::AFTER_DRAIN) { E(acc, cur, wr, wc, fr, fq); S.done(cur); }
        PG8_STAMP();
        if (!has_next) break;
#pragma unroll
        for (int a = 0; a < 2; ++a)
#pragma unroll
            for (int b = 0; b < 2; ++b)
#pragma unroll
                for (int m = 0; m < 4; ++m)
#pragma unroll
                    for (int n = 0; n < 2; ++n) acc[a][b][m][n] = (f32x4){0.f, 0.f, 0.f, 0.f};
        cur = nxt; cA = nA; cB = nB; ++ui;
    }
    PG8_WAIT_V(0);
    if (wr == 0) PG8_BAR;
    PG8_BAR;
    if constexpr (Epi::AFTER_DRAIN) { E.fused(acc, cur, wr, wc, fr, fq, lds, wid, lane); S.done(cur); }
    PG8_STAMP();
    if (STAMP && wid == 0) { stamps[lane] = lane < nts ? (((unsigned long long)(unsigned)ts_hi << 32) | (unsigned)ts_lo) : 0ull;
        if (lane == 62) stamps[62] = rt_entry; if (lane == 63) stamps[63] = (unsigned long long)wall_clock64(); }
#undef PG8_STAMP
#undef PG8_SA
#undef PG8_SB
#undef PG8_STAGE
#undef PG8_LDA
#undef PG8_LDB
#undef PG8_MMA
#undef PG8_WAIT_V
#undef PG8_WAIT_L
#undef PG8_BAR
#undef PG8_SCHED
}
}

#define LAS __attribute__((address_space(3)))
using pg8::bf16_t; using pg8::bf16x8; using pg8::f32x4; using pg8::u32x4;
typedef unsigned u32x2 __attribute__((ext_vector_type(2)));
constexpr int DM = 1024, MP = 16384, MS = 512, MT = MP + MS, NMR = 2048, DFF = 4096, NIN = 3072;
constexpr float EPS = 1e-6f;
constexpr int NTHR = 512;
constexpr int LDS_BYTES = 144 * 1024;
constexpr size_t MB = 1024 * 1024;
constexpr size_t WS_WIN = 0, WS_WOUT = 6 * MB, WS_WCQ = 8 * MB, WS_WCKV = 10 * MB, WS_WCO = 14 * MB, WS_WUP = 16 * MB, WS_WDN = 24 * MB;
constexpr size_t WS_HN = 32 * MB;
constexpr size_t SZ_ROWB = (size_t)MT * DM * 2;
constexpr size_t WS_Z = WS_HN + SZ_ROWB;
constexpr size_t ZSZ = (size_t)MT * 512;
constexpr size_t WS_H = WS_HN;
constexpr size_t WS_C = WS_Z + 8 * ZSZ * 2;
constexpr size_t WS_MEMN = WS_C, WS_KB = WS_C + 4 * MB, WS_VT = WS_C + 8 * MB;
constexpr size_t WS_D = WS_C + 12 * MB;
constexpr size_t WS_DS = WS_D, WS_SC = WS_D + 32 * MB, WS_OI = WS_D + 64 * MB, WS_DEC = WS_D + 80 * MB;
constexpr size_t WS_HQ = WS_D, WS_CA = WS_D + 36 * MB;
constexpr size_t WS_E = WS_D + 81 * MB;
constexpr size_t WS_O = WS_E, WS_X1 = WS_O + SZ_ROWB, WS_XB = WS_X1 + 2 * SZ_ROWB, WS_SS = WS_XB + SZ_ROWB, WS_END = WS_SS + 3 * MT * 4;
static_assert(SZ_ROWB * 4 >= (size_t)MT * DFF * 2 && WS_END < 512 * MB, "workspace map");
constexpr size_t OUT_YP = 0, OUT_YS = 16777216, OUT_SP = 17301504, OUT_SSMP = 17825792, OUT_MK = 26214400, OUT_MV = 28311552, OUT_CMV = 30408704;

struct Params { const float* in[25]; float* out; unsigned char* ws; int ph_lo, ph_hi;
    __device__ __forceinline__ bf16_t* wsb(size_t off) const { return (bf16_t*)(ws + off); }
    __device__ __forceinline__ float* wsf(size_t off) const { return (float*)(ws + off); }
    __device__ __forceinline__ bf16_t* Z(int a) const { return (bf16_t*)(ws + WS_Z) + (size_t)a * ZSZ; }
};
typedef Params Ctx;


__device__ __forceinline__ float bf2f(bf16_t b) { return __uint_as_float(((unsigned)b) << 16); }
typedef float f32x2c __attribute__((ext_vector_type(2)));
typedef __bf16 bf16x2c __attribute__((ext_vector_type(2)));
__device__ __forceinline__ unsigned pk2(float lo, float hi) { const f32x2c v = {lo, hi}; const bf16x2c b = __builtin_convertvector(v, bf16x2c); return __builtin_bit_cast(unsigned, b); }
__device__ __forceinline__ bf16_t f2bf(float f) { return (bf16_t)(pk2(f, f) & 0xffffu); }
__device__ __forceinline__ float sigm(float x) { return __builtin_amdgcn_rcpf(1.0f + __expf(-x)); }
__device__ __forceinline__ float bflo(unsigned w) { return __uint_as_float(w << 16); }
__device__ __forceinline__ float bfhi(unsigned w) { return __uint_as_float(w & 0xffff0000u); }

struct Epi1 {
    static constexpr bool PERM = true, AFTER_DRAIN = false;
    bf16_t* Zb; const float* lbp;
    __device__ __forceinline__ void operator()(const f32x4 (&acc)[2][2][4][2], const pg8::Unit& u, int wr, int wc, int fr, int fq) const {
        const int sec = u.pn >> 1;
        const int row0 = u.pm * 256 + wr * 64 + fr;
        const int cs0 = (u.pn & 1) * 256 + wc * 32 + 8 * fq;
        if (sec == 1) {
            bf16_t* Zk = Zb + ZSZ; bf16_t* Zl = Zb + 2 * ZSZ;
            f32x4 pp[2][4];
#pragma unroll
            for (int bj = 0; bj < 2; ++bj) { const int cs = cs0 + bj * 128; pp[bj][0] = *(const f32x4*)(lbp + cs); pp[bj][1] = *(const f32x4*)(lbp + cs + 4); pp[bj][2] = *(const f32x4*)(lbp + 512 + cs); pp[bj][3] = *(const f32x4*)(lbp + 512 + cs + 4); }
#pragma unroll
            for (int bj = 0; bj < 2; ++bj) {
                const int cs = cs0 + bj * 128;
                const f32x4 p0a = pp[bj][0], p0b = pp[bj][1], p1a = pp[bj][2], p1b = pp[bj][3];
                float lb[8];
#pragma unroll
                for (int j = 0; j < 4; ++j) { lb[j] = sigm(p0a[j] - p1a[j]); lb[4 + j] = sigm(p0b[j] - p1b[j]); }
#pragma unroll
                for (int ai = 0; ai < 2; ++ai)
#pragma unroll
                    for (int m = 0; m < 4; ++m) {
                        const size_t o = (size_t)(row0 + ai * 128 + m * 16) * 512 + cs;
                        float kk[8], lf[8];
#pragma unroll
                        for (int j = 0; j < 8; ++j) { const float z = (j < 4) ? acc[ai][bj][m][0][j] : acc[ai][bj][m][1][j - 4];
                            const float sg = sigm(z), oml = 1.0f - lb[j]; kk[j] = oml * (1.0f - sg); lf[j] = __logf(lb[j] + oml * sg); }
                        u32x4 w; w.x = pk2(kk[0], kk[1]); w.y = pk2(kk[2], kk[3]); w.z = pk2(kk[4], kk[5]); w.w = pk2(kk[6], kk[7]);
                        *(u32x4*)(Zk + o) = w;
                        w.x = pk2(lf[0], lf[1]); w.y = pk2(lf[2], lf[3]); w.z = pk2(lf[4], lf[5]); w.w = pk2(lf[6], lf[7]);
                        *(u32x4*)(Zl + o) = w;
                    }
            }
        } else {
            bf16_t* Zo = Zb + (size_t)(sec == 0 ? 0 : sec + 1) * ZSZ;
#pragma unroll
            for (int bj = 0; bj < 2; ++bj) {
                const int cs = cs0 + bj * 128;
#pragma unroll
                for (int ai = 0; ai < 2; ++ai)
#pragma unroll
                    for (int m = 0; m < 4; ++m) {
                        const size_t o = (size_t)(row0 + ai * 128 + m * 16) * 512 + cs;
                        float r[8];
#pragma unroll
                        for (int j = 0; j < 8; ++j) { const float z = (j < 4) ? acc[ai][bj][m][0][j] : acc[ai][bj][m][1][j - 4];
                            const float t = (sec >= 4) ? 1.5957691216f * (z + 0.044715f * z * z * z) : z;
                            const float sg = sigm(t);
                            r[j] = (sec == 2) ? z : ((sec == 3) ? sg : z * sg); }
                        u32x4 w; w.x = pk2(r[0], r[1]); w.y = pk2(r[2], r[3]); w.z = pk2(r[4], r[5]); w.w = pk2(r[6], r[7]);
                        *(u32x4*)(Zo + o) = w;
                    }
            }
        }
    }
};

struct EpiMem {
    static constexpr bool PERM = false, AFTER_DRAIN = false;
    float* outK; float* outV; bf16_t* KB; bf16_t* VT;
    __device__ __forceinline__ void operator()(const f32x4 (&acc)[2][2][4][2], const pg8::Unit& u, int wr, int wc, int fr, int fq) const {
        const int row0 = u.pm * 256 + wr * 64 + fr;
        const bool isV = u.pn >= 4;
        const int col0 = (u.pn & 3) * 256 + wc * 32 + 4 * fq;
        float* outp = isV ? outV : outK;
#pragma unroll
        for (int ai = 0; ai < 2; ++ai)
#pragma unroll
            for (int m = 0; m < 4; ++m) {
                const int row = row0 + ai * 128 + m * 16;
#pragma unroll
                for (int bj = 0; bj < 2; ++bj)
#pragma unroll
                    for (int n = 0; n < 2; ++n) {
                        const int c = col0 + bj * 128 + n * 16; const f32x4 v = acc[ai][bj][m][n];
                        *(f32x4*)(outp + (size_t)row * 1024 + c) = v;
                        if (!isV) { u32x2 w; w.x = pk2(v[0], v[1]); w.y = pk2(v[2], v[3]); *(u32x2*)(KB + (size_t)row * 1024 + c) = w; }
                        else { const int b = row >> 8, mm = row & 255;
#pragma unroll
                            for (int j = 0; j < 4; ++j) VT[((size_t)b * 1024 + c + j) * 256 + mm] = f2bf(v[j]); }
                    }
            }
    }
};

template <bool RB> struct EpiRes {
    static constexpr bool PERM = false, AFTER_DRAIN = false;
    const float* resf; bf16_t* xb; float* ss;
    __device__ __forceinline__ void operator()(const f32x4 (&acc)[2][2][4][2], const pg8::Unit& u, int wr, int wc, int fr, int fq) const {
        const int row0 = u.pm * 256 + wr * 64 + fr, col0 = u.pn * 256 + wc * 32 + 4 * fq;
#pragma unroll
        for (int ai = 0; ai < 2; ++ai) {
            f32x4 rv[4][2][2];
#pragma unroll
            for (int m = 0; m < 4; ++m)
#pragma unroll
                for (int bj = 0; bj < 2; ++bj)
#pragma unroll
                    for (int n = 0; n < 2; ++n) { const size_t oo = (size_t)(row0 + ai * 128 + m * 16) * 1024 + col0 + bj * 128 + n * 16;
                        if (RB) { const u32x2 rr = *(const u32x2*)(xb + oo); rv[m][bj][n] = (f32x4){bflo(rr.x), bfhi(rr.x), bflo(rr.y), bfhi(rr.y)}; }
                        else rv[m][bj][n] = *(const f32x4*)(resf + oo); }
#pragma unroll
            for (int m = 0; m < 4; ++m) {
                const int row = row0 + ai * 128 + m * 16; const size_t o = (size_t)row * 1024 + col0; float s = 0.f;
#pragma unroll
                for (int bj = 0; bj < 2; ++bj)
#pragma unroll
                    for (int n = 0; n < 2; ++n) {
                        const size_t oo = o + bj * 128 + n * 16; const f32x4 v = rv[m][bj][n] + acc[ai][bj][m][n];
                        u32x2 w; w.x = pk2(v[0], v[1]); w.y = pk2(v[2], v[3]); *(u32x2*)(xb + oo) = w;
                        s += (v[0] * v[0] + v[1] * v[1]) + (v[2] * v[2] + v[3] * v[3]);
                    }
                s += __shfl_xor(s, 16); s += __shfl_xor(s, 32);
                if (fq == 0) atomicAdd(ss + row, s);
            }
        }
    }
};

template <int ACT> struct EpiScale {
    static constexpr bool PERM = true, AFTER_DRAIN = false;
    bf16_t* O; int ldc; const float* ss; float scale;
    __device__ __forceinline__ void operator()(const f32x4 (&acc)[2][2][4][2], const pg8::Unit& u, int wr, int wc, int fr, int fq) const {
        const int row0 = u.pm * 256 + wr * 64 + fr, col0 = u.pn * 256 + wc * 32 + 8 * fq;
        float ssv[2][4];
#pragma unroll
        for (int ai = 0; ai < 2; ++ai)
#pragma unroll
            for (int m = 0; m < 4; ++m) ssv[ai][m] = ss[row0 + ai * 128 + m * 16];
#pragma unroll
        for (int ai = 0; ai < 2; ++ai)
#pragma unroll
            for (int m = 0; m < 4; ++m) {
                const int row = row0 + ai * 128 + m * 16;
                const float rs = rsqrtf(ssv[ai][m] * (1.0f / 1024.0f) + EPS) * scale;
                bf16_t* rowp = O + (size_t)row * ldc + col0;
#pragma unroll
                for (int bj = 0; bj < 2; ++bj) {
                    f32x4 v0 = acc[ai][bj][m][0] * rs, v1 = acc[ai][bj][m][1] * rs;
                    if (ACT == 1) {
#pragma unroll
                        for (int j = 0; j < 4; ++j) { const float a = fmaxf(v0[j], 0.f), b = fmaxf(v1[j], 0.f); v0[j] = a * a; v1[j] = b * b; } }
                    u32x4 w; w.x = pk2(v0[0], v0[1]); w.y = pk2(v0[2], v0[3]); w.z = pk2(v1[0], v1[1]); w.w = pk2(v1[2], v1[3]);
                    *(u32x4*)(rowp + bj * 128) = w;
                }
            }
    }
};

struct WDesc { const float* W; const float* gain; bf16_t* Wt; int K, N, t; };
__device__ __forceinline__ WDesc wdesc(const Ctx& C, int t) {
    WDesc d;
    if (t < 768) d = WDesc{C.in[8], nullptr, C.wsb(WS_WIN), 1024, 3072, t};
    else if (t < 1024) d = WDesc{C.in[14], nullptr, C.wsb(WS_WOUT), 1024, 1024, t - 768};
    else if (t < 1280) d = WDesc{C.in[17], C.in[15], C.wsb(WS_WCQ), 1024, 1024, t - 1024};
    else if (t < 1536) d = WDesc{C.in[18], nullptr, C.wsb(WS_WCKV), 1024, 1024, t - 1280};
    else if (t < 1792) d = WDesc{C.in[19], nullptr, C.wsb(WS_WCKV) + 1024 * 1024, 1024, 1024, t - 1536};
    else if (t < 2048) d = WDesc{C.in[20], nullptr, C.wsb(WS_WCO), 1024, 1024, t - 1792};
    else if (t < 3072) d = WDesc{C.in[22], C.in[21], C.wsb(WS_WUP), 1024, 4096, t - 2048};
    else d = WDesc{C.in[23], nullptr, C.wsb(WS_WDN), 4096, 1024, t - 3072};
    return d;
}
__device__ __forceinline__ void cvt_load(const WDesc& d, f32x4 (&v)[2], float (&gq)[2]) {
    const int tid = threadIdx.x; const int ntn = d.N >> 6; const int kt = d.t / ntn, nt = d.t - kt * ntn; const int k0 = kt * 64, n0 = nt * 64;
#pragma unroll
    for (int p = 0; p < 2; ++p) { const int k = p * 32 + (tid >> 4), n4 = (tid & 15) * 4;
        v[p] = *(const f32x4*)(d.W + (size_t)(k0 + k) * d.N + n0 + n4); gq[p] = d.gain ? d.gain[k0 + k] : 1.0f; }
}
__device__ __forceinline__ void cvt_store(const WDesc& d, const f32x4 (&v)[2], const float (&gq)[2], LAS float* tl) {
    const int tid = threadIdx.x; const int ntn = d.N >> 6; const int kt = d.t / ntn, nt = d.t - kt * ntn; const int k0 = kt * 64, n0 = nt * 64;
#pragma unroll
    for (int p = 0; p < 2; ++p) { const int k = p * 32 + (tid >> 4), n4 = (tid & 15) * 4; const f32x4 x = v[p] * gq[p];
        tl[k * 65 + n4 + 0] = x[0]; tl[k * 65 + n4 + 1] = x[1]; tl[k * 65 + n4 + 2] = x[2]; tl[k * 65 + n4 + 3] = x[3]; }
    __syncthreads();
    {
        const int n = tid >> 3, k8 = (tid & 7) * 8; float r[8];
#pragma unroll
        for (int j = 0; j < 8; ++j) r[j] = tl[(k8 + j) * 65 + n];
        u32x4 w; w.x = pk2(r[0], r[1]); w.y = pk2(r[2], r[3]); w.z = pk2(r[4], r[5]); w.w = pk2(r[6], r[7]);
        *(u32x4*)(d.Wt + (size_t)(n0 + n) * d.K + k0 + k8) = w;
    }
    __syncthreads();
}

__device__ __forceinline__ void phase_prep(const Ctx& C, LAS unsigned char* lds) {
    const int tid = threadIdx.x, lane = tid & 63, wid = tid >> 6;
    LAS float* tl = (LAS float*)lds;
    {
        int t = blockIdx.x; WDesc d = wdesc(C, t < 4096 ? t : 0); f32x4 v[2]; float gq[2];
        if (t < 4096) cvt_load(d, v, gq);
        for (; t < 4096; t += gridDim.x) {
            const int tn = t + gridDim.x; WDesc dn = wdesc(C, tn < 4096 ? tn : 0); f32x4 vn[2]; float gn[2];
            if (tn < 4096) cvt_load(dn, vn, gn); else { vn[0] = v[0]; vn[1] = v[1]; gn[0] = gq[0]; gn[1] = gq[1]; }
            cvt_store(d, v, gq, tl);
            d = dn; v[0] = vn[0]; v[1] = vn[1]; gq[0] = gn[0]; gq[1] = gn[1];
        }
    }
    {
        const int NR = MT + NMR, stride = gridDim.x * 8; int r = blockIdx.x * 8 + wid;
        f32x4 v[4];
#define ROWSRC(rr) ((rr) < MP ? C.in[0] + (size_t)(rr) * 1024 : ((rr) < MT ? C.in[1] + (size_t)((rr) - MP) * 1024 : C.in[2] + (size_t)((rr) - MT) * 1024))
        if (r < NR) { const float* src = ROWSRC(r);
#pragma unroll
            for (int i = 0; i < 4; ++i) v[i] = *(const f32x4*)(src + i * 256 + lane * 4); }
        for (; r < NR; r += stride) {
            const int rn = r + stride; f32x4 vn[4];
            if (rn < NR) { const float* src = ROWSRC(rn);
#pragma unroll
                for (int i = 0; i < 4; ++i) vn[i] = *(const f32x4*)(src + i * 256 + lane * 4); }
            else {
#pragma unroll
                for (int i = 0; i < 4; ++i) vn[i] = v[i]; }
            const float* g = (r < MT) ? C.in[7] : C.in[16]; bf16_t* dst = (r < MT) ? C.wsb(WS_HN) + (size_t)r * 1024 : C.wsb(WS_MEMN) + (size_t)(r - MT) * 1024;
            f32x4 gg[4];
#pragma unroll
            for (int i = 0; i < 4; ++i) gg[i] = *(const f32x4*)(g + i * 256 + lane * 4);
            float s = 0.f;
#pragma unroll
            for (int i = 0; i < 4; ++i) s += (v[i][0] * v[i][0] + v[i][1] * v[i][1]) + (v[i][2] * v[i][2] + v[i][3] * v[i][3]);
#pragma unroll
            for (int o = 32; o >= 1; o >>= 1) s += __shfl_xor(s, o);
            const float rs = rsqrtf(s * (1.0f / 1024.0f) + EPS);
#pragma unroll
            for (int i = 0; i < 4; ++i) { const f32x4 y = v[i] * rs * gg[i]; u32x2 w; w.x = pk2(y[0], y[1]); w.y = pk2(y[2], y[3]); *(u32x2*)(dst + i * 256 + lane * 4) = w; }
#pragma unroll
            for (int i = 0; i < 4; ++i) v[i] = vn[i];
        }
#undef ROWSRC
    }
    float* ss = C.wsf(WS_SS);
    for (int i = blockIdx.x * NTHR + tid; i < 3 * MT; i += gridDim.x * NTHR) ss[i] = 0.f;
}

__device__ __forceinline__ bf16x8 ld8(const LAS bf16_t* p) { return *(const LAS bf16x8*)p; }
__device__ __forceinline__ bf16x8 gld8(const bf16_t* p) { return *(const bf16x8*)p; }
#define MFMA16(a, b, c) __builtin_amdgcn_mfma_f32_16x16x32_bf16((a), (b), (c), 0, 0, 0)

__device__ __forceinline__ void hg_load(const Ctx& C, int item, unsigned (&rq)[16], unsigned (&rk)[16], unsigned (&rl)[16], unsigned (&rv)[16]) {
    const int tid = threadIdx.x; const int b = item >> 7, c = (item >> 2) & 31, h = item & 3; const int k = tid & 127, i = tid >> 7;
    const size_t o = ((size_t)b * 2048 + c * 64 + 16 * i) * 512 + h * 128 + k;
    const bf16_t* pq = C.Z(0) + o; const bf16_t* pk = C.Z(1) + o; const bf16_t* pl = C.Z(2) + o; const bf16_t* pv = C.Z(3) + o;
#pragma unroll
    for (int t = 0; t < 16; ++t) { rq[t] = pq[t * 512]; rk[t] = pk[t * 512]; rl[t] = pl[t * 512]; rv[t] = pv[t * 512]; }
}
__device__ __forceinline__ void hg_intra(const Ctx& C, LAS unsigned char* lds, int item, int next_item, unsigned (&rq)[16], unsigned (&rk)[16], unsigned (&rl)[16], unsigned (&rv)[16]) {
    const int tid = threadIdx.x, lane = tid & 63, wid = tid >> 6, r = lane & 15, qd = lane >> 4;
    const int b = item >> 7, c = (item >> 2) & 31, h = item & 3;
    const size_t row0 = (size_t)b * 2048 + c * 64; const int hc = h * 128;
    LAS bf16_t* sQV = (LAS bf16_t*)lds;
    LAS bf16_t* sKE = sQV + 7 * 2176;
    LAS bf16_t* sKD = sKE + 3 * 2176;
    LAS bf16_t* sKT = sKD + 4 * 2176;
    LAS bf16_t* sVT = sKT + 128 * 72;
    LAS bf16_t* sA = sVT + 128 * 72;
    LAS float* sTot = (LAS float*)(sA + 64 * 72);
    const int k = tid & 127, i = tid >> 7;
    float q[16], kk[16], bl[16];
    {
        float lf[16]; unsigned vv[16];
#pragma unroll
        for (int t = 0; t < 16; ++t) { q[t] = __uint_as_float(rq[t] << 16); kk[t] = __uint_as_float(rk[t] << 16); lf[t] = __uint_as_float(rl[t] << 16); vv[t] = rv[t]; }
        if (next_item < 1024) hg_load(C, next_item, rq, rk, rl, rv);
        float cum = 0.f;
#pragma unroll
        for (int t = 0; t < 16; ++t) { cum += lf[t]; bl[t] = cum; }
        sTot[i * 128 + k] = cum;
        u32x4 w0, w1;
        w0.x = vv[0] | (vv[1] << 16); w0.y = vv[2] | (vv[3] << 16); w0.z = vv[4] | (vv[5] << 16); w0.w = vv[6] | (vv[7] << 16);
        w1.x = vv[8] | (vv[9] << 16); w1.y = vv[10] | (vv[11] << 16); w1.z = vv[12] | (vv[13] << 16); w1.w = vv[14] | (vv[15] << 16);
        *(LAS u32x4*)(sVT + k * 72 + 16 * i) = w0; *(LAS u32x4*)(sVT + k * 72 + 16 * i + 8) = w1;
    }
    __syncthreads();
    {
        const float t0 = sTot[k], t1 = sTot[128 + k], t2 = sTot[256 + k], t3 = sTot[384 + k];
        const float bend0 = t0, bend1 = t0 + t1, bend2 = bend1 + t2, blast = bend2 + t3;
        const float bstart = (i == 0) ? 0.f : ((i == 1) ? bend0 : ((i == 2) ? bend1 : bend2));
        const float cum = bl[15];
        const float cE = __expf(bstart), c0 = __expf(bstart - bend0), c1 = __expf(bstart - bend1), cdec = __expf(blast - (bstart + cum));
        const int idD = (i == 0) ? 0 : (1 + ((i - 1) * i) / 2 + (i - 1));
        const int id0 = 1 + ((i - 1) * i) / 2;
        bf16_t* pqe = C.Z(7) + (row0 + 16 * i) * 512 + hc + k;
        unsigned kd16[16];
#pragma unroll
        for (int t = 0; t < 16; ++t) {
            const float e = __expf(bl[t]), ei = __expf(-bl[t]), ek = __expf(cum - bl[t]);
            const float qdv = q[t] * e, kdv = kk[t] * ei, kev = kk[t] * ek;
            sQV[(idD * 16 + t) * 136 + k] = f2bf(qdv);
            if (i >= 2) sQV[(id0 * 16 + t) * 136 + k] = f2bf(qdv * c0);
            if (i == 3) sQV[(5 * 16 + t) * 136 + k] = f2bf(qdv * c1);
            sKD[(i * 16 + t) * 136 + k] = f2bf(kdv);
            if (i < 3) sKE[(i * 16 + t) * 136 + k] = f2bf(kev);
            kd16[t] = f2bf(kev * cdec);
            pqe[t * 512] = f2bf(qdv * cE);
        }
        u32x4 w0, w1;
        w0.x = kd16[0] | (kd16[1] << 16); w0.y = kd16[2] | (kd16[3] << 16); w0.z = kd16[4] | (kd16[5] << 16); w0.w = kd16[6] | (kd16[7] << 16);
        w1.x = kd16[8] | (kd16[9] << 16); w1.y = kd16[10] | (kd16[11] << 16); w1.z = kd16[12] | (kd16[13] << 16); w1.w = kd16[14] | (kd16[15] << 16);
        *(LAS u32x4*)(sKT + k * 72 + 16 * i) = w0; *(LAS u32x4*)(sKT + k * 72 + 16 * i + 8) = w1;
        if (i == 0) C.wsf(WS_DEC)[(size_t)item * 128 + k] = __expf(blast);
    }
    __syncthreads();
#pragma unroll
    for (int x = 0; x < 2; ++x) {
        const int tile = wid * 2 + x, ti = tile >> 2, tj = tile & 3;
        f32x4 d = {0.f, 0.f, 0.f, 0.f};
        if (tj <= ti) {
            const int ida = (ti == 0) ? 0 : (1 + ((ti - 1) * ti) / 2 + ((tj == ti) ? ti - 1 : tj));
            const LAS bf16_t* Aop = sQV + ida * 2176 + r * 136 + qd * 8;
            const LAS bf16_t* Bop = ((tj == ti) ? (sKD + ti * 2176) : (sKE + tj * 2176)) + r * 136 + qd * 8;
#pragma unroll
            for (int k4 = 0; k4 < 4; ++k4) d = MFMA16(ld8(Aop + k4 * 32), ld8(Bop + k4 * 32), d);
        }
#pragma unroll
        for (int jx = 0; jx < 4; ++jx) { const int t = 4 * qd + jx; const bool keep = (tj < ti) || (tj == ti && r <= t);
            sA[(16 * ti + t) * 72 + 16 * tj + r] = f2bf(keep ? d[jx] : 0.f); }
    }
    __syncthreads();
    {
        bf16_t* OI = C.wsb(WS_OI); bf16_t* DS = C.wsb(WS_DS) + (size_t)item * 16384;
        const bf16x8 v0 = ld8(sVT + (16 * wid + r) * 72 + qd * 8), v1 = ld8(sVT + (16 * wid + r) * 72 + 32 + qd * 8);
#pragma unroll
        for (int ti = 0; ti < 4; ++ti) {
            f32x4 d = {0.f, 0.f, 0.f, 0.f};
            d = MFMA16(v0, ld8(sA + (16 * ti + r) * 72 + qd * 8), d);
            d = MFMA16(v1, ld8(sA + (16 * ti + r) * 72 + 32 + qd * 8), d);
            u32x2 w; w.x = pk2(d[0], d[1]); w.y = pk2(d[2], d[3]);
            *(u32x2*)(OI + (row0 + 16 * ti + r) * 512 + hc + 16 * wid + 4 * qd) = w;
        }
#pragma unroll
        for (int kt = 0; kt < 8; ++kt) {
            f32x4 d = {0.f, 0.f, 0.f, 0.f};
            d = MFMA16(ld8(sKT + (16 * kt + r) * 72 + qd * 8), v0, d);
            d = MFMA16(ld8(sKT + (16 * kt + r) * 72 + 32 + qd * 8), v1, d);
            u32x2 w; w.x = pk2(d[0], d[1]); w.y = pk2(d[2], d[3]);
            *(u32x2*)(DS + (16 * wid + r) * 128 + 16 * kt + 4 * qd) = w;
        }
    }
    __syncthreads();
}

__device__ __forceinline__ void hg_scan(const Ctx& C) {
    const bf16_t* __restrict__ DS = C.wsb(WS_DS); bf16_t* __restrict__ SC = C.wsb(WS_SC); const float* __restrict__ DEC = C.wsf(WS_DEC);
    float* __restrict__ outS = C.out + OUT_SP;
    for (int g = blockIdx.x * NTHR + threadIdx.x; g < 32 * 4096; g += gridDim.x * NTHR) {
        const int bh = g >> 12, e = g & 4095, v = e >> 5, k4 = (e & 31) * 4, b = bh >> 2, h = bh & 3;
        float S0 = 0.f, S1 = 0.f, S2 = 0.f, S3 = 0.f;
#pragma unroll 16
        for (int c = 0; c < 32; ++c) {
            const int item = b * 128 + c * 4 + h; const size_t off = (size_t)item * 16384 + v * 128 + k4;
            u32x2 w; w.x = pk2(S0, S1); w.y = pk2(S2, S3); *(u32x2*)(SC + off) = w;
            const f32x4 dc = *(const f32x4*)(DEC + (size_t)item * 128 + k4); const u32x2 ds = *(const u32x2*)(DS + off);
            S0 = dc[0] * S0 + bflo(ds.x); S1 = dc[1] * S1 + bfhi(ds.x); S2 = dc[2] * S2 + bflo(ds.y); S3 = dc[3] * S3 + bfhi(ds.y);
        }
        float* o = outS + ((size_t)(b * 4 + h) * 128 + k4) * 128 + v;
        o[0] = S0; o[128] = S1; o[256] = S2; o[384] = S3;
    }
}

__device__ __forceinline__ void gmlp_item(const Ctx& C, LAS unsigned char* lds, int item) {
    const int tid = threadIdx.x, lane = tid & 63, wid = tid >> 6, r = lane & 15, qd = lane >> 4;
    const int n = item >> 2, g = item & 3; const size_t rb = (size_t)n * 128;
    LAS bf16_t* sW = (LAS bf16_t*)lds;
    LAS bf16_t* sVN = sW + 128 * 136;
    LAS float* sSt = (LAS float*)(sVN + 128 * 136);
    const bf16_t* Zgv = C.Z(6); const bf16_t* Zu = C.Z(5);
    u32x4 gvt[4]; u32x2 uu8[8]; float bb8[8];
#pragma unroll
    for (int it = 0; it < 4; ++it) { const int e = it * NTHR + tid; gvt[it] = *(const u32x4*)(Zgv + (rb + (e >> 4)) * 512 + g * 128 + (e & 15) * 8); }
#pragma unroll
    for (int ti = 0; ti < 8; ++ti) { uu8[ti] = *(const u32x2*)(Zu + (rb + 16 * ti + r) * 512 + g * 128 + 16 * wid + 4 * qd); bb8[ti] = C.in[13][g * 128 + 16 * ti + r]; }
    {
        const int row = tid >> 2, qt = tid & 3; const bf16_t* p = Zgv + (rb + row) * 512 + qt * 128;
        float s = 0.f, s2 = 0.f;
#pragma unroll
        for (int i = 0; i < 16; ++i) { const u32x4 w = *(const u32x4*)(p + i * 8);
#pragma unroll
            for (int j = 0; j < 4; ++j) { const float a = bflo(w[j]), bb = bfhi(w[j]); s += a + bb; s2 += a * a + bb * bb; } }
        s += __shfl_xor(s, 1); s2 += __shfl_xor(s2, 1); s += __shfl_xor(s, 2); s2 += __shfl_xor(s2, 2);
        const float mean = s * (1.0f / 512.0f), var = fmaxf(s2 * (1.0f / 512.0f) - mean * mean, 0.f);
        if (qt == 0) { sSt[row * 2] = mean; sSt[row * 2 + 1] = rsqrtf(var + EPS); }
    }
    {
        const float* W = C.in[12] + (size_t)g * 16384;
#pragma unroll
        for (int it = 0; it < 8; ++it) { const int e = (it * NTHR + tid) * 4, t = e >> 7, s = e & 127; const f32x4 v = *(const f32x4*)(W + e);
            u32x2 w; w.x = pk2(s <= t ? v[0] : 0.f, s + 1 <= t ? v[1] : 0.f); w.y = pk2(s + 2 <= t ? v[2] : 0.f, s + 3 <= t ? v[3] : 0.f);
            *(LAS u32x2*)(sW + t * 136 + s) = w; }
    }
    __syncthreads();
    {
        const float* lgp = C.in[10] + g * 128; const float* lbp2 = C.in[11] + g * 128;
#pragma unroll
        for (int it = 0; it < 4; ++it) { const int e = it * NTHR + tid, sx = e >> 4, c8 = (e & 15) * 8;
            const u32x4 w = gvt[it]; const float mean = sSt[sx * 2], rs = sSt[sx * 2 + 1];
            const f32x4 g0 = *(const f32x4*)(lgp + c8), g1 = *(const f32x4*)(lgp + c8 + 4), b0 = *(const f32x4*)(lbp2 + c8), b1 = *(const f32x4*)(lbp2 + c8 + 4);
            u32x4 o;
            o.x = pk2((bflo(w.x) - mean) * rs * g0[0] + b0[0], (bfhi(w.x) - mean) * rs * g0[1] + b0[1]);
            o.y = pk2((bflo(w.y) - mean) * rs * g0[2] + b0[2], (bfhi(w.y) - mean) * rs * g0[3] + b0[3]);
            o.z = pk2((bflo(w.z) - mean) * rs * g1[0] + b1[0], (bfhi(w.z) - mean) * rs * g1[1] + b1[1]);
            o.w = pk2((bflo(w.w) - mean) * rs * g1[2] + b1[2], (bfhi(w.w) - mean) * rs * g1[3] + b1[3]);
            *(LAS u32x4*)(sVN + sx * 136 + c8) = o; }
    }
    __syncthreads();
    {
        bf16_t* O = C.wsb(WS_O);
        bf16x8 bfr[4];
#pragma unroll
        for (int k4 = 0; k4 < 4; ++k4) { unsigned x[8];
#pragma unroll
            for (int j = 0; j < 8; ++j) x[j] = sVN[(k4 * 32 + qd * 8 + j) * 136 + 16 * wid + r];
            u32x4 w; w.x = x[0] | (x[1] << 16); w.y = x[2] | (x[3] << 16); w.z = x[4] | (x[5] << 16); w.w = x[6] | (x[7] << 16);
            bfr[k4] = __builtin_bit_cast(bf16x8, w); }
#pragma unroll
        for (int ti = 0; ti < 8; ++ti) {
            f32x4 d = {0.f, 0.f, 0.f, 0.f};
#pragma unroll
            for (int k4 = 0; k4 < 4; ++k4) if (k4 <= (ti >> 1)) d = MFMA16(bfr[k4], ld8(sW + (16 * ti + r) * 136 + k4 * 32 + qd * 8), d);
            const int t = 16 * ti + r, cc = g * 128 + 16 * wid + 4 * qd; const float bb = bb8[ti];
            const u32x2 uu = uu8[ti];
            u32x2 w; w.x = pk2(bflo(uu.x) * (d[0] + bb), bfhi(uu.x) * (d[1] + bb)); w.y = pk2(bflo(uu.y) * (d[2] + bb), bfhi(uu.y) * (d[3] + bb));
            *(u32x2*)(O + (rb + t) * 1024 + 512 + cc) = w;
        }
    }
    __syncthreads();
}

__device__ __forceinline__ void hg_sample_item(const Ctx& C, LAS unsigned char* lds, int item) {
    const int tid = threadIdx.x, lane = tid & 63, wid = tid >> 6;
    const int bs = item >> 2, h = item & 3, hc = h * 128; const size_t r0 = (size_t)MP + bs * 4;
    LAS float* sq = (LAS float*)lds; LAS float* sk = sq + 512; LAS float* sf = sk + 512;
    LAS float* sp = sf + 512;
    LAS float* sred = sp + 2048;
    {
        const int t = tid >> 7, k = tid & 127; const size_t o = (r0 + t) * 512 + hc + k;
        sq[tid] = bf2f(C.Z(0)[o]); sk[tid] = bf2f(C.Z(1)[o]); sf[tid] = __expf(bf2f(C.Z(2)[o]));
    }
    const int v = tid & 127, kq = tid >> 7;
    const float gg_pre = bf2f(C.Z(4)[(r0 + (tid >> 7)) * 512 + hc + v]), hgn_pre = C.in[9][hc + v];
    float S[32];
    const float* sin = C.in[3] + (size_t)item * 16384 + (size_t)(kq * 32) * 128 + v;
#pragma unroll
    for (int j = 0; j < 32; ++j) S[j] = sin[j * 128];
    float vt[4];
#pragma unroll
    for (int t = 0; t < 4; ++t) vt[t] = bf2f(C.Z(3)[(r0 + t) * 512 + hc + v]);
    __syncthreads();
#pragma unroll
    for (int t = 0; t < 4; ++t) {
        float po = 0.f;
#pragma unroll
        for (int j = 0; j < 32; ++j) { const int k = kq * 32 + j; S[j] = sf[t * 128 + k] * S[j] + sk[t * 128 + k] * vt[t]; po += S[j] * sq[t * 128 + k]; }
        sp[(kq * 4 + t) * 128 + v] = po;
    }
    float* sout = C.out + OUT_SSMP + (size_t)item * 16384 + (size_t)(kq * 32) * 128 + v;
#pragma unroll
    for (int j = 0; j < 32; ++j) sout[j * 128] = S[j];
    __syncthreads();
    {
        const int t = tid >> 7;
        const float o = sp[(0 * 4 + t) * 128 + v] + sp[(1 * 4 + t) * 128 + v] + sp[(2 * 4 + t) * 128 + v] + sp[(3 * 4 + t) * 128 + v];
        float s = o * o;
#pragma unroll
        for (int x = 32; x >= 1; x >>= 1) s += __shfl_xor(s, x);
        if (lane == 0) sred[wid] = s;
        __syncthreads();
        const float ms = (sred[2 * t] + sred[2 * t + 1]) * (1.0f / 128.0f);
        C.wsb(WS_O)[(r0 + t) * 1024 + hc + v] = f2bf(o * rsqrtf(ms + EPS) * hgn_pre * gg_pre);
    }
    __syncthreads();
}

__device__ __forceinline__ void gmlp_sample_item(const Ctx& C, LAS unsigned char* lds, int bs) {
    const int tid = threadIdx.x, lane = tid & 63, wid = tid >> 6; const size_t r0 = (size_t)MP + bs * 4;
    LAS float* sred = (LAS float*)lds;
    const int c = tid, g = c >> 7;
    float gv[4], s[4], s2[4], uuv[4], bsv[4], wv[10];
    const float lg = C.in[10][c], lbb = C.in[11][c];
    { const float* W = C.in[12] + (size_t)g * 16384; const float* bsp = C.in[13] + g * 128; int q = 0;
#pragma unroll
      for (int t = 0; t < 4; ++t) { bsv[t] = bsp[t]; uuv[t] = bf2f(C.Z(5)[(r0 + t) * 512 + c]);
#pragma unroll
          for (int sx = 0; sx < 4; ++sx) if (sx <= t) wv[q++] = W[t * 128 + sx]; } }
#pragma unroll
    for (int t = 0; t < 4; ++t) { gv[t] = bf2f(C.Z(6)[(r0 + t) * 512 + c]); s[t] = gv[t]; s2[t] = gv[t] * gv[t]; }
#pragma unroll
    for (int t = 0; t < 4; ++t)
#pragma unroll
        for (int x = 32; x >= 1; x >>= 1) { s[t] += __shfl_xor(s[t], x); s2[t] += __shfl_xor(s2[t], x); }
    if (lane == 0) {
#pragma unroll
        for (int t = 0; t < 4; ++t) { sred[wid * 8 + t] = s[t]; sred[wid * 8 + 4 + t] = s2[t]; } }
    __syncthreads();
    float vn[4];
#pragma unroll
    for (int t = 0; t < 4; ++t) { float a = 0.f, a2 = 0.f;
#pragma unroll
        for (int w = 0; w < 8; ++w) { a += sred[w * 8 + t]; a2 += sred[w * 8 + 4 + t]; }
        const float mean = a * (1.0f / 512.0f), var = fmaxf(a2 * (1.0f / 512.0f) - mean * mean, 0.f);
        vn[t] = (gv[t] - mean) * rsqrtf(var + EPS) * lg + lbb;
        C.out[OUT_CMV + ((size_t)bs * 4 + t) * 512 + c] = vn[t]; }
    { int q = 0;
#pragma unroll
      for (int t = 0; t < 4; ++t) { float mix = bsv[t];
#pragma unroll
          for (int sx = 0; sx < 4; ++sx) if (sx <= t) mix += wv[q++] * vn[sx];
          C.wsb(WS_O)[(r0 + t) * 1024 + 512 + c] = f2bf(uuv[t] * mix); } }
    __syncthreads();
}

__device__ __forceinline__ void hg_out(const Ctx& C, LAS unsigned char* lds) {
    const int tid = threadIdx.x, lane = tid & 63, wid = tid >> 6, r = lane & 15, qd = lane >> 4;
    const bf16_t* __restrict__ QE = C.Z(7); const bf16_t* __restrict__ SC = C.wsb(WS_SC); const bf16_t* __restrict__ OI = C.wsb(WS_OI); const bf16_t* __restrict__ Zg = C.Z(4); bf16_t* __restrict__ O = C.wsb(WS_O);
    const float* hgn = C.in[9];
    LAS bf16_t* sS = (LAS bf16_t*)lds;
    const int sv = (tid >> 4) & 127, sk8 = (tid & 15) * 8;
    u32x4 st[8];
    int p = blockIdx.x;
#define HGO_LOAD(pp) do { _Pragma("unroll") for (int it = 0; it < 8; ++it) { const int e = it * NTHR + tid; \
        st[it] = *(const u32x4*)(SC + (size_t)(2 * (pp) + (e >> 11)) * 16384 + ((e & 2047) >> 4) * 128 + (e & 15) * 8); } } while (0)
    if (p < 512) HGO_LOAD(p);
    for (; p < 512; p += gridDim.x) {
        const int item = 2 * p + (wid >> 2), ti = wid & 3; const int b = item >> 7, c = (item >> 2) & 31, h = item & 3, hc = h * 128;
        const size_t row = (size_t)b * 2048 + c * 64 + 16 * ti + r;
        bf16x8 a[4];
#pragma unroll
        for (int k4 = 0; k4 < 4; ++k4) a[k4] = gld8(QE + row * 512 + hc + k4 * 32 + qd * 8);
        u32x2 oi[8], gg[8];
#pragma unroll
        for (int vt = 0; vt < 8; ++vt) { oi[vt] = *(const u32x2*)(OI + row * 512 + hc + 16 * vt + 4 * qd); gg[vt] = *(const u32x2*)(Zg + row * 512 + hc + 16 * vt + 4 * qd); }
        __syncthreads();
#pragma unroll
        for (int it = 0; it < 8; ++it) { const int e = it * NTHR + tid; *(LAS u32x4*)(sS + (e >> 11) * (128 * 136) + ((e & 2047) >> 4) * 136 + (e & 15) * 8) = st[it]; }
        __syncthreads();
        if (p + (int)gridDim.x < 512) HGO_LOAD(p + gridDim.x);
        const LAS bf16_t* sT = sS + (wid >> 2) * (128 * 136);
        f32x4 d[8];
#pragma unroll
        for (int vt = 0; vt < 8; ++vt) { d[vt] = (f32x4){0.f, 0.f, 0.f, 0.f};
#pragma unroll
            for (int k4 = 0; k4 < 4; ++k4) d[vt] = MFMA16(ld8(sT + (16 * vt + r) * 136 + k4 * 32 + qd * 8), a[k4], d[vt]); }
        float sq = 0.f;
#pragma unroll
        for (int vt = 0; vt < 8; ++vt) {
            d[vt][0] += bflo(oi[vt].x); d[vt][1] += bfhi(oi[vt].x); d[vt][2] += bflo(oi[vt].y); d[vt][3] += bfhi(oi[vt].y);
            sq += (d[vt][0] * d[vt][0] + d[vt][1] * d[vt][1]) + (d[vt][2] * d[vt][2] + d[vt][3] * d[vt][3]); }
        sq += __shfl_xor(sq, 16); sq += __shfl_xor(sq, 32);
        const float rs = rsqrtf(sq * (1.0f / 128.0f) + EPS);
#pragma unroll
        for (int vt = 0; vt < 8; ++vt) { const int cc = hc + 16 * vt + 4 * qd; const f32x4 gn = *(const f32x4*)(hgn + cc);
            u32x2 w; w.x = pk2(d[vt][0] * rs * gn[0] * bflo(gg[vt].x), d[vt][1] * rs * gn[1] * bfhi(gg[vt].x)); w.y = pk2(d[vt][2] * rs * gn[2] * bflo(gg[vt].y), d[vt][3] * rs * gn[3] * bfhi(gg[vt].y));
            *(u32x2*)(O + row * 1024 + cc) = w; }
    }
#undef HGO_LOAD
    __syncthreads();
    (void)sv; (void)sk8;
}

__device__ __forceinline__ void attn_prompt_item(const Ctx& C, LAS unsigned char* lds, int item) {
    const int tid = threadIdx.x, lane = tid & 63, wid = tid >> 6, r = lane & 15, qd = lane >> 4;
    const int b = item >> 5, h = (item >> 3) & 3, qt = item & 7;
    int opq = 0; asm volatile("" : "+v"(opq));
    LAS bf16_t* sK = (LAS bf16_t*)lds + opq;
    const bf16_t* KB = C.wsb(WS_KB); const bf16_t* VT = C.wsb(WS_VT); const bf16_t* HQ = C.wsb(WS_HQ); bf16_t* CA = C.wsb(WS_CA);
    const size_t q0 = (size_t)b * 2048 + qt * 256 + wid * 32;
    {   const bf16_t* gsrc = KB + ((size_t)b * 256 + (tid >> 5)) * 1024 + h * 256 + (tid & 31) * 8; LAS bf16_t* ldst = sK + (tid >> 5) * 264 + (tid & 31) * 8;
        u32x4 stg[16];
#pragma unroll
        for (int it = 0; it < 16; ++it) stg[it] = *(const u32x4*)(gsrc + (size_t)it * 16 * 1024);
#pragma unroll
        for (int it = 0; it < 16; ++it) *(LAS u32x4*)(ldst + it * 16 * 264) = stg[it]; }
    bf16x8 qf[2][8];
#pragma unroll
    for (int x = 0; x < 2; ++x)
#pragma unroll
        for (int k8 = 0; k8 < 8; ++k8) qf[x][k8] = gld8(HQ + (q0 + x * 16 + r) * 1024 + h * 256 + k8 * 32 + qd * 8);
    __syncthreads();
    bf16x8 pf[2][8];
    {
        f32x4 s[2][16];
#pragma unroll
        for (int mt = 0; mt < 16; ++mt) { s[0][mt] = (f32x4){0.f, 0.f, 0.f, 0.f}; s[1][mt] = (f32x4){0.f, 0.f, 0.f, 0.f};
#pragma unroll
            for (int k8 = 0; k8 < 8; ++k8) { const bf16x8 kf = ld8(sK + (16 * mt + r) * 264 + k8 * 32 + qd * 8);
                s[0][mt] = MFMA16(kf, qf[0][k8], s[0][mt]); s[1][mt] = MFMA16(kf, qf[1][k8], s[1][mt]); } }
#pragma unroll
        for (int x = 0; x < 2; ++x) {
            float mx = -3.0e38f;
#pragma unroll
            for (int mt = 0; mt < 16; ++mt)
#pragma unroll
                for (int jx = 0; jx < 4; ++jx) mx = fmaxf(mx, s[x][mt][jx]);
            mx = fmaxf(mx, __shfl_xor(mx, 16)); mx = fmaxf(mx, __shfl_xor(mx, 32));
            float sum = 0.f;
#pragma unroll
            for (int mt = 0; mt < 16; ++mt)
#pragma unroll
                for (int jx = 0; jx < 4; ++jx) { const float e = __expf(s[x][mt][jx] - mx); s[x][mt][jx] = e; sum += e; }
            sum += __shfl_xor(sum, 16); sum += __shfl_xor(sum, 32);
            const float inv = __builtin_amdgcn_rcpf(sum);
#pragma unroll
            for (int k8 = 0; k8 < 8; ++k8) { u32x4 w; w.x = pk2(s[x][2 * k8][0] * inv, s[x][2 * k8][1] * inv); w.y = pk2(s[x][2 * k8][2] * inv, s[x][2 * k8][3] * inv);
                w.z = pk2(s[x][2 * k8 + 1][0] * inv, s[x][2 * k8 + 1][1] * inv); w.w = pk2(s[x][2 * k8 + 1][2] * inv, s[x][2 * k8 + 1][3] * inv);
                pf[x][k8] = __builtin_bit_cast(bf16x8, w); }
        }
    }
    __syncthreads();
    {   const bf16_t* gsrc = VT + ((size_t)b * 1024 + h * 256 + (tid >> 5)) * 256 + (tid & 31) * 8; LAS bf16_t* ldst = sK + (tid >> 5) * 264 + (tid & 31) * 8;
        u32x4 stg[16];
#pragma unroll
        for (int it = 0; it < 16; ++it) stg[it] = *(const u32x4*)(gsrc + (size_t)it * 16 * 256);
#pragma unroll
        for (int it = 0; it < 16; ++it) *(LAS u32x4*)(ldst + it * 16 * 264) = stg[it]; }
    __syncthreads();
#pragma unroll 2
    for (int dt = 0; dt < 16; ++dt) {
        f32x4 o0 = {0.f, 0.f, 0.f, 0.f}, o1 = {0.f, 0.f, 0.f, 0.f};
        bf16x8 vf[8];
#pragma unroll
        for (int k8 = 0; k8 < 8; ++k8) {
            const LAS bf16_t* vp = sK + (16 * dt + r) * 264 + 32 * k8 + 4 * qd;
            const u32x2 lo = *(const LAS u32x2*)vp, hi = *(const LAS u32x2*)(vp + 16);
            u32x4 w; w.x = lo.x; w.y = lo.y; w.z = hi.x; w.w = hi.y; vf[k8] = __builtin_bit_cast(bf16x8, w);
        }
#pragma unroll
        for (int k8 = 0; k8 < 8; ++k8) { o0 = MFMA16(vf[k8], pf[0][k8], o0); o1 = MFMA16(vf[k8], pf[1][k8], o1); }
        u32x2 w0, w1; w0.x = pk2(o0[0], o0[1]); w0.y = pk2(o0[2], o0[3]); w1.x = pk2(o1[0], o1[1]); w1.y = pk2(o1[2], o1[3]);
        *(u32x2*)(CA + (q0 + r) * 1024 + h * 256 + 16 * dt + 4 * qd) = w0;
        *(u32x2*)(CA + (q0 + 16 + r) * 1024 + h * 256 + 16 * dt + 4 * qd) = w1;
    }
    __syncthreads();
}

__device__ __forceinline__ void attn_sample_item(const Ctx& C, LAS unsigned char* lds, int item) {
    const int tid = threadIdx.x, lane = tid & 63, wid = tid >> 6, r = lane & 15, qd = lane >> 4;
    const int bs = item >> 1, hp = item & 1, hl = wid & 1, h = 2 * hp + hl, kq = wid >> 1;
    LAS float* sP = (LAS float*)lds;
    LAS float* sMx = sP + 2048;
    LAS float* sSm = sMx + 32;
    LAS float* sO = sSm + 32;
    const bf16_t* HQ = C.wsb(WS_HQ); const size_t r0 = (size_t)MP + bs * 4;
    const float* Kc = C.in[4] + (size_t)bs * 262144; const float* Vc = C.in[5] + (size_t)bs * 262144;
    bf16x8 qf[8];
#pragma unroll
    for (int k8 = 0; k8 < 8; ++k8) { if (r < 4) qf[k8] = gld8(HQ + (r0 + r) * 1024 + h * 256 + k8 * 32 + qd * 8); else qf[k8] = (bf16x8){0, 0, 0, 0, 0, 0, 0, 0}; }
    f32x4 s[4];
    const float* kp = Kc + ((size_t)(kq * 64 + r) * 4 + h) * 256 + qd * 8;
    const float* vp = Vc + ((size_t)(kq * 64) * 4 + h) * 256 + lane * 4;
    f32x4 ka[16], kb[16];
#define LOADK(dst, mt) do { _Pragma("unroll") for (int k8 = 0; k8 < 8; ++k8) { dst[2 * k8] = *(const f32x4*)(kp + (size_t)(mt) * 16384 + k8 * 32); dst[2 * k8 + 1] = *(const f32x4*)(kp + (size_t)(mt) * 16384 + k8 * 32 + 4); } } while (0)
#define MMAK(src, mt) do { s[mt] = (f32x4){0.f, 0.f, 0.f, 0.f}; _Pragma("unroll") for (int k8 = 0; k8 < 8; ++k8) { u32x4 w; w.x = pk2(src[2 * k8][0], src[2 * k8][1]); w.y = pk2(src[2 * k8][2], src[2 * k8][3]); \
        w.z = pk2(src[2 * k8 + 1][0], src[2 * k8 + 1][1]); w.w = pk2(src[2 * k8 + 1][2], src[2 * k8 + 1][3]); s[mt] = MFMA16(__builtin_bit_cast(bf16x8, w), qf[k8], s[mt]); } } while (0)
#define LOADV(dst, m0) do { _Pragma("unroll") for (int m = 0; m < 16; ++m) dst[m] = *(const f32x4*)(vp + (size_t)((m0) + m) * 1024); } while (0)
#define FMAV(src, m0) do { _Pragma("unroll") for (int m = 0; m < 16; ++m) { _Pragma("unroll") for (int t = 0; t < 4; ++t) acc[t] += src[m] * sP[(wid * 4 + t) * 64 + (m0) + m]; } } while (0)
    LOADK(ka, 0); LOADK(kb, 1);
    MMAK(ka, 0); LOADK(ka, 2);
    MMAK(kb, 1); LOADK(kb, 3);
    MMAK(ka, 2); LOADV(ka, 0);
    MMAK(kb, 3); LOADV(kb, 16);
    float mx = -3.0e38f;
#pragma unroll
    for (int mt = 0; mt < 4; ++mt)
#pragma unroll
        for (int jx = 0; jx < 4; ++jx) mx = fmaxf(mx, s[mt][jx]);
    mx = fmaxf(mx, __shfl_xor(mx, 16)); mx = fmaxf(mx, __shfl_xor(mx, 32));
    float sum = 0.f;
#pragma unroll
    for (int mt = 0; mt < 4; ++mt)
#pragma unroll
        for (int jx = 0; jx < 4; ++jx) { const float e = __expf(s[mt][jx] - mx); s[mt][jx] = e; sum += e; }
    sum += __shfl_xor(sum, 16); sum += __shfl_xor(sum, 32);
    if (lane < 4) { sMx[(hl * 4 + kq) * 4 + lane] = mx; sSm[(hl * 4 + kq) * 4 + lane] = sum; }
    if (r < 4) {
#pragma unroll
        for (int mt = 0; mt < 4; ++mt)
#pragma unroll
            for (int jx = 0; jx < 4; ++jx) sP[(wid * 4 + r) * 64 + 16 * mt + 4 * qd + jx] = s[mt][jx];
    }
    {
        f32x4 acc[4];
#pragma unroll
        for (int t = 0; t < 4; ++t) acc[t] = (f32x4){0.f, 0.f, 0.f, 0.f};
        FMAV(ka, 0); LOADV(ka, 32);
        FMAV(kb, 16); LOADV(kb, 48);
        FMAV(ka, 32); FMAV(kb, 48);
#pragma unroll
        for (int t = 0; t < 4; ++t) *(LAS f32x4*)(sO + ((hl * 4 + kq) * 4 + t) * 256 + lane * 4) = acc[t];
    }
#undef LOADK
#undef MMAK
#undef LOADV
#undef FMAV
    __syncthreads();
    {
        const int e = tid * 4, hl2 = e >> 10, t = (e >> 8) & 3, d = e & 255;
        float m4[4], w4[4]; float gm = -3.0e38f, den = 0.f;
#pragma unroll
        for (int q4 = 0; q4 < 4; ++q4) { m4[q4] = sMx[(hl2 * 4 + q4) * 4 + t]; gm = fmaxf(gm, m4[q4]); }
#pragma unroll
        for (int q4 = 0; q4 < 4; ++q4) { w4[q4] = __expf(m4[q4] - gm); den += w4[q4] * sSm[(hl2 * 4 + q4) * 4 + t]; }
        const float inv = __builtin_amdgcn_rcpf(den);
        f32x4 o = {0.f, 0.f, 0.f, 0.f};
#pragma unroll
        for (int q4 = 0; q4 < 4; ++q4) o += *(const LAS f32x4*)(sO + ((hl2 * 4 + q4) * 4 + t) * 256 + d) * (w4[q4] * inv);
        u32x2 w; w.x = pk2(o[0], o[1]); w.y = pk2(o[2], o[3]);
        *(u32x2*)(C.wsb(WS_CA) + (r0 + t) * 1024 + (2 * hp + hl2) * 256 + d) = w;
    }
    __syncthreads();
}

template <class F> __device__ __forceinline__ void sgemm_tile(const bf16_t* A, const bf16_t* Bt, int K, int N, int tile, LAS unsigned char* lds, const F& epi) {
    const int tid = threadIdx.x, lane = tid & 63, wid = tid >> 6, r = lane & 15, qd = lane >> 4;
    const int ntn = N >> 6; const int mt = tile / ntn, nt = tile - mt * ntn;
    const int row0 = MP + 32 * mt, n0 = 64 * nt; const int KW = K >> 3;
    f32x4 acc[2][4];
#pragma unroll
    for (int mi = 0; mi < 2; ++mi)
#pragma unroll
        for (int ni = 0; ni < 4; ++ni) acc[mi][ni] = (f32x4){0.f, 0.f, 0.f, 0.f};
    const bf16_t* ap = A + (size_t)(row0 + r) * K + wid * KW + qd * 8;
    const bf16_t* bp = Bt + (size_t)(n0 + r) * K + wid * KW + qd * 8;
#pragma unroll 1
    for (int kc = 0; kc < KW; kc += 128) {
        bf16x8 a[2][4], b[4][4];
#pragma unroll
        for (int ks = 0; ks < 4; ++ks) {
#pragma unroll
            for (int mi = 0; mi < 2; ++mi) a[mi][ks] = gld8(ap + (size_t)mi * 16 * K + kc + ks * 32);
#pragma unroll
            for (int ni = 0; ni < 4; ++ni) b[ni][ks] = gld8(bp + (size_t)ni * 16 * K + kc + ks * 32);
        }
#pragma unroll
        for (int ks = 0; ks < 4; ++ks)
#pragma unroll
            for (int mi = 0; mi < 2; ++mi)
#pragma unroll
                for (int ni = 0; ni < 4; ++ni) acc[mi][ni] = MFMA16(a[mi][ks], b[ni][ks], acc[mi][ni]);
    }
    LAS float* red = (LAS float*)lds;
#pragma unroll
    for (int mi = 0; mi < 2; ++mi)
#pragma unroll
        for (int ni = 0; ni < 4; ++ni)
#pragma unroll
            for (int jx = 0; jx < 4; ++jx) red[(wid * 32 + 16 * mi + 4 * qd + jx) * 68 + 16 * ni + r] = acc[mi][ni][jx];
    __syncthreads();
    {
        const int row = tid >> 4, c4 = (tid & 15) * 4;
        f32x4 v = *(const LAS f32x4*)(red + row * 68 + c4);
#pragma unroll
        for (int w = 1; w < 8; ++w) v += *(const LAS f32x4*)(red + (w * 32 + row) * 68 + c4);
        epi(row0 + row, n0 + c4, v);
    }
    __syncthreads();
}
struct SEpi1 {
    bf16_t* Zb; const float* lbp;
    __device__ __forceinline__ void operator()(int row, int col, const f32x4& v) const {
        const int sec = col >> 9, cs = col & 511; const size_t o = (size_t)row * 512 + cs;
        if (sec == 1) {
            const f32x4 p0 = *(const f32x4*)(lbp + cs), p1 = *(const f32x4*)(lbp + 512 + cs); float kk[4], lf[4];
#pragma unroll
            for (int j = 0; j < 4; ++j) { const float lb = sigm(p0[j] - p1[j]), sg = sigm(v[j]), oml = 1.0f - lb; kk[j] = oml * (1.0f - sg); lf[j] = __logf(lb + oml * sg); }
            u32x2 w; w.x = pk2(kk[0], kk[1]); w.y = pk2(kk[2], kk[3]); *(u32x2*)(Zb + ZSZ + o) = w;
            w.x = pk2(lf[0], lf[1]); w.y = pk2(lf[2], lf[3]); *(u32x2*)(Zb + 2 * ZSZ + o) = w;
        } else {
            float rr[4];
#pragma unroll
            for (int j = 0; j < 4; ++j) { const float z = v[j]; const float t = (sec >= 4) ? 1.5957691216f * (z + 0.044715f * z * z * z) : z; const float sg = sigm(t);
                rr[j] = (sec == 2) ? z : ((sec == 3) ? sg : z * sg); }
            u32x2 w; w.x = pk2(rr[0], rr[1]); w.y = pk2(rr[2], rr[3]); *(u32x2*)(Zb + (size_t)(sec == 0 ? 0 : sec + 1) * ZSZ + o) = w;
        }
    }
};
template <bool RB> struct SEpiRes {
    const float* resf; bf16_t* xb; float* ss;
    __device__ __forceinline__ void operator()(int row, int col, const f32x4& a) const {
        const size_t o = (size_t)row * 1024 + col; f32x4 v;
        if (RB) { const u32x2 rr = *(const u32x2*)(xb + o); v = (f32x4){bflo(rr.x), bfhi(rr.x), bflo(rr.y), bfhi(rr.y)} + a; }
        else v = *(const f32x4*)(resf + o) + a;
        u32x2 w; w.x = pk2(v[0], v[1]); w.y = pk2(v[2], v[3]); *(u32x2*)(xb + o) = w;
        float s = (v[0] * v[0] + v[1] * v[1]) + (v[2] * v[2] + v[3] * v[3]);
        s += __shfl_xor(s, 1); s += __shfl_xor(s, 2); s += __shfl_xor(s, 4); s += __shfl_xor(s, 8);
        if ((threadIdx.x & 15) == 0) atomicAdd(ss + row, s);
    }
};
template <int ACT> struct SEpiScale {
    bf16_t* O; int ldc; const float* ss; float scale;
    __device__ __forceinline__ void operator()(int row, int col, const f32x4& a) const {
        const float rs = rsqrtf(ss[row] * (1.0f / 1024.0f) + EPS) * scale; f32x4 v = a * rs;
        if (ACT == 1) {
#pragma unroll
            for (int j = 0; j < 4; ++j) { const float x = fmaxf(v[j], 0.f); v[j] = x * x; } }
        u32x2 w; w.x = pk2(v[0], v[1]); w.y = pk2(v[2], v[3]); *(u32x2*)(O + (size_t)row * ldc + col) = w;
    }
};


__device__ __forceinline__ void panel_wait(unsigned* cnt, unsigned want) {
    if (threadIdx.x == 0) {
        __hip_atomic_fetch_add(cnt, 1u, __ATOMIC_RELAXED, __HIP_MEMORY_SCOPE_AGENT);
        unsigned sp = 0;
        while (__hip_atomic_load(cnt, __ATOMIC_RELAXED, __HIP_MEMORY_SCOPE_AGENT) < want) { __builtin_amdgcn_s_sleep(2); if (++sp > (1u << 22)) break; }
        __builtin_amdgcn_fence(__ATOMIC_ACQUIRE, "agent");
        asm volatile("s_waitcnt vmcnt(0)" ::: "memory");
    }
}
struct EpiFinal {
    static constexpr bool PERM = false, AFTER_DRAIN = true;
    const bf16_t* res; float* out; float* ss; unsigned* cnt; const float* gfin;
    __device__ __forceinline__ void fused(f32x4 (&acc)[2][2][4][2], const pg8::Unit& u, int wr, int wc, int fr, int fq, LAS unsigned char* lds, int wid, int lane) const {
        const int row0 = u.pm * 256 + wr * 64 + fr, col0 = u.pn * 256 + wc * 32 + 4 * fq;
#pragma unroll
        for (int ai = 0; ai < 2; ++ai)
#pragma unroll
            for (int m = 0; m < 4; ++m) {
                const int row = row0 + ai * 128 + m * 16; const size_t o = (size_t)row * 1024 + col0; float s = 0.f;
#pragma unroll
                for (int bj = 0; bj < 2; ++bj)
#pragma unroll
                    for (int n = 0; n < 2; ++n) { const u32x2 rr = *(const u32x2*)(res + o + bj * 128 + n * 16); const f32x4 v = (f32x4){bflo(rr.x), bfhi(rr.x), bflo(rr.y), bfhi(rr.y)} + acc[ai][bj][m][n]; acc[ai][bj][m][n] = v;
                        s += (v[0] * v[0] + v[1] * v[1]) + (v[2] * v[2] + v[3] * v[3]); }
                s += __shfl_xor(s, 16); s += __shfl_xor(s, 32);
                if (fq == 0) atomicAdd(ss + row, s);
            }
        asm volatile("s_waitcnt vmcnt(0)" ::: "memory");
        __syncthreads();
        panel_wait(cnt + 64 * u.pm, 4u);
        __syncthreads();
        f32x4 gv[2][2];
#pragma unroll
        for (int bj = 0; bj < 2; ++bj)
#pragma unroll
            for (int n = 0; n < 2; ++n) gv[bj][n] = *(const f32x4*)(gfin + col0 + bj * 128 + n * 16);
        float ssv[2][4];
#pragma unroll
        for (int ai = 0; ai < 2; ++ai)
#pragma unroll
            for (int m = 0; m < 4; ++m) ssv[ai][m] = __hip_atomic_load(ss + row0 + ai * 128 + m * 16, __ATOMIC_RELAXED, __HIP_MEMORY_SCOPE_AGENT);
#pragma unroll
        for (int ai = 0; ai < 2; ++ai)
#pragma unroll
            for (int m = 0; m < 4; ++m) {
                const int row = row0 + ai * 128 + m * 16; const size_t o = (size_t)row * 1024 + col0;
                const float rs = rsqrtf(ssv[ai][m] * (1.0f / 1024.0f) + EPS);
#pragma unroll
                for (int bj = 0; bj < 2; ++bj)
#pragma unroll
                    for (int n = 0; n < 2; ++n) *(f32x4*)(out + o + bj * 128 + n * 16) = acc[ai][bj][m][n] * rs * gv[bj][n];
            }
    }
};
struct SEpiFinal {
    const bf16_t* res; float* out; float* ss; unsigned* cnt; const float* gfin;
    __device__ __forceinline__ void operator()(int row, int col, const f32x4& a) const {
        const size_t o = (size_t)row * 1024 + col; const u32x2 rr = *(const u32x2*)(res + o); const f32x4 v = (f32x4){bflo(rr.x), bfhi(rr.x), bflo(rr.y), bfhi(rr.y)} + a;
        float s = (v[0] * v[0] + v[1] * v[1]) + (v[2] * v[2] + v[3] * v[3]);
        s += __shfl_xor(s, 1); s += __shfl_xor(s, 2); s += __shfl_xor(s, 4); s += __shfl_xor(s, 8);
        if ((threadIdx.x & 15) == 0) atomicAdd(ss + row, s);
        asm volatile("s_waitcnt vmcnt(0)" ::: "memory");
        __syncthreads();
        panel_wait(cnt + 64 * ((row - MP) >> 5), 16u);
        __syncthreads();
        const float rs = rsqrtf(__hip_atomic_load(ss + row, __ATOMIC_RELAXED, __HIP_MEMORY_SCOPE_AGENT) * (1.0f / 1024.0f) + EPS);
        *(f32x4*)(out + o) = v * rs * *(const f32x4*)(gfin + col);
    }
};

#define XB_TMO      128
#define XB_XCNT(j)  (256  + 64 * (j))
#define XB_XSUB(j)  (1280 + 64 * (j))
#define XB_XGEN(j)  (2304 + 64 * (j))
#define XB_TOP      3328
#define XB_TOPGEN   3392
#define XCD_BAR_WORDS 3456
#define XB_SPIN_CAP (1u << 18)

__device__ __forceinline__ unsigned xb_ld(unsigned* p)              { return __hip_atomic_load(p, __ATOMIC_RELAXED, __HIP_MEMORY_SCOPE_AGENT); }
__device__ __forceinline__ unsigned xb_add(unsigned* p, unsigned v) { return __hip_atomic_fetch_add(p, v, __ATOMIC_RELAXED, __HIP_MEMORY_SCOPE_AGENT); }
__device__ __forceinline__ unsigned xb_xcc_id() { return (unsigned)__builtin_amdgcn_s_getreg((3 << 11) | 20) & 0xFu; }
#define XB_SPIN(cond, bar) do { unsigned _sp = 0; while (cond) { __builtin_amdgcn_s_sleep(1); \
    if ((++_sp & 255u) == 0u) { if (xb_ld(&(bar)[XB_TMO])) break; if (_sp > XB_SPIN_CAP) { atomicAdd(&(bar)[XB_TMO], 1u); break; } } } } while (0)

struct XcdBarrier {
    unsigned* bar; unsigned x;
    volatile LAS unsigned* st;
};

__device__ __forceinline__ XcdBarrier xcd_barrier_post(unsigned* bar, volatile LAS unsigned* st) {
    XcdBarrier b; b.bar = bar; b.x = xb_xcc_id(); b.st = st;
    if (threadIdx.x == 0) (void)xb_add(&bar[XB_XCNT(b.x)], 1u);
    return b;
}
__device__ __forceinline__ void xcd_barrier_complete(unsigned* bar, unsigned x, unsigned& nloc, unsigned& nx) {
    const unsigned G = gridDim.x * gridDim.y * gridDim.z;
    unsigned sum, cnt, mine, sp = 0u;
    for (;;) {
        sum = 0u; cnt = 0u; mine = 0u;
#pragma unroll
        for (unsigned j = 0; j < 16; ++j) { const unsigned c = xb_ld(&bar[XB_XCNT(j)]); sum += c; cnt += (c > 0u) ? 1u : 0u; mine = (j == x) ? c : mine; }
        if (sum == G) break;
        __builtin_amdgcn_s_sleep(1);
        if ((++sp & 255u) == 0u) { if (xb_ld(&bar[XB_TMO])) break; if (sp > XB_SPIN_CAP) { atomicAdd(&bar[XB_TMO], 1u); break; } }
    }
    nloc = mine > 0u ? mine : 1u; nx = cnt > 0u ? cnt : 1u;
}

__device__ __forceinline__ void xcd_barrier(const XcdBarrier& b) {
    asm volatile("s_waitcnt vmcnt(0)" ::: "memory");
    __syncthreads();
    if (threadIdx.x == 0) {
        unsigned* bar = b.bar;
        __builtin_amdgcn_s_waitcnt(0);
        unsigned nloc = b.st[0], nx = b.st[1];
        if (nloc == 0u) { xcd_barrier_complete(bar, b.x, nloc, nx); b.st[0] = nloc; b.st[1] = nx; }
        const unsigned old = xb_add(&bar[XB_XSUB(b.x)], 1u);
        const unsigned gen = old / nloc;
        if (old + 1u == (gen + 1u) * nloc) {
            __builtin_amdgcn_fence(__ATOMIC_RELEASE, "agent");
            asm volatile("s_waitcnt vmcnt(0)" ::: "memory");
            const unsigned og = xb_add(&bar[XB_TOP], 1u);
            const unsigned tg = og / nx;
            if (og + 1u == (tg + 1u) * nx) xb_add(&bar[XB_TOPGEN], 1u);
            else XB_SPIN(xb_ld(&bar[XB_TOPGEN]) == tg, bar);
            __builtin_amdgcn_fence(__ATOMIC_ACQUIRE, "agent");
            xb_add(&bar[XB_XGEN(b.x)], 1u);
            asm volatile("s_waitcnt vmcnt(0)" ::: "memory");
        } else {
            XB_SPIN(xb_ld(&bar[XB_XGEN(b.x)]) == gen, bar);
            __builtin_amdgcn_fence(__ATOMIC_ACQUIRE, "agent");
            asm volatile("s_waitcnt vmcnt(0)" ::: "memory");
        }
    }
    __syncthreads();
}


constexpr int NPH = 11;
constexpr size_t WS_BAR = WS_END + 4096 - (WS_END % 4096);
constexpr int BAR_BYTES = 65536;
constexpr int LDS_ST_OFF = LDS_BYTES - 16;
static_assert(WS_BAR + BAR_BYTES < 512 * MB && XCD_BAR_WORDS <= 4096 && (4096 + 80 * 64) * 4 <= BAR_BYTES, "barrier words");
__global__ void __launch_bounds__(NTHR, 2) mega(Params P) {
    extern __shared__ __attribute__((aligned(16))) unsigned char smem[];
    LAS unsigned char* lds = (LAS unsigned char*)smem;
    cg::grid_group grid = cg::this_grid();
    const Ctx& C = P;
    const int lo = P.ph_lo, hi = P.ph_hi; const int G = gridDim.x, bx = blockIdx.x;
    if (threadIdx.x < 4) ((LAS unsigned*)(lds + LDS_ST_OFF))[threadIdx.x] = 0u;
    __syncthreads();
    XcdBarrier bar = xcd_barrier_post((unsigned*)(P.ws + WS_BAR), (volatile LAS unsigned*)(lds + LDS_ST_OFF));
    if (lo < 0) grid.sync();
#define IN(k) (lo <= (k) && (k) < hi)
#ifndef REP_PHASE
#define REP_PHASE -1
#endif
#define REPEAT(k) for (int rep_ = 0; rep_ < ((REP_PHASE == (k)) ? 2 : 1); ++rep_, (REP_PHASE == (k) && rep_ == 1) ? xcd_barrier(bar) : (void)0)
#define SEAM(k) do { if (IN(k) && IN((k) + 1)) xcd_barrier(bar); } while (0)
    if (IN(0)) REPEAT(0) phase_prep(C, lds);
    SEAM(0);
#define P1_MEM() do { pg8::Gemm g{C.wsb(WS_MEMN), C.wsb(WS_WCKV), NMR, 2048, DM}; pg8::StaticOrder S; S.init(NMR, 2048, G, bx); \
          EpiMem E{C.out + OUT_MK, C.out + OUT_MV, C.wsb(WS_KB), C.wsb(WS_VT)}; pg8::gemm_phase<EpiMem, pg8::StaticOrder>(lds, g, S, E, nullptr); } while (0)
#define P1_BIG() do { pg8::Gemm g{C.wsb(WS_HN), C.wsb(WS_WIN), MP, NIN, DM}; pg8::StaticOrder S; S.init(MP, NIN, G, bx); \
        Epi1 E{C.Z(0), C.in[6]}; pg8::gemm_phase<Epi1, pg8::StaticOrder>(lds, g, S, E, nullptr); } while (0)
    if (IN(1)) {
        const int grp = (bx >> 3) & 3; SEpi1 SE{C.Z(0), C.in[6]};
        const int t0 = (G > 128) ? bx - 64 : bx, tstep = (G > 128) ? G - 64 : G; const bool tiles = (G <= 128) || bx >= 64;
        int t = t0, k = 0;
        if (tiles) for (; t < 768 && k < grp; t += tstep, ++k) sgemm_tile(C.wsb(WS_HN), C.wsb(WS_WIN), DM, NIN, t, lds, SE);
        if (grp & 1) { P1_MEM(); P1_BIG(); } else { P1_BIG(); P1_MEM(); }
        if (tiles) for (; t < 768; t += tstep) sgemm_tile(C.wsb(WS_HN), C.wsb(WS_WIN), DM, NIN, t, lds, SE);
    }
    SEAM(1);
    if (IN(2)) {
        unsigned rq[16], rk[16], rl[16], rv[16];
        if (bx < 1024) hg_load(C, bx, rq, rk, rl, rv);
        for (int it = bx; it < 1024; it += G) hg_intra(C, lds, it, it + G, rq, rk, rl, rv);
    }
    SEAM(2);
    if (IN(3)) REPEAT(3) {
        hg_scan(C);
        if ((bx >> 3) & 1) { for (int it = bx; it < 512; it += G) hg_sample_item(C, lds, it); for (int it = bx; it < 512; it += G) gmlp_item(C, lds, it); }
        else { for (int it = bx; it < 512; it += G) gmlp_item(C, lds, it); for (int it = bx; it < 512; it += G) hg_sample_item(C, lds, it); }
        for (int it = bx; it < 128; it += G) gmlp_sample_item(C, lds, it);
    }
    SEAM(3);
    if (IN(4)) REPEAT(4) hg_out(C, lds);
    SEAM(4);
    if (IN(5)) {
#define PBIG() do { pg8::Gemm g{C.wsb(WS_O), C.wsb(WS_WOUT), MP, DM, DM}; pg8::StaticOrder S; S.init(MP, DM, G, bx); EpiRes<false> E{C.in[0], C.wsb(WS_XB), C.wsf(WS_SS)}; pg8::gemm_phase<EpiRes<false>, pg8::StaticOrder>(lds, g, S, E, nullptr); } while (0)
#define PTILE() do { SEpiRes<false> SE{C.in[1] - (size_t)MP * 1024, C.wsb(WS_XB), C.wsf(WS_SS)}; for (int t = bx; t < 256; t += G) sgemm_tile(C.wsb(WS_O), C.wsb(WS_WOUT), DM, DM, t, lds, SE); } while (0)
        if ((bx >> 3) & 1) { PTILE(); PBIG(); } else { PBIG(); PTILE(); }
#undef PBIG
#undef PTILE
    }
    SEAM(5);
    if (IN(6)) {
#define PBIG() do { pg8::Gemm g{C.wsb(WS_XB), C.wsb(WS_WCQ), MP, DM, DM}; pg8::StaticOrder S; S.init(MP, DM, G, bx); EpiScale<0> E{C.wsb(WS_HQ), DM, C.wsf(WS_SS), 0.0625f}; pg8::gemm_phase<EpiScale<0>, pg8::StaticOrder>(lds, g, S, E, nullptr); } while (0)
#define PTILE() do { SEpiScale<0> SE{C.wsb(WS_HQ), DM, C.wsf(WS_SS), 0.0625f}; for (int t = bx; t < 256; t += G) sgemm_tile(C.wsb(WS_XB), C.wsb(WS_WCQ), DM, DM, t, lds, SE); } while (0)
        if ((bx >> 3) & 1) { PTILE(); PBIG(); } else { PBIG(); PTILE(); }
#undef PBIG
#undef PTILE
    }
    SEAM(6);
    if (IN(7)) REPEAT(7) {
        if ((bx >> 3) & 1) { for (int it = bx; it < 256; it += G) attn_sample_item(C, lds, it); for (int it = bx; it < 256; it += G) attn_prompt_item(C, lds, it); }
        else { for (int it = bx; it < 256; it += G) attn_prompt_item(C, lds, it); for (int it = bx; it < 256; it += G) attn_sample_item(C, lds, it); }
    }
    SEAM(7);
    if (IN(8)) {
#define PBIG() do { pg8::Gemm g{C.wsb(WS_CA), C.wsb(WS_WCO), MP, DM, DM}; pg8::StaticOrder S; S.init(MP, DM, G, bx); EpiRes<true> E{nullptr, C.wsb(WS_XB), C.wsf(WS_SS) + MT}; pg8::gemm_phase<EpiRes<true>, pg8::StaticOrder>(lds, g, S, E, nullptr); } while (0)
#define PTILE() do { SEpiRes<true> SE{nullptr, C.wsb(WS_XB), C.wsf(WS_SS) + MT}; for (int t = bx; t < 256; t += G) sgemm_tile(C.wsb(WS_CA), C.wsb(WS_WCO), DM, DM, t, lds, SE); } while (0)
        if ((bx >> 3) & 1) { PTILE(); PBIG(); } else { PBIG(); PTILE(); }
#undef PBIG
#undef PTILE
    }
    SEAM(8);
    if (IN(9)) {
        const int grp = (bx >> 3) & 3; SEpiScale<1> SE{C.wsb(WS_H), DFF, C.wsf(WS_SS) + MT, 1.0f};
        int t = bx, k = 0;
        for (; t < 1024 && k < grp; t += G, ++k) sgemm_tile(C.wsb(WS_XB), C.wsb(WS_WUP), DM, DFF, t, lds, SE);
        { pg8::Gemm g{C.wsb(WS_XB), C.wsb(WS_WUP), MP, DFF, DM}; pg8::StaticOrder S; S.init(MP, DFF, G, bx);
          EpiScale<1> E{C.wsb(WS_H), DFF, C.wsf(WS_SS) + MT, 1.0f}; pg8::gemm_phase<EpiScale<1>, pg8::StaticOrder>(lds, g, S, E, nullptr); }
        for (; t < 1024; t += G) sgemm_tile(C.wsb(WS_XB), C.wsb(WS_WUP), DM, DFF, t, lds, SE);
    }
    SEAM(9);
    if (IN(10)) { pg8::Gemm g{C.wsb(WS_H), C.wsb(WS_WDN), MP, DM, DFF}; pg8::StaticOrder S; S.init(MP, DM, G, bx);
        unsigned* pc = (unsigned*)(P.ws + WS_BAR) + 4096;
        EpiFinal E{C.wsb(WS_XB), C.out + OUT_YP, C.wsf(WS_SS) + 2 * MT, pc, C.in[24]}; pg8::gemm_phase<EpiFinal, pg8::StaticOrder>(lds, g, S, E, nullptr);
        SEpiFinal SE{C.wsb(WS_XB), C.out + OUT_YP, C.wsf(WS_SS) + 2 * MT, pc + 64 * 64, C.in[24]};
        for (int t = bx; t < 256; t += G) sgemm_tile(C.wsb(WS_H), C.wsb(WS_WDN), DFF, DM, t, lds, SE); }
#undef IN
#undef SEAM
}

#ifndef MULTI_LAUNCH
#define MULTI_LAUNCH 0
#endif
extern "C" void kernel_launch(void* const* d_in, const int* in_sizes, int n_in, void* d_out, int out_size, void* d_ws, size_t ws_size, hipStream_t stream) {
    static int grid = 0;
    if (grid == 0) {
        int dev = 0, cus = 0, per_cu = 0;
        (void)hipGetDevice(&dev);
        (void)hipDeviceGetAttribute(&cus, hipDeviceAttributeMultiprocessorCount, dev);
        if (hipFuncSetAttribute((const void*)mega, hipFuncAttributeMaxDynamicSharedMemorySize, LDS_BYTES) != hipSuccess) fprintf(stderr, "hipFuncSetAttribute failed\n");
        if (hipOccupancyMaxActiveBlocksPerMultiprocessor(&per_cu, (const void*)mega, NTHR, LDS_BYTES) != hipSuccess || per_cu < 1) { fprintf(stderr, "occupancy query: %d\n", per_cu); per_cu = 1; }
        (void)hipGetLastError();
        grid = cus * per_cu;
        if (grid <= 0) grid = 256;
    }
    Params p{};
    for (int i = 0; i < 25; ++i) p.in[i] = (const float*)d_in[i];
    p.out = (float*)d_out; p.ws = (unsigned char*)d_ws;
    (void)hipMemsetAsync((unsigned char*)d_ws + WS_BAR, 0, BAR_BYTES, stream);
#if MULTI_LAUNCH
    for (int ph = 0; ph < NPH; ++ph) { p.ph_lo = ph; p.ph_hi = ph + 1; hipLaunchKernelGGL(mega, dim3(grid), dim3(NTHR), LDS_BYTES, stream, p); }
#else
    p.ph_lo = 0; p.ph_hi = NPH;
    void* args[] = {&p};
    hipError_t e = hipLaunchCooperativeKernel((const void*)mega, dim3(grid), dim3(NTHR), args, LDS_BYTES, stream);
    if (e != hipSuccess) fprintf(stderr, "cooperative launch failed: %s (grid %d)\n", hipGetErrorString(e), grid);
#endif
}
```

```cpp
#include <hip/hip_runtime.h>
#include <hip/hip_cooperative_groups.h>
#include <cstdio>
namespace cg = cooperative_groups;
namespace pg8 {
#define PG8_LAS __attribute__((address_space(3)))
typedef unsigned short bf16_t;
typedef short bf16x8 __attribute__((ext_vector_type(8)));
typedef float f32x4 __attribute__((ext_vector_type(4)));
typedef unsigned u32x4 __attribute__((ext_vector_type(4)));
constexpr int BM = 256, BK = 64, HALF = 128, HTB = HALF * BK * 2  , STAGE_BYTES = 8 * HTB, NXCD = 8, WGM = 8;

__host__ __device__ __forceinline__ int lds_byte(int r, int c) { const int st = (r >> 4) * 2 + (c >> 5), rr = r & 15, cc = c & 31, ob = rr * 64 + cc * 2; return st * 1024 + (ob ^ (((ob >> 9) & 1) << 5)); }
__host__ __device__ __forceinline__ void stage_rc(int b, int& R, int& C) { const int st = b / 1024, sb = b % 1024, swz = sb ^ (((sb >> 9) & 1) << 5); R = (st >> 1) * 16 + swz / 64; C = (st & 1) * 32 + (swz % 64) / 2; }
__host__ __device__ __forceinline__ int perm32(int rho) { const int n = rho >> 4, i = rho & 15; return 8 * (i >> 2) + 4 * n + (i & 3); }

struct Unit { int pm, pn; };
struct Gemm { const bf16_t* A; const bf16_t* Bt; int M, N, K; };

struct StaticOrder {
    int nM, nN, nwg, G, c;
    __host__ __device__ void init(int M, int N, int G_, int c_) { nM = M / BM; nN = N / BM; nwg = nM * nN; G = G_; c = c_; }
    __host__ __device__ bool next(int i, Unit& u) const {
        const long L = (long)i * G + c; if (L >= nwg) return false;
        int wgid = (int)L; { const int q = nwg / NXCD, r = nwg % NXCD, xcd = wgid % NXCD, off = wgid / NXCD; wgid = (xcd < r ? xcd * (q + 1) : r * (q + 1) + (xcd - r) * q) + off; }
        const int nig = WGM * nN, gid = wgid / nig, fm = gid * WGM, gsz = (nM - fm) < WGM ? (nM - fm) : WGM;
        u.pm = fm + ((wgid % nig) % gsz); u.pn = (wgid % nig) / gsz; return true;
    }
    __device__ __forceinline__ void a_ready(const Unit&) const {}
    __device__ __forceinline__ void done(const Unit&) const {}
};
template <class Epi, class Sched, bool STAMP = false>
__device__ __forceinline__ void gemm_phase(PG8_LAS unsigned char* lds, const Gemm g, const Sched& S, const Epi& E, unsigned long long* stamps) {
    const int tid = threadIdx.x, wid = __builtin_amdgcn_readfirstlane(tid >> 6), lane = tid & 63, wr = wid >> 2, wc = wid & 3, fr = lane & 15, fq = lane >> 4;
    const int K = g.K, nt = K / BK;
    int ts_lo = 0, ts_hi = 0, nts = 0; const unsigned long long rt_entry = STAMP ? (unsigned long long)wall_clock64() : 0ull;
#define PG8_STAMP() do { if (STAMP && wid == 0 && nts < 64) { const unsigned long long _c = (unsigned long long)clock64(); \
        ts_lo = (lane == nts) ? (int)(unsigned)_c : ts_lo; ts_hi = (lane == nts) ? (int)(unsigned)(_c >> 32) : ts_hi; ++nts; } } while (0)
    PG8_STAMP();
    unsigned voffA[2], voffB[2];
#pragma unroll
    for (int i = 0; i < 2; ++i) { int R, C; stage_rc(tid * 16 + i * 8192, R, C); const int Rb = Epi::PERM ? ((R & ~31) + perm32(R & 31)) : R;
        voffA[i] = (unsigned)(R * K + C) * 2u; voffB[i] = (unsigned)(Rb * K + C) * 2u; }
    const size_t kstep = (size_t)(BK * 2);
    const size_t hstep = (size_t)HALF * K * 2;
    const size_t tstep = 2 * hstep;
    const unsigned ldsw = (unsigned)wid * 1024u;
    const int aoff = lds_byte(wr * 64 + fr, fq * 8), boff = lds_byte(wc * 32 + fr, fq * 8);
#define PG8_SA(b, h) (((b) * 2 + (h)) * HTB)
#define PG8_SB(b, h) ((4 + (b) * 2 + (h)) * HTB)
#define PG8_STAGE(bufoff, gbase, voff) do { _Pragma("unroll") for (int _i = 0; _i < 2; ++_i) \
        __builtin_amdgcn_global_load_lds((const unsigned*)((const char*)(gbase) + (voff)[_i]), (PG8_LAS unsigned*)(lds + (bufoff) + ldsw + _i * 8192), 16, 0, 0); } while (0)
#define PG8_LDA(dst, b, h) do { _Pragma("unroll") for (int m = 0; m < 4; ++m) _Pragma("unroll") for (int k = 0; k < 2; ++k) dst[m][k] = *(const PG8_LAS bf16x8*)(lds + PG8_SA(b, h) + aoff + m * 2048 + k * 1024); } while (0)
#define PG8_LDB(dst, b, h) do { _Pragma("unroll") for (int n = 0; n < 2; ++n) _Pragma("unroll") for (int k = 0; k < 2; ++k) dst[n][k] = *(const PG8_LAS bf16x8*)(lds + PG8_SB(b, h) + boff + n * 2048 + k * 1024); } while (0)
#define PG8_MMA(ai, bj, At, Bt) do { __builtin_amdgcn_s_setprio(1); _Pragma("unroll") for (int m = 0; m < 4; ++m) _Pragma("unroll") for (int n = 0; n < 2; ++n) _Pragma("unroll") for (int k = 0; k < 2; ++k) \
        acc[ai][bj][m][n] = __builtin_amdgcn_mfma_f32_16x16x32_bf16(Bt[n][k], At[m][k], acc[ai][bj][m][n], 0, 0, 0); __builtin_amdgcn_s_setprio(0); } while (0)
#define PG8_WAIT_V(n) asm volatile("s_waitcnt vmcnt(" #n ")" ::: "memory")
#define PG8_WAIT_L(n) asm volatile("s_waitcnt lgkmcnt(" #n ")" ::: "memory")
#define PG8_BAR __builtin_amdgcn_s_barrier()
#define PG8_SCHED __builtin_amdgcn_sched_barrier(0)
    Unit cur, nxt; int ui = 0;
    if (!S.next(0, cur)) return;
    f32x4 acc[2][2][4][2];
#pragma unroll
    for (int a = 0; a < 2; ++a)
#pragma unroll
        for (int b = 0; b < 2; ++b)
#pragma unroll
            for (int m = 0; m < 4; ++m)
#pragma unroll
                for (int n = 0; n < 2; ++n) acc[a][b][m][n] = (f32x4){0.f, 0.f, 0.f, 0.f};
    bf16x8 At[4][2], B0[2][2], B1[2][2];
    const char* cA = (const char*)g.A + (size_t)cur.pm * tstep; const char* cB = (const char*)g.Bt + (size_t)cur.pn * tstep;
    S.a_ready(cur);
    PG8_STAGE(PG8_SB(0, 0), cB, voffB); PG8_STAGE(PG8_SA(0, 0), cA, voffA); PG8_STAGE(PG8_SB(0, 1), cB + hstep, voffB); PG8_STAGE(PG8_SA(0, 1), cA + hstep, voffA);
    if (wr == 1) PG8_BAR;
    PG8_WAIT_V(4); PG8_BAR;
    PG8_STAGE(PG8_SB(1, 0), cB + kstep, voffB); PG8_STAGE(PG8_SA(1, 0), cA + kstep, voffA); PG8_STAGE(PG8_SB(1, 1), cB + hstep + kstep, voffB);
    PG8_WAIT_V(6); PG8_BAR;
    PG8_STAMP();
    for (;;) {
        const bool has_next = S.next(ui + 1, nxt);
        const char* nA = has_next ? (const char*)g.A + (size_t)nxt.pm * tstep : cA; const char* nB = has_next ? (const char*)g.Bt + (size_t)nxt.pn * tstep : cB;
        for (int t = 0; t < nt; t += 2) {
            const bool last = (t == nt - 2);
            const char* a1 = cA + (size_t)(t + 1) * kstep;
            const char* a2 = last ? nA : cA + (size_t)(t + 2) * kstep; const char* b2 = last ? nB : cB + (size_t)(t + 2) * kstep;
            const char* a3 = a2 + kstep; const char* b3 = b2 + kstep;
            if (last && has_next) S.a_ready(nxt);
            PG8_LDB(B0, 0, 0); PG8_SCHED; PG8_LDA(At, 0, 0); PG8_STAGE(PG8_SA(1, 1), a1 + hstep, voffA);
            PG8_WAIT_L(8); PG8_BAR; PG8_WAIT_L(0); PG8_MMA(0, 0, At, B0); PG8_BAR; PG8_SCHED;
            PG8_LDB(B1, 0, 1); PG8_STAGE(PG8_SB(0, 0), b2, voffB);
            PG8_BAR; PG8_WAIT_L(0); PG8_MMA(0, 1, At, B1); PG8_BAR;
            PG8_LDA(At, 0, 1); PG8_STAGE(PG8_SA(0, 0), a2, voffA);
            PG8_BAR; PG8_WAIT_L(0); PG8_MMA(1, 0, At, B0); PG8_BAR; PG8_SCHED;
            PG8_STAGE(PG8_SB(0, 1), b2 + hstep, voffB);
            PG8_WAIT_V(6); PG8_BAR; PG8_MMA(1, 1, At, B1); PG8_BAR;
            PG8_LDB(B0, 1, 0); PG8_SCHED; PG8_LDA(At, 1, 0); PG8_STAGE(PG8_SA(0, 1), a2 + hstep, voffA);
            PG8_WAIT_L(8); PG8_BAR; PG8_WAIT_L(0); PG8_MMA(0, 0, At, B0); PG8_BAR; PG8_SCHED;
            PG8_LDB(B1, 1, 1); PG8_STAGE(PG8_SB(1, 0), b3, voffB);
            PG8_BAR; PG8_WAIT_L(0); PG8_MMA(0, 1, At, B1); PG8_BAR;
            PG8_LDA(At, 1, 1); PG8_STAGE(PG8_SA(1, 0), a3, voffA);
            PG8_BAR; PG8_WAIT_L(0); PG8_MMA(1, 0, At, B0); PG8_BAR; PG8_SCHED;
            PG8_STAGE(PG8_SB(1, 1), b3 + hstep, voffB);
            PG8_WAIT_V(6); PG8_BAR; PG8_MMA(1, 1, At, B1); PG8_BAR;
        }
        PG8_STAMP();
        if constexpr (!Epi::AFTER_DRAIN) { E(acc, cur, wr, wc, fr, fq); S.done(cur); }
        PG8_STAMP();
        if (!has_next) break;
#pragma unroll
        for (int a = 0; a < 2; ++a)
#pragma unroll
            for (int b = 0; b < 2; ++b)
#pragma unroll
                for (int m = 0; m < 4; ++m)
#pragma unroll
                    for (int n = 0; n < 2; ++n) acc[a][b][m][n] = (f32x4){0.f, 0.f, 0.f, 0.f};
        cur = nxt; cA = nA; cB = nB; ++ui;
    }
    PG8_WAIT_V(0);
    if (wr == 0) PG8_BAR;
    PG8_BAR;
    if constexpr (Epi::AFTER_DRAIN) { E.fused(acc, cur, wr, wc, fr, fq, lds, wid, lane); S.done(cur); }
    PG8_STAMP();
    if (STAMP && wid == 0) { stamps[lane] = lane < nts ? (((unsigned long long)(unsigned)ts_hi << 32) | (unsigned)ts_lo) : 0ull;
        if (lane == 62) stamps[62] = rt_entry; if (lane == 63) stamps[63] = (unsigned long long)wall_clock64(); }
#undef PG8_STAMP
#undef PG8_SA
#undef PG8_SB
#undef PG8_STAGE
#undef PG8_LDA
#undef PG8_LDB
#undef PG8_MMA
#undef PG8_WAIT_V
#undef PG8_WAIT_L
#undef PG8_BAR
#undef PG8_SCHED
}
}

#define LAS __attribute__((address_space(3)))
using pg8::bf16_t; using pg8::bf16x8; using pg8::f32x4; using pg8::u32x4;
typedef unsigned u32x2 __attribute__((ext_vector_type(2)));
constexpr int DM = 1024, MP = 16384, MS = 512, MT = MP + MS, NMR = 2048, DFF = 4096, NIN = 3072;
constexpr float EPS = 1e-6f;
constexpr int NTHR = 512;
constexpr int LDS_BYTES = 144 * 1024;
constexpr size_t MB = 1024 * 1024;
constexpr size_t WS_WIN = 0, WS_WOUT = 6 * MB, WS_WCQ = 8 * MB, WS_WCKV = 10 * MB, WS_WCO = 14 * MB, WS_WUP = 16 * MB, WS_WDN = 24 * MB;
constexpr size_t WS_HN = 32 * MB;
constexpr size_t SZ_ROWB = (size_t)MT * DM * 2;
constexpr size_t WS_Z = WS_HN + SZ_ROWB;
constexpr size_t ZSZ = (size_t)MT * 512;
constexpr size_t WS_H = WS_HN;
constexpr size_t WS_C = WS_Z + 8 * ZSZ * 2;
constexpr size_t WS_MEMN = WS_C, WS_KB = WS_C + 4 * MB, WS_VT = WS_C + 8 * MB;
constexpr size_t WS_D = WS_C + 12 * MB;
constexpr size_t WS_DS = WS_D, WS_SC = WS_D + 32 * MB, WS_OI = WS_D + 64 * MB, WS_DEC = WS_D + 80 * MB;
constexpr size_t WS_HQ = WS_D, WS_CA = WS_D + 36 * MB;
constexpr size_t WS_E = WS_D + 81 * MB;
constexpr size_t WS_O = WS_E, WS_X1 = WS_O + SZ_ROWB, WS_XB = WS_X1 + 2 * SZ_ROWB, WS_SS = WS_XB + SZ_ROWB, WS_LN = WS_SS + 3 * MT * 4, WS_END = WS_LN + 2 * MT * 4;
static_assert(SZ_ROWB * 4 >= (size_t)MT * DFF * 2 && WS_END < 512 * MB, "workspace map");
constexpr size_t OUT_YP = 0, OUT_YS = 16777216, OUT_SP = 17301504, OUT_SSMP = 17825792, OUT_MK = 26214400, OUT_MV = 28311552, OUT_CMV = 30408704;

struct Params { const float* in[25]; float* out; unsigned char* ws; int ph_lo, ph_hi;
    __device__ __forceinline__ bf16_t* wsb(size_t off) const { return (bf16_t*)(ws + off); }
    __device__ __forceinline__ float* wsf(size_t off) const { return (float*)(ws + off); }
    __device__ __forceinline__ bf16_t* Z(int a) const { return (bf16_t*)(ws + WS_Z) + (size_t)a * ZSZ; }
};
typedef Params Ctx;


__device__ __forceinline__ float bf2f(bf16_t b) { return __uint_as_float(((unsigned)b) << 16); }
typedef float f32x2c __attribute__((ext_vector_type(2)));
typedef __bf16 bf16x2c __attribute__((ext_vector_type(2)));
__device__ __forceinline__ unsigned pk2(float lo, float hi) { const f32x2c v = {lo, hi}; const bf16x2c b = __builtin_convertvector(v, bf16x2c); return __builtin_bit_cast(unsigned, b); }
__device__ __forceinline__ bf16_t f2bf(float f) { return (bf16_t)(pk2(f, f) & 0xffffu); }
__device__ __forceinline__ float sigm(float x) { return __builtin_amdgcn_rcpf(1.0f + __expf(-x)); }
__device__ __forceinline__ float bflo(unsigned w) { return __uint_as_float(w << 16); }
__device__ __forceinline__ float bfhi(unsigned w) { return __uint_as_float(w & 0xffff0000u); }

struct Epi1 {
    static constexpr bool PERM = true, AFTER_DRAIN = false;
    bf16_t* Zb; const float* lbp; float* ln;
    __device__ __forceinline__ void operator()(const f32x4 (&acc)[2][2][4][2], const pg8::Unit& u, int wr, int wc, int fr, int fq) const {
        const int sec = u.pn >> 1;
        const int row0 = u.pm * 256 + wr * 64 + fr;
        const int cs0 = (u.pn & 1) * 256 + wc * 32 + 8 * fq;
        if (sec == 1) {
            bf16_t* Zk = Zb + ZSZ; bf16_t* Zl = Zb + 2 * ZSZ;
            f32x4 pp[2][4];
#pragma unroll
            for (int bj = 0; bj < 2; ++bj) { const int cs = cs0 + bj * 128; pp[bj][0] = *(const f32x4*)(lbp + cs); pp[bj][1] = *(const f32x4*)(lbp + cs + 4); pp[bj][2] = *(const f32x4*)(lbp + 512 + cs); pp[bj][3] = *(const f32x4*)(lbp + 512 + cs + 4); }
#pragma unroll
            for (int bj = 0; bj < 2; ++bj) {
                const int cs = cs0 + bj * 128;
                const f32x4 p0a = pp[bj][0], p0b = pp[bj][1], p1a = pp[bj][2], p1b = pp[bj][3];
                float lb[8];
#pragma unroll
                for (int j = 0; j < 4; ++j) { lb[j] = sigm(p0a[j] - p1a[j]); lb[4 + j] = sigm(p0b[j] - p1b[j]); }
#pragma unroll
                for (int ai = 0; ai < 2; ++ai)
#pragma unroll
                    for (int m = 0; m < 4; ++m) {
                        const size_t o = (size_t)(row0 + ai * 128 + m * 16) * 512 + cs;
                        float kk[8], lf[8];
#pragma unroll
                        for (int j = 0; j < 8; ++j) { const float z = (j < 4) ? acc[ai][bj][m][0][j] : acc[ai][bj][m][1][j - 4];
                            const float sg = sigm(z), oml = 1.0f - lb[j]; kk[j] = oml * (1.0f - sg); lf[j] = __logf(lb[j] + oml * sg); }
                        u32x4 w; w.x = pk2(kk[0], kk[1]); w.y = pk2(kk[2], kk[3]); w.z = pk2(kk[4], kk[5]); w.w = pk2(kk[6], kk[7]);
                        *(u32x4*)(Zk + o) = w;
                        w.x = pk2(lf[0], lf[1]); w.y = pk2(lf[2], lf[3]); w.z = pk2(lf[4], lf[5]); w.w = pk2(lf[6], lf[7]);
                        *(u32x4*)(Zl + o) = w;
                    }
            }
        } else {
            bf16_t* Zo = Zb + (size_t)(sec == 0 ? 0 : sec + 1) * ZSZ;
            float l1[2][4], l2[2][4];
#pragma unroll
            for (int ai = 0; ai < 2; ++ai)
#pragma unroll
                for (int m = 0; m < 4; ++m) { l1[ai][m] = 0.f; l2[ai][m] = 0.f; }
#pragma unroll
            for (int bj = 0; bj < 2; ++bj) {
                const int cs = cs0 + bj * 128;
#pragma unroll
                for (int ai = 0; ai < 2; ++ai)
#pragma unroll
                    for (int m = 0; m < 4; ++m) {
                        const size_t o = (size_t)(row0 + ai * 128 + m * 16) * 512 + cs;
                        float r[8];
#pragma unroll
                        for (int j = 0; j < 8; ++j) { const float z = (j < 4) ? acc[ai][bj][m][0][j] : acc[ai][bj][m][1][j - 4];
                            const float t = (sec >= 4) ? 1.5957691216f * (z + 0.044715f * z * z * z) : z;
                            const float sg = sigm(t);
                            r[j] = (sec == 2) ? z : ((sec == 3) ? sg : z * sg); }
                        u32x4 w; w.x = pk2(r[0], r[1]); w.y = pk2(r[2], r[3]); w.z = pk2(r[4], r[5]); w.w = pk2(r[6], r[7]);
                        *(u32x4*)(Zo + o) = w;
                        if (sec == 5) {
#pragma unroll
                            for (int j = 0; j < 8; ++j) { l1[ai][m] += r[j]; l2[ai][m] += r[j] * r[j]; } }
                    }
            }
            if (sec == 5) {
#pragma unroll
                for (int ai = 0; ai < 2; ++ai)
#pragma unroll
                    for (int m = 0; m < 4; ++m) { float a = l1[ai][m], b = l2[ai][m];
                        a += __shfl_xor(a, 16); b += __shfl_xor(b, 16); a += __shfl_xor(a, 32); b += __shfl_xor(b, 32);
                        if (fq == 0) { const int row = row0 + ai * 128 + m * 16; atomicAdd(ln + row, a); atomicAdd(ln + MT + row, b); } }
            }
        }
    }
};

struct EpiMem {
    static constexpr bool PERM = false, AFTER_DRAIN = false;
    float* outK; float* outV; bf16_t* KB; bf16_t* VT;
    __device__ __forceinline__ void operator()(const f32x4 (&acc)[2][2][4][2], const pg8::Unit& u, int wr, int wc, int fr, int fq) const {
        const int row0 = u.pm * 256 + wr * 64 + fr;
        const bool isV = u.pn >= 4;
        const int col0 = (u.pn & 3) * 256 + wc * 32 + 4 * fq;
        float* outp = isV ? outV : outK;
#pragma unroll
        for (int ai = 0; ai < 2; ++ai)
#pragma unroll
            for (int m = 0; m < 4; ++m) {
                const int row = row0 + ai * 128 + m * 16;
#pragma unroll
                for (int bj = 0; bj < 2; ++bj)
#pragma unroll
                    for (int n = 0; n < 2; ++n) {
                        const int c = col0 + bj * 128 + n * 16; const f32x4 v = acc[ai][bj][m][n];
                        *(f32x4*)(outp + (size_t)row * 1024 + c) = v;
                        if (!isV) { u32x2 w; w.x = pk2(v[0], v[1]); w.y = pk2(v[2], v[3]); *(u32x2*)(KB + (size_t)row * 1024 + c) = w; }
                        else { const int b = row >> 8, mm = row & 255;
#pragma unroll
                            for (int j = 0; j < 4; ++j) VT[((size_t)b * 1024 + c + j) * 256 + mm] = f2bf(v[j]); }
                    }
            }
    }
};

template <bool RB> struct EpiRes {
    static constexpr bool PERM = false, AFTER_DRAIN = false;
    const float* resf; bf16_t* xb; float* ss;
    __device__ __forceinline__ void operator()(const f32x4 (&acc)[2][2][4][2], const pg8::Unit& u, int wr, int wc, int fr, int fq) const {
        const int row0 = u.pm * 256 + wr * 64 + fr, col0 = u.pn * 256 + wc * 32 + 4 * fq;
#pragma unroll
        for (int ai = 0; ai < 2; ++ai) {
            f32x4 rv[4][2][2];
#pragma unroll
            for (int m = 0; m < 4; ++m)
#pragma unroll
                for (int bj = 0; bj < 2; ++bj)
#pragma unroll
                    for (int n = 0; n < 2; ++n) { const size_t oo = (size_t)(row0 + ai * 128 + m * 16) * 1024 + col0 + bj * 128 + n * 16;
                        if (RB) { const u32x2 rr = *(const u32x2*)(xb + oo); rv[m][bj][n] = (f32x4){bflo(rr.x), bfhi(rr.x), bflo(rr.y), bfhi(rr.y)}; }
                        else rv[m][bj][n] = *(const f32x4*)(resf + oo); }
#pragma unroll
            for (int m = 0; m < 4; ++m) {
                const int row = row0 + ai * 128 + m * 16; const size_t o = (size_t)row * 1024 + col0; float s = 0.f;
#pragma unroll
                for (int bj = 0; bj < 2; ++bj)
#pragma unroll
                    for (int n = 0; n < 2; ++n) {
                        const size_t oo = o + bj * 128 + n * 16; const f32x4 v = rv[m][bj][n] + acc[ai][bj][m][n];
                        u32x2 w; w.x = pk2(v[0], v[1]); w.y = pk2(v[2], v[3]); *(u32x2*)(xb + oo) = w;
                        s += (v[0] * v[0] + v[1] * v[1]) + (v[2] * v[2] + v[3] * v[3]);
                    }
                s += __shfl_xor(s, 16); s += __shfl_xor(s, 32);
                if (fq == 0) atomicAdd(ss + row, s);
            }
        }
    }
};

template <int ACT> struct EpiScale {
    static constexpr bool PERM = true, AFTER_DRAIN = false;
    bf16_t* O; int ldc; const float* ss; float scale;
    __device__ __forceinline__ void operator()(const f32x4 (&acc)[2][2][4][2], const pg8::Unit& u, int wr, int wc, int fr, int fq) const {
        const int row0 = u.pm * 256 + wr * 64 + fr, col0 = u.pn * 256 + wc * 32 + 8 * fq;
        float ssv[2][4];
#pragma unroll
        for (int ai = 0; ai < 2; ++ai)
#pragma unroll
            for (int m = 0; m < 4; ++m) ssv[ai][m] = ss[row0 + ai * 128 + m * 16];
#pragma unroll
        for (int ai = 0; ai < 2; ++ai)
#pragma unroll
            for (int m = 0; m < 4; ++m) {
                const int row = row0 + ai * 128 + m * 16;
                const float rs = rsqrtf(ssv[ai][m] * (1.0f / 1024.0f) + EPS) * scale;
                bf16_t* rowp = O + (size_t)row * ldc + col0;
#pragma unroll
                for (int bj = 0; bj < 2; ++bj) {
                    f32x4 v0 = acc[ai][bj][m][0] * rs, v1 = acc[ai][bj][m][1] * rs;
                    if (ACT == 1) {
#pragma unroll
                        for (int j = 0; j < 4; ++j) { const float a = fmaxf(v0[j], 0.f), b = fmaxf(v1[j], 0.f); v0[j] = a * a; v1[j] = b * b; } }
                    u32x4 w; w.x = pk2(v0[0], v0[1]); w.y = pk2(v0[2], v0[3]); w.z = pk2(v1[0], v1[1]); w.w = pk2(v1[2], v1[3]);
                    *(u32x4*)(rowp + bj * 128) = w;
                }
            }
    }
};

struct WDesc { const float* W; const float* gain; bf16_t* Wt; int K, N, t; };
__device__ __forceinline__ WDesc wdesc(const Ctx& C, int t) {
    WDesc d;
    if (t < 768) d = WDesc{C.in[8], nullptr, C.wsb(WS_WIN), 1024, 3072, t};
    else if (t < 1024) d = WDesc{C.in[14], nullptr, C.wsb(WS_WOUT), 1024, 1024, t - 768};
    else if (t < 1280) d = WDesc{C.in[17], C.in[15], C.wsb(WS_WCQ), 1024, 1024, t - 1024};
    else if (t < 1536) d = WDesc{C.in[18], nullptr, C.wsb(WS_WCKV), 1024, 1024, t - 1280};
    else if (t < 1792) d = WDesc{C.in[19], nullptr, C.wsb(WS_WCKV) + 1024 * 1024, 1024, 1024, t - 1536};
    else if (t < 2048) d = WDesc{C.in[20], nullptr, C.wsb(WS_WCO), 1024, 1024, t - 1792};
    else if (t < 3072) d = WDesc{C.in[22], C.in[21], C.wsb(WS_WUP), 1024, 4096, t - 2048};
    else d = WDesc{C.in[23], nullptr, C.wsb(WS_WDN), 4096, 1024, t - 3072};
    return d;
}
__device__ __forceinline__ void cvt_load(const WDesc& d, f32x4 (&v)[2], float (&gq)[2]) {
    const int tid = threadIdx.x; const int ntn = d.N >> 6; const int kt = d.t / ntn, nt = d.t - kt * ntn; const int k0 = kt * 64, n0 = nt * 64;
#pragma unroll
    for (int p = 0; p < 2; ++p) { const int k = p * 32 + (tid >> 4), n4 = (tid & 15) * 4;
        v[p] = *(const f32x4*)(d.W + (size_t)(k0 + k) * d.N + n0 + n4); gq[p] = d.gain ? d.gain[k0 + k] : 1.0f; }
}
__device__ __forceinline__ void cvt_store(const WDesc& d, const f32x4 (&v)[2], const float (&gq)[2], LAS float* tl) {
    const int tid = threadIdx.x; const int ntn = d.N >> 6; const int kt = d.t / ntn, nt = d.t - kt * ntn; const int k0 = kt * 64, n0 = nt * 64;
#pragma unroll
    for (int p = 0; p < 2; ++p) { const int k = p * 32 + (tid >> 4), n4 = (tid & 15) * 4; const f32x4 x = v[p] * gq[p];
        tl[k * 65 + n4 + 0] = x[0]; tl[k * 65 + n4 + 1] = x[1]; tl[k * 65 + n4 + 2] = x[2]; tl[k * 65 + n4 + 3] = x[3]; }
    __syncthreads();
    {
        const int n = tid >> 3, k8 = (tid & 7) * 8; float r[8];
#pragma unroll
        for (int j = 0; j < 8; ++j) r[j] = tl[(k8 + j) * 65 + n];
        u32x4 w; w.x = pk2(r[0], r[1]); w.y = pk2(r[2], r[3]); w.z = pk2(r[4], r[5]); w.w = pk2(r[6], r[7]);
        *(u32x4*)(d.Wt + (size_t)(n0 + n) * d.K + k0 + k8) = w;
    }
    __syncthreads();
}

__device__ __forceinline__ void phase_prep(const Ctx& C, LAS unsigned char* lds) {
    const int tid = threadIdx.x, lane = tid & 63, wid = tid >> 6;
    LAS float* tl = (LAS float*)lds;
    {
        int t = blockIdx.x; WDesc d = wdesc(C, t < 4096 ? t : 0); f32x4 v[2]; float gq[2];
        if (t < 4096) cvt_load(d, v, gq);
        for (; t < 4096; t += gridDim.x) {
            const int tn = t + gridDim.x; WDesc dn = wdesc(C, tn < 4096 ? tn : 0); f32x4 vn[2]; float gn[2];
            if (tn < 4096) cvt_load(dn, vn, gn); else { vn[0] = v[0]; vn[1] = v[1]; gn[0] = gq[0]; gn[1] = gq[1]; }
            cvt_store(d, v, gq, tl);
            d = dn; v[0] = vn[0]; v[1] = vn[1]; gq[0] = gn[0]; gq[1] = gn[1];
        }
    }
    {
        const int NR = MT + NMR, stride = gridDim.x * 8; int r = blockIdx.x * 8 + wid;
        f32x4 v[4];
#define ROWSRC(rr) ((rr) < MP ? C.in[0] + (size_t)(rr) * 1024 : ((rr) < MT ? C.in[1] + (size_t)((rr) - MP) * 1024 : C.in[2] + (size_t)((rr) - MT) * 1024))
        if (r < NR) { const float* src = ROWSRC(r);
#pragma unroll
            for (int i = 0; i < 4; ++i) v[i] = *(const f32x4*)(src + i * 256 + lane * 4); }
        for (; r < NR; r += stride) {
            const int rn = r + stride; f32x4 vn[4];
            if (rn < NR) { const float* src = ROWSRC(rn);
#pragma unroll
                for (int i = 0; i < 4; ++i) vn[i] = *(const f32x4*)(src + i * 256 + lane * 4); }
            else {
#pragma unroll
                for (int i = 0; i < 4; ++i) vn[i] = v[i]; }
            const float* g = (r < MT) ? C.in[7] : C.in[16]; bf16_t* dst = (r < MT) ? C.wsb(WS_HN) + (size_t)r * 1024 : C.wsb(WS_MEMN) + (size_t)(r - MT) * 1024;
            f32x4 gg[4];
#pragma unroll
            for (int i = 0; i < 4; ++i) gg[i] = *(const f32x4*)(g + i * 256 + lane * 4);
            float s = 0.f;
#pragma unroll
            for (int i = 0; i < 4; ++i) s += (v[i][0] * v[i][0] + v[i][1] * v[i][1]) + (v[i][2] * v[i][2] + v[i][3] * v[i][3]);
#pragma unroll
            for (int o = 32; o >= 1; o >>= 1) s += __shfl_xor(s, o);
            const float rs = rsqrtf(s * (1.0f / 1024.0f) + EPS);
#pragma unroll
            for (int i = 0; i < 4; ++i) { const f32x4 y = v[i] * rs * gg[i]; u32x2 w; w.x = pk2(y[0], y[1]); w.y = pk2(y[2], y[3]); *(u32x2*)(dst + i * 256 + lane * 4) = w; }
#pragma unroll
            for (int i = 0; i < 4; ++i) v[i] = vn[i];
        }
#undef ROWSRC
    }
    float* ss = C.wsf(WS_SS);
    for (int i = blockIdx.x * NTHR + tid; i < 5 * MT; i += gridDim.x * NTHR) ss[i] = 0.f;
}

__device__ __forceinline__ bf16x8 ld8(const LAS bf16_t* p) { return *(const LAS bf16x8*)p; }
__device__ __forceinline__ bf16x8 gld8(const bf16_t* p) { return *(const bf16x8*)p; }
#define MFMA16(a, b, c) __builtin_amdgcn_mfma_f32_16x16x32_bf16((a), (b), (c), 0, 0, 0)

__device__ __forceinline__ void hg_load(const Ctx& C, int item, unsigned (&rq)[16], unsigned (&rk)[16], unsigned (&rl)[16], unsigned (&rv)[16]) {
    const int tid = threadIdx.x; const int b = item >> 7, c = (item >> 2) & 31, h = item & 3; const int k = tid & 127, i = tid >> 7;
    const size_t o = ((size_t)b * 2048 + c * 64 + 16 * i) * 512 + h * 128 + k;
    const bf16_t* pq = C.Z(0) + o; const bf16_t* pk = C.Z(1) + o; const bf16_t* pl = C.Z(2) + o; const bf16_t* pv = C.Z(3) + o;
#pragma unroll
    for (int t = 0; t < 16; ++t) { rq[t] = pq[t * 512]; rk[t] = pk[t * 512]; rl[t] = pl[t * 512]; rv[t] = pv[t * 512]; }
}
__device__ __forceinline__ void hg_intra(const Ctx& C, LAS unsigned char* lds, int item, int next_item, unsigned (&rq)[16], unsigned (&rk)[16], unsigned (&rl)[16], unsigned (&rv)[16]) {
    const int tid = threadIdx.x, lane = tid & 63, wid = tid >> 6, r = lane & 15, qd = lane >> 4;
    const int b = item >> 7, c = (item >> 2) & 31, h = item & 3;
    const size_t row0 = (size_t)b * 2048 + c * 64; const int hc = h * 128;
    LAS bf16_t* sQV = (LAS bf16_t*)lds;
    LAS bf16_t* sKE = sQV + 7 * 2176;
    LAS bf16_t* sKD = sKE + 3 * 2176;
    LAS bf16_t* sKT = sKD + 4 * 2176;
    LAS bf16_t* sVT = sKT + 128 * 72;
    LAS bf16_t* sA = sVT + 128 * 72;
    LAS float* sTot = (LAS float*)(sA + 64 * 72);
    const int k = tid & 127, i = tid >> 7;
    float q[16], kk[16], bl[16];
    {
        float lf[16]; unsigned vv[16];
#pragma unroll
        for (int t = 0; t < 16; ++t) { q[t] = __uint_as_float(rq[t] << 16); kk[t] = __uint_as_float(rk[t] << 16); lf[t] = __uint_as_float(rl[t] << 16); vv[t] = rv[t]; }
        if (next_item < 1024) hg_load(C, next_item, rq, rk, rl, rv);
        float cum = 0.f;
#pragma unroll
        for (int t = 0; t < 16; ++t) { cum += lf[t]; bl[t] = cum; }
        sTot[i * 128 + k] = cum;
        u32x4 w0, w1;
        w0.x = vv[0] | (vv[1] << 16); w0.y = vv[2] | (vv[3] << 16); w0.z = vv[4] | (vv[5] << 16); w0.w = vv[6] | (vv[7] << 16);
        w1.x = vv[8] | (vv[9] << 16); w1.y = vv[10] | (vv[11] << 16); w1.z = vv[12] | (vv[13] << 16); w1.w = vv[14] | (vv[15] << 16);
        *(LAS u32x4*)(sVT + k * 72 + 16 * i) = w0; *(LAS u32x4*)(sVT + k * 72 + 16 * i + 8) = w1;
    }
    __syncthreads();
    {
        const float t0 = sTot[k], t1 = sTot[128 + k], t2 = sTot[256 + k], t3 = sTot[384 + k];
        const float bend0 = t0, bend1 = t0 + t1, bend2 = bend1 + t2, blast = bend2 + t3;
        const float bstart = (i == 0) ? 0.f : ((i == 1) ? bend0 : ((i == 2) ? bend1 : bend2));
        const float cum = bl[15];
        const float cE = __expf(bstart), c0 = __expf(bstart - bend0), c1 = __expf(bstart - bend1), cdec = __expf(blast - (bstart + cum));
        const int idD = (i == 0) ? 0 : (1 + ((i - 1) * i) / 2 + (i - 1));
        const int id0 = 1 + ((i - 1) * i) / 2;
        bf16_t* pqe = C.Z(7) + (row0 + 16 * i) * 512 + hc + k;
        unsigned kd16[16];
#pragma unroll
        for (int t = 0; t < 16; ++t) {
            const float e = __expf(bl[t]), ei = __expf(-bl[t]), ek = __expf(cum - bl[t]);
            const float qdv = q[t] * e, kdv = kk[t] * ei, kev = kk[t] * ek;
            sQV[(idD * 16 + t) * 136 + k] = f2bf(qdv);
            if (i >= 2) sQV[(id0 * 16 + t) * 136 + k] = f2bf(qdv * c0);
            if (i == 3) sQV[(5 * 16 + t) * 136 + k] = f2bf(qdv * c1);
            sKD[(i * 16 + t) * 136 + k] = f2bf(kdv);
            if (i < 3) sKE[(i * 16 + t) * 136 + k] = f2bf(kev);
            kd16[t] = f2bf(kev * cdec);
            pqe[t * 512] = f2bf(qdv * cE);
        }
        u32x4 w0, w1;
        w0.x = kd16[0] | (kd16[1] << 16); w0.y = kd16[2] | (kd16[3] << 16); w0.z = kd16[4] | (kd16[5] << 16); w0.w = kd16[6] | (kd16[7] << 16);
        w1.x = kd16[8] | (kd16[9] << 16); w1.y = kd16[10] | (kd16[11] << 16); w1.z = kd16[12] | (kd16[13] << 16); w1.w = kd16[14] | (kd16[15] << 16);
        *(LAS u32x4*)(sKT + k * 72 + 16 * i) = w0; *(LAS u32x4*)(sKT + k * 72 + 16 * i + 8) = w1;
        if (i == 0) C.wsf(WS_DEC)[(size_t)item * 128 + k] = __expf(blast);
    }
    __syncthreads();
#pragma unroll
    for (int x = 0; x < 2; ++x) {
        const int tile = wid * 2 + x, ti = tile >> 2, tj = tile & 3;
        f32x4 d = {0.f, 0.f, 0.f, 0.f};
        if (tj <= ti) {
            const int ida = (ti == 0) ? 0 : (1 + ((ti - 1) * ti) / 2 + ((tj == ti) ? ti - 1 : tj));
            const LAS bf16_t* Aop = sQV + ida * 2176 + r * 136 + qd * 8;
            const LAS bf16_t* Bop = ((tj == ti) ? (sKD + ti * 2176) : (sKE + tj * 2176)) + r * 136 + qd * 8;
#pragma unroll
            for (int k4 = 0; k4 < 4; ++k4) d = MFMA16(ld8(Aop + k4 * 32), ld8(Bop + k4 * 32), d);
        }
#pragma unroll
        for (int jx = 0; jx < 4; ++jx) { const int t = 4 * qd + jx; const bool keep = (tj < ti) || (tj == ti && r <= t);
            sA[(16 * ti + t) * 72 + 16 * tj + r] = f2bf(keep ? d[jx] : 0.f); }
    }
    __syncthreads();
    {
        bf16_t* OI = C.wsb(WS_OI); bf16_t* DS = C.wsb(WS_DS) + (size_t)item * 16384;
        const bf16x8 v0 = ld8(sVT + (16 * wid + r) * 72 + qd * 8), v1 = ld8(sVT + (16 * wid + r) * 72 + 32 + qd * 8);
#pragma unroll
        for (int ti = 0; ti < 4; ++ti) {
            f32x4 d = {0.f, 0.f, 0.f, 0.f};
            d = MFMA16(v0, ld8(sA + (16 * ti + r) * 72 + qd * 8), d);
            d = MFMA16(v1, ld8(sA + (16 * ti + r) * 72 + 32 + qd * 8), d);
            u32x2 w; w.x = pk2(d[0], d[1]); w.y = pk2(d[2], d[3]);
            *(u32x2*)(OI + (row0 + 16 * ti + r) * 512 + hc + 16 * wid + 4 * qd) = w;
        }
#pragma unroll
        for (int kt = 0; kt < 8; ++kt) {
            f32x4 d = {0.f, 0.f, 0.f, 0.f};
            d = MFMA16(ld8(sKT + (16 * kt + r) * 72 + qd * 8), v0, d);
            d = MFMA16(ld8(sKT + (16 * kt + r) * 72 + 32 + qd * 8), v1, d);
            u32x2 w; w.x = pk2(d[0], d[1]); w.y = pk2(d[2], d[3]);
            *(u32x2*)(DS + (16 * wid + r) * 128 + 16 * kt + 4 * qd) = w;
        }
    }
    __syncthreads();
}

__device__ __forceinline__ void hg_scan(const Ctx& C) {
    const bf16_t* __restrict__ DS = C.wsb(WS_DS); bf16_t* __restrict__ SC = C.wsb(WS_SC); const float* __restrict__ DEC = C.wsf(WS_DEC);
    float* __restrict__ outS = C.out + OUT_SP;
    for (int g = blockIdx.x * NTHR + threadIdx.x; g < 32 * 4096; g += gridDim.x * NTHR) {
        const int bh = g >> 12, e = g & 4095, v = e >> 5, k4 = (e & 31) * 4, b = bh >> 2, h = bh & 3;
        float S0 = 0.f, S1 = 0.f, S2 = 0.f, S3 = 0.f;
#pragma unroll 16
        for (int c = 0; c < 32; ++c) {
            const int item = b * 128 + c * 4 + h; const size_t off = (size_t)item * 16384 + v * 128 + k4;
            u32x2 w; w.x = pk2(S0, S1); w.y = pk2(S2, S3); *(u32x2*)(SC + off) = w;
            const f32x4 dc = *(const f32x4*)(DEC + (size_t)item * 128 + k4); const u32x2 ds = *(const u32x2*)(DS + off);
            S0 = dc[0] * S0 + bflo(ds.x); S1 = dc[1] * S1 + bfhi(ds.x); S2 = dc[2] * S2 + bflo(ds.y); S3 = dc[3] * S3 + bfhi(ds.y);
        }
        float* o = outS + ((size_t)(b * 4 + h) * 128 + k4) * 128 + v;
        o[0] = S0; o[128] = S1; o[256] = S2; o[384] = S3;
    }
}

__device__ __forceinline__ void gmlp_item(const Ctx& C, LAS unsigned char* lds, int item) {
    const int tid = threadIdx.x, lane = tid & 63, wid = tid >> 6, r = lane & 15, qd = lane >> 4;
    const int n = item >> 2, g = item & 3; const size_t rb = (size_t)n * 128;
    LAS bf16_t* sW = (LAS bf16_t*)lds;
    LAS bf16_t* sVN = sW + 128 * 136;
    LAS float* sSt = (LAS float*)(sVN + 128 * 136);
    const bf16_t* Zgv = C.Z(6); const bf16_t* Zu = C.Z(5);
    u32x4 gvt[4]; u32x2 uu8[8]; float bb8[8];
#pragma unroll
    for (int it = 0; it < 4; ++it) { const int e = it * NTHR + tid; gvt[it] = *(const u32x4*)(Zgv + (rb + (e >> 4)) * 512 + g * 128 + (e & 15) * 8); }
#pragma unroll
    for (int ti = 0; ti < 8; ++ti) { uu8[ti] = *(const u32x2*)(Zu + (rb + 16 * ti + r) * 512 + g * 128 + 16 * wid + 4 * qd); bb8[ti] = C.in[13][g * 128 + 16 * ti + r]; }
    if (tid < 128) {
        const float* ln = C.wsf(WS_LN); const float s1 = ln[rb + tid], s2 = ln[MT + rb + tid];
        const float mean = s1 * (1.0f / 512.0f), var = fmaxf(s2 * (1.0f / 512.0f) - mean * mean, 0.f);
        sSt[tid * 2] = mean; sSt[tid * 2 + 1] = rsqrtf(var + EPS);
    }
    {
        const float* W = C.in[12] + (size_t)g * 16384;
#pragma unroll
        for (int it = 0; it < 8; ++it) { const int e = (it * NTHR + tid) * 4, t = e >> 7, s = e & 127; const f32x4 v = *(const f32x4*)(W + e);
            u32x2 w; w.x = pk2(s <= t ? v[0] : 0.f, s + 1 <= t ? v[1] : 0.f); w.y = pk2(s + 2 <= t ? v[2] : 0.f, s + 3 <= t ? v[3] : 0.f);
            *(LAS u32x2*)(sW + t * 136 + s) = w; }
    }
    __syncthreads();
    {
        const float* lgp = C.in[10] + g * 128; const float* lbp2 = C.in[11] + g * 128;
#pragma unroll
        for (int it = 0; it < 4; ++it) { const int e = it * NTHR + tid, sx = e >> 4, c8 = (e & 15) * 8;
            const u32x4 w = gvt[it]; const float mean = sSt[sx * 2], rs = sSt[sx * 2 + 1];
            const f32x4 g0 = *(const f32x4*)(lgp + c8), g1 = *(const f32x4*)(lgp + c8 + 4), b0 = *(const f32x4*)(lbp2 + c8), b1 = *(const f32x4*)(lbp2 + c8 + 4);
            u32x4 o;
            o.x = pk2((bflo(w.x) - mean) * rs * g0[0] + b0[0], (bfhi(w.x) - mean) * rs * g0[1] + b0[1]);
            o.y = pk2((bflo(w.y) - mean) * rs * g0[2] + b0[2], (bfhi(w.y) - mean) * rs * g0[3] + b0[3]);
            o.z = pk2((bflo(w.z) - mean) * rs * g1[0] + b1[0], (bfhi(w.z) - mean) * rs * g1[1] + b1[1]);
            o.w = pk2((bflo(w.w) - mean) * rs * g1[2] + b1[2], (bfhi(w.w) - mean) * rs * g1[3] + b1[3]);
            *(LAS u32x4*)(sVN + sx * 136 + c8) = o; }
    }
    __syncthreads();
    {
        bf16_t* O = C.wsb(WS_O);
        bf16x8 bfr[4];
#pragma unroll
        for (int k4 = 0; k4 < 4; ++k4) { unsigned x[8];
#pragma unroll
            for (int j = 0; j < 8; ++j) x[j] = sVN[(k4 * 32 + qd * 8 + j) * 136 + 16 * wid + r];
            u32x4 w; w.x = x[0] | (x[1] << 16); w.y = x[2] | (x[3] << 16); w.z = x[4] | (x[5] << 16); w.w = x[6] | (x[7] << 16);
            bfr[k4] = __builtin_bit_cast(bf16x8, w); }
#pragma unroll
        for (int ti = 0; ti < 8; ++ti) {
            f32x4 d = {0.f, 0.f, 0.f, 0.f};
#pragma unroll
            for (int k4 = 0; k4 < 4; ++k4) if (k4 <= (ti >> 1)) d = MFMA16(bfr[k4], ld8(sW + (16 * ti + r) * 136 + k4 * 32 + qd * 8), d);
            const int t = 16 * ti + r, cc = g * 128 + 16 * wid + 4 * qd; const float bb = bb8[ti];
            const u32x2 uu = uu8[ti];
            u32x2 w; w.x = pk2(bflo(uu.x) * (d[0] + bb), bfhi(uu.x) * (d[1] + bb)); w.y = pk2(bflo(uu.y) * (d[2] + bb), bfhi(uu.y) * (d[3] + bb));
            *(u32x2*)(O + (rb + t) * 1024 + 512 + cc) = w;
        }
    }
    __syncthreads();
}

__device__ __forceinline__ void hg_sample_item(const Ctx& C, LAS unsigned char* lds, int item) {
    const int tid = threadIdx.x, lane = tid & 63, wid = tid >> 6;
    const int bs = item >> 2, h = item & 3, hc = h * 128; const size_t r0 = (size_t)MP + bs * 4;
    LAS float* sq = (LAS float*)lds; LAS float* sk = sq + 512; LAS float* sf = sk + 512;
    LAS float* sp = sf + 512;
    LAS float* sred = sp + 2048;
    {
        const int t = tid >> 7, k = tid & 127; const size_t o = (r0 + t) * 512 + hc + k;
        sq[tid] = bf2f(C.Z(0)[o]); sk[tid] = bf2f(C.Z(1)[o]); sf[tid] = __expf(bf2f(C.Z(2)[o]));
    }
    const int v = tid & 127, kq = tid >> 7;
    const float gg_pre = bf2f(C.Z(4)[(r0 + (tid >> 7)) * 512 + hc + v]), hgn_pre = C.in[9][hc + v];
    float S[32];
    const float* sin = C.in[3] + (size_t)item * 16384 + (size_t)(kq * 32) * 128 + v;
#pragma unroll
    for (int j = 0; j < 32; ++j) S[j] = sin[j * 128];
    float vt[4];
#pragma unroll
    for (int t = 0; t < 4; ++t) vt[t] = bf2f(C.Z(3)[(r0 + t) * 512 + hc + v]);
    __syncthreads();
#pragma unroll
    for (int t = 0; t < 4; ++t) {
        float po = 0.f;
#pragma unroll
        for (int j = 0; j < 32; ++j) { const int k = kq * 32 + j; S[j] = sf[t * 128 + k] * S[j] + sk[t * 128 + k] * vt[t]; po += S[j] * sq[t * 128 + k]; }
        sp[(kq * 4 + t) * 128 + v] = po;
    }
    float* sout = C.out + OUT_SSMP + (size_t)item * 16384 + (size_t)(kq * 32) * 128 + v;
#pragma unroll
    for (int j = 0; j < 32; ++j) sout[j * 128] = S[j];
    __syncthreads();
    {
        const int t = tid >> 7;
        const float o = sp[(0 * 4 + t) * 128 + v] + sp[(1 * 4 + t) * 128 + v] + sp[(2 * 4 + t) * 128 + v] + sp[(3 * 4 + t) * 128 + v];
        float s = o * o;
#pragma unroll
        for (int x = 32; x >= 1; x >>= 1) s += __shfl_xor(s, x);
        if (lane == 0) sred[wid] = s;
        __syncthreads();
        const float ms = (sred[2 * t] + sred[2 * t + 1]) * (1.0f / 128.0f);
        C.wsb(WS_O)[(r0 + t) * 1024 + hc + v] = f2bf(o * rsqrtf(ms + EPS) * hgn_pre * gg_pre);
    }
    __syncthreads();
}

__device__ __forceinline__ void gmlp_sample_item(const Ctx& C, LAS unsigned char* lds, int bs) {
    const int tid = threadIdx.x, lane = tid & 63, wid = tid >> 6; const size_t r0 = (size_t)MP + bs * 4;
    LAS float* sred = (LAS float*)lds;
    const int c = tid, g = c >> 7;
    float gv[4], s[4], s2[4], uuv[4], bsv[4], wv[10];
    const float lg = C.in[10][c], lbb = C.in[11][c];
    { const float* W = C.in[12] + (size_t)g * 16384; const float* bsp = C.in[13] + g * 128; int q = 0;
#pragma unroll
      for (int t = 0; t < 4; ++t) { bsv[t] = bsp[t]; uuv[t] = bf2f(C.Z(5)[(r0 + t) * 512 + c]);
#pragma unroll
          for (int sx = 0; sx < 4; ++sx) if (sx <= t) wv[q++] = W[t * 128 + sx]; } }
#pragma unroll
    for (int t = 0; t < 4; ++t) { gv[t] = bf2f(C.Z(6)[(r0 + t) * 512 + c]); s[t] = gv[t]; s2[t] = gv[t] * gv[t]; }
#pragma unroll
    for (int t = 0; t < 4; ++t)
#pragma unroll
        for (int x = 32; x >= 1; x >>= 1) { s[t] += __shfl_xor(s[t], x); s2[t] += __shfl_xor(s2[t], x); }
    if (lane == 0) {
#pragma unroll
        for (int t = 0; t < 4; ++t) { sred[wid * 8 + t] = s[t]; sred[wid * 8 + 4 + t] = s2[t]; } }
    __syncthreads();
    float vn[4];
#pragma unroll
    for (int t = 0; t < 4; ++t) { float a = 0.f, a2 = 0.f;
#pragma unroll
        for (int w = 0; w < 8; ++w) { a += sred[w * 8 + t]; a2 += sred[w * 8 + 4 + t]; }
        const float mean = a * (1.0f / 512.0f), var = fmaxf(a2 * (1.0f / 512.0f) - mean * mean, 0.f);
        vn[t] = (gv[t] - mean) * rsqrtf(var + EPS) * lg + lbb;
        C.out[OUT_CMV + ((size_t)bs * 4 + t) * 512 + c] = vn[t]; }
    { int q = 0;
#pragma unroll
      for (int t = 0; t < 4; ++t) { float mix = bsv[t];
#pragma unroll
          for (int sx = 0; sx < 4; ++sx) if (sx <= t) mix += wv[q++] * vn[sx];
          C.wsb(WS_O)[(r0 + t) * 1024 + 512 + c] = f2bf(uuv[t] * mix); } }
    __syncthreads();
}

__device__ __forceinline__ void hg_out(const Ctx& C, LAS unsigned char* lds) {
    const int tid = threadIdx.x, lane = tid & 63, wid = tid >> 6, r = lane & 15, qd = lane >> 4;
    const bf16_t* __restrict__ QE = C.Z(7); const bf16_t* __restrict__ SC = C.wsb(WS_SC); const bf16_t* __restrict__ OI = C.wsb(WS_OI); const bf16_t* __restrict__ Zg = C.Z(4); bf16_t* __restrict__ O = C.wsb(WS_O);
    const float* hgn = C.in[9];
    LAS bf16_t* sS = (LAS bf16_t*)lds;
    const int sv = (tid >> 4) & 127, sk8 = (tid & 15) * 8;
    u32x4 st[8];
    int p = blockIdx.x;
#define HGO_LOAD(pp) do { _Pragma("unroll") for (int it = 0; it < 8; ++it) { const int e = it * NTHR + tid; \
        st[it] = *(const u32x4*)(SC + (size_t)(2 * (pp) + (e >> 11)) * 16384 + ((e & 2047) >> 4) * 128 + (e & 15) * 8); } } while (0)
    if (p < 512) HGO_LOAD(p);
    for (; p < 512; p += gridDim.x) {
        const int item = 2 * p + (wid >> 2), ti = wid & 3; const int b = item >> 7, c = (item >> 2) & 31, h = item & 3, hc = h * 128;
        const size_t row = (size_t)b * 2048 + c * 64 + 16 * ti + r;
        bf16x8 a[4];
#pragma unroll
        for (int k4 = 0; k4 < 4; ++k4) a[k4] = gld8(QE + row * 512 + hc + k4 * 32 + qd * 8);
        u32x2 oi[8], gg[8];
#pragma unroll
        for (int vt = 0; vt < 8; ++vt) { oi[vt] = *(const u32x2*)(OI + row * 512 + hc + 16 * vt + 4 * qd); gg[vt] = *(const u32x2*)(Zg + row * 512 + hc + 16 * vt + 4 * qd); }
        __syncthreads();
#pragma unroll
        for (int it = 0; it < 8; ++it) { const int e = it * NTHR + tid; *(LAS u32x4*)(sS + (e >> 11) * (128 * 136) + ((e & 2047) >> 4) * 136 + (e & 15) * 8) = st[it]; }
        __syncthreads();
        if (p + (int)gridDim.x < 512) HGO_LOAD(p + gridDim.x);
        const LAS bf16_t* sT = sS + (wid >> 2) * (128 * 136);
        f32x4 d[8];
#pragma unroll
        for (int vt = 0; vt < 8; ++vt) { d[vt] = (f32x4){0.f, 0.f, 0.f, 0.f};
#pragma unroll
            for (int k4 = 0; k4 < 4; ++k4) d[vt] = MFMA16(ld8(sT + (16 * vt + r) * 136 + k4 * 32 + qd * 8), a[k4], d[vt]); }
        float sq = 0.f;
#pragma unroll
        for (int vt = 0; vt < 8; ++vt) {
            d[vt][0] += bflo(oi[vt].x); d[vt][1] += bfhi(oi[vt].x); d[vt][2] += bflo(oi[vt].y); d[vt][3] += bfhi(oi[vt].y);
            sq += (d[vt][0] * d[vt][0] + d[vt][1] * d[vt][1]) + (d[vt][2] * d[vt][2] + d[vt][3] * d[vt][3]); }
        sq += __shfl_xor(sq, 16); sq += __shfl_xor(sq, 32);
        const float rs = rsqrtf(sq * (1.0f / 128.0f) + EPS);
#pragma unroll
        for (int vt = 0; vt < 8; ++vt) { const int cc = hc + 16 * vt + 4 * qd; const f32x4 gn = *(const f32x4*)(hgn + cc);
            u32x2 w; w.x = pk2(d[vt][0] * rs * gn[0] * bflo(gg[vt].x), d[vt][1] * rs * gn[1] * bfhi(gg[vt].x)); w.y = pk2(d[vt][2] * rs * gn[2] * bflo(gg[vt].y), d[vt][3] * rs * gn[3] * bfhi(gg[vt].y));
            *(u32x2*)(O + row * 1024 + cc) = w; }
    }
#undef HGO_LOAD
    __syncthreads();
    (void)sv; (void)sk8;
}

__device__ __forceinline__ void attn_prompt_item(const Ctx& C, LAS unsigned char* lds, int item) {
    const int tid = threadIdx.x, lane = tid & 63, wid = tid >> 6, r = lane & 15, qd = lane >> 4;
    const int b = item >> 5, h = (item >> 3) & 3, qt = item & 7;
    int opq = 0; asm volatile("" : "+v"(opq));
    LAS bf16_t* sK = (LAS bf16_t*)lds + opq;
    const bf16_t* KB = C.wsb(WS_KB); const bf16_t* VT = C.wsb(WS_VT); const bf16_t* HQ = C.wsb(WS_HQ); bf16_t* CA = C.wsb(WS_CA);
    const size_t q0 = (size_t)b * 2048 + qt * 256 + wid * 32;
    {   const bf16_t* gsrc = KB + ((size_t)b * 256 + (tid >> 5)) * 1024 + h * 256 + (tid & 31) * 8; LAS bf16_t* ldst = sK + (tid >> 5) * 264 + (tid & 31) * 8;
        u32x4 stg[16];
#pragma unroll
        for (int it = 0; it < 16; ++it) stg[it] = *(const u32x4*)(gsrc + (size_t)it * 16 * 1024);
#pragma unroll
        for (int it = 0; it < 16; ++it) *(LAS u32x4*)(ldst + it * 16 * 264) = stg[it]; }
    bf16x8 qf[2][8];
#pragma unroll
    for (int x = 0; x < 2; ++x)
#pragma unroll
        for (int k8 = 0; k8 < 8; ++k8) qf[x][k8] = gld8(HQ + (q0 + x * 16 + r) * 1024 + h * 256 + k8 * 32 + qd * 8);
    __syncthreads();
    bf16x8 pf[2][8];
    {
        f32x4 s[2][16];
#pragma unroll
        for (int mt = 0; mt < 16; ++mt) { s[0][mt] = (f32x4){0.f, 0.f, 0.f, 0.f}; s[1][mt] = (f32x4){0.f, 0.f, 0.f, 0.f};
#pragma unroll
            for (int k8 = 0; k8 < 8; ++k8) { const bf16x8 kf = ld8(sK + (16 * mt + r) * 264 + k8 * 32 + qd * 8);
                s[0][mt] = MFMA16(kf, qf[0][k8], s[0][mt]); s[1][mt] = MFMA16(kf, qf[1][k8], s[1][mt]); } }
#pragma unroll
        for (int x = 0; x < 2; ++x) {
            float mx = -3.0e38f;
#pragma unroll
            for (int mt = 0; mt < 16; ++mt)
#pragma unroll
                for (int jx = 0; jx < 4; ++jx) mx = fmaxf(mx, s[x][mt][jx]);
            mx = fmaxf(mx, __shfl_xor(mx, 16)); mx = fmaxf(mx, __shfl_xor(mx, 32));
            float sum = 0.f;
#pragma unroll
            for (int mt = 0; mt < 16; ++mt)
#pragma unroll
                for (int jx = 0; jx < 4; ++jx) { const float e = __expf(s[x][mt][jx] - mx); s[x][mt][jx] = e; sum += e; }
            sum += __shfl_xor(sum, 16); sum += __shfl_xor(sum, 32);
            const float inv = __builtin_amdgcn_rcpf(sum);
#pragma unroll
            for (int k8 = 0; k8 < 8; ++k8) { u32x4 w; w.x = pk2(s[x][2 * k8][0] * inv, s[x][2 * k8][1] * inv); w.y = pk2(s[x][2 * k8][2] * inv, s[x][2 * k8][3] * inv);
                w.z = pk2(s[x][2 * k8 + 1][0] * inv, s[x][2 * k8 + 1][1] * inv); w.w = pk2(s[x][2 * k8 + 1][2] * inv, s[x][2 * k8 + 1][3] * inv);
                pf[x][k8] = __builtin_bit_cast(bf16x8, w); }
        }
    }
    __syncthreads();
    {   const bf16_t* gsrc = VT + ((size_t)b * 1024 + h * 256 + (tid >> 5)) * 256 + (tid & 31) * 8; LAS bf16_t* ldst = sK + (tid >> 5) * 264 + (tid & 31) * 8;
        u32x4 stg[16];
#pragma unroll
        for (int it = 0; it < 16; ++it) stg[it] = *(const u32x4*)(gsrc + (size_t)it * 16 * 256);
#pragma unroll
        for (int it = 0; it < 16; ++it) *(LAS u32x4*)(ldst + it * 16 * 264) = stg[it]; }
    __syncthreads();
#pragma unroll 2
    for (int dt = 0; dt < 16; ++dt) {
        f32x4 o0 = {0.f, 0.f, 0.f, 0.f}, o1 = {0.f, 0.f, 0.f, 0.f};
        bf16x8 vf[8];
#pragma unroll
        for (int k8 = 0; k8 < 8; ++k8) {
            const LAS bf16_t* vp = sK + (16 * dt + r) * 264 + 32 * k8 + 4 * qd;
            const u32x2 lo = *(const LAS u32x2*)vp, hi = *(const LAS u32x2*)(vp + 16);
            u32x4 w; w.x = lo.x; w.y = lo.y; w.z = hi.x; w.w = hi.y; vf[k8] = __builtin_bit_cast(bf16x8, w);
        }
#pragma unroll
        for (int k8 = 0; k8 < 8; ++k8) { o0 = MFMA16(vf[k8], pf[0][k8], o0); o1 = MFMA16(vf[k8], pf[1][k8], o1); }
        u32x2 w0, w1; w0.x = pk2(o0[0], o0[1]); w0.y = pk2(o0[2], o0[3]); w1.x = pk2(o1[0], o1[1]); w1.y = pk2(o1[2], o1[3]);
        *(u32x2*)(CA + (q0 + r) * 1024 + h * 256 + 16 * dt + 4 * qd) = w0;
        *(u32x2*)(CA + (q0 + 16 + r) * 1024 + h * 256 + 16 * dt + 4 * qd) = w1;
    }
    __syncthreads();
}

__device__ __forceinline__ void attn_sample_item(const Ctx& C, LAS unsigned char* lds, int item) {
    const int tid = threadIdx.x, lane = tid & 63, wid = tid >> 6, r = lane & 15, qd = lane >> 4;
    const int bs = item >> 1, hp = item & 1, hl = wid & 1, h = 2 * hp + hl, kq = wid >> 1;
    LAS float* sP = (LAS float*)lds;
    LAS float* sMx = sP + 2048;
    LAS float* sSm = sMx + 32;
    LAS float* sO = sSm + 32;
    const bf16_t* HQ = C.wsb(WS_HQ); const size_t r0 = (size_t)MP + bs * 4;
    const float* Kc = C.in[4] + (size_t)bs * 262144; const float* Vc = C.in[5] + (size_t)bs * 262144;
    bf16x8 qf[8];
#pragma unroll
    for (int k8 = 0; k8 < 8; ++k8) { if (r < 4) qf[k8] = gld8(HQ + (r0 + r) * 1024 + h * 256 + k8 * 32 + qd * 8); else qf[k8] = (bf16x8){0, 0, 0, 0, 0, 0, 0, 0}; }
    f32x4 s[4];
    const float* kp = Kc + ((size_t)(kq * 64 + r) * 4 + h) * 256 + qd * 8;
    const float* vp = Vc + ((size_t)(kq * 64) * 4 + h) * 256 + lane * 4;
    f32x4 ka[16], kb[16];
#define LOADK(dst, mt) do { _Pragma("unroll") for (int k8 = 0; k8 < 8; ++k8) { dst[2 * k8] = *(const f32x4*)(kp + (size_t)(mt) * 16384 + k8 * 32); dst[2 * k8 + 1] = *(const f32x4*)(kp + (size_t)(mt) * 16384 + k8 * 32 + 4); } } while (0)
#define MMAK(src, mt) do { s[mt] = (f32x4){0.f, 0.f, 0.f, 0.f}; _Pragma("unroll") for (int k8 = 0; k8 < 8; ++k8) { u32x4 w; w.x = pk2(src[2 * k8][0], src[2 * k8][1]); w.y = pk2(src[2 * k8][2], src[2 * k8][3]); \
        w.z = pk2(src[2 * k8 + 1][0], src[2 * k8 + 1][1]); w.w = pk2(src[2 * k8 + 1][2], src[2 * k8 + 1][3]); s[mt] = MFMA16(__builtin_bit_cast(bf16x8, w), qf[k8], s[mt]); } } while (0)
#define LOADV(dst, m0) do { _Pragma("unroll") for (int m = 0; m < 16; ++m) dst[m] = *(const f32x4*)(vp + (size_t)((m0) + m) * 1024); } while (0)
#define FMAV(src, m0) do { _Pragma("unroll") for (int m = 0; m < 16; ++m) { _Pragma("unroll") for (int t = 0; t < 4; ++t) acc[t] += src[m] * sP[(wid * 4 + t) * 64 + (m0) + m]; } } while (0)
    LOADK(ka, 0); LOADK(kb, 1);
    MMAK(ka, 0); LOADK(ka, 2);
    MMAK(kb, 1); LOADK(kb, 3);
    MMAK(ka, 2); LOADV(ka, 0);
    MMAK(kb, 3); LOADV(kb, 16);
    float mx = -3.0e38f;
#pragma unroll
    for (int mt = 0; mt < 4; ++mt)
#pragma unroll
        for (int jx = 0; jx < 4; ++jx) mx = fmaxf(mx, s[mt][jx]);
    mx = fmaxf(mx, __shfl_xor(mx, 16)); mx = fmaxf(mx, __shfl_xor(mx, 32));
    float sum = 0.f;
#pragma unroll
    for (int mt = 0; mt < 4; ++mt)
#pragma unroll
        for (int jx = 0; jx < 4; ++jx) { const float e = __expf(s[mt][jx] - mx); s[mt][jx] = e; sum += e; }
    sum += __shfl_xor(sum, 16); sum += __shfl_xor(sum, 32);
    if (lane < 4) { sMx[(hl * 4 + kq) * 4 + lane] = mx; sSm[(hl * 4 + kq) * 4 + lane] = sum; }
    if (r < 4) {
#pragma unroll
        for (int mt = 0; mt < 4; ++mt)
#pragma unroll
            for (int jx = 0; jx < 4; ++jx) sP[(wid * 4 + r) * 64 + 16 * mt + 4 * qd + jx] = s[mt][jx];
    }
    {
        f32x4 acc[4];
#pragma unroll
        for (int t = 0; t < 4; ++t) acc[t] = (f32x4){0.f, 0.f, 0.f, 0.f};
        FMAV(ka, 0); LOADV(ka, 32);
        FMAV(kb, 16); LOADV(kb, 48);
        FMAV(ka, 32); FMAV(kb, 48);
#pragma unroll
        for (int t = 0; t < 4; ++t) *(LAS f32x4*)(sO + ((hl * 4 + kq) * 4 + t) * 256 + lane * 4) = acc[t];
    }
#undef LOADK
#undef MMAK
#undef LOADV
#undef FMAV
    __syncthreads();
    {
        const int e = tid * 4, hl2 = e >> 10, t = (e >> 8) & 3, d = e & 255;
        float m4[4], w4[4]; float gm = -3.0e38f, den = 0.f;
#pragma unroll
        for (int q4 = 0; q4 < 4; ++q4) { m4[q4] = sMx[(hl2 * 4 + q4) * 4 + t]; gm = fmaxf(gm, m4[q4]); }
#pragma unroll
        for (int q4 = 0; q4 < 4; ++q4) { w4[q4] = __expf(m4[q4] - gm); den += w4[q4] * sSm[(hl2 * 4 + q4) * 4 + t]; }
        const float inv = __builtin_amdgcn_rcpf(den);
        f32x4 o = {0.f, 0.f, 0.f, 0.f};
#pragma unroll
        for (int q4 = 0; q4 < 4; ++q4) o += *(const LAS f32x4*)(sO + ((hl2 * 4 + q4) * 4 + t) * 256 + d) * (w4[q4] * inv);
        u32x2 w; w.x = pk2(o[0], o[1]); w.y = pk2(o[2], o[3]);
        *(u32x2*)(C.wsb(WS_CA) + (r0 + t) * 1024 + (2 * hp + hl2) * 256 + d) = w;
    }
    __syncthreads();
}

template <class F> __device__ __forceinline__ void sgemm_tile(const bf16_t* A, const bf16_t* Bt, int K, int N, int tile, LAS unsigned char* lds, const F& epi) {
    const int tid = threadIdx.x, lane = tid & 63, wid = tid >> 6, r = lane & 15, qd = lane >> 4;
    const int ntn = N >> 6; const int mt = tile / ntn, nt = tile - mt * ntn;
    const int row0 = MP + 32 * mt, n0 = 64 * nt; const int KW = K >> 3;
    f32x4 acc[2][4];
#pragma unroll
    for (int mi = 0; mi < 2; ++mi)
#pragma unroll
        for (int ni = 0; ni < 4; ++ni) acc[mi][ni] = (f32x4){0.f, 0.f, 0.f, 0.f};
    const bf16_t* ap = A + (size_t)(row0 + r) * K + wid * KW + qd * 8;
    const bf16_t* bp = Bt + (size_t)(n0 + r) * K + wid * KW + qd * 8;
#pragma unroll 1
    for (int kc = 0; kc < KW; kc += 128) {
        bf16x8 a[2][4], b[4][4];
#pragma unroll
        for (int ks = 0; ks < 4; ++ks) {
#pragma unroll
            for (int mi = 0; mi < 2; ++mi) a[mi][ks] = gld8(ap + (size_t)mi * 16 * K + kc + ks * 32);
#pragma unroll
            for (int ni = 0; ni < 4; ++ni) b[ni][ks] = gld8(bp + (size_t)ni * 16 * K + kc + ks * 32);
        }
#pragma unroll
        for (int ks = 0; ks < 4; ++ks)
#pragma unroll
            for (int mi = 0; mi < 2; ++mi)
#pragma unroll
                for (int ni = 0; ni < 4; ++ni) acc[mi][ni] = MFMA16(a[mi][ks], b[ni][ks], acc[mi][ni]);
    }
    LAS float* red = (LAS float*)lds;
#pragma unroll
    for (int mi = 0; mi < 2; ++mi)
#pragma unroll
        for (int ni = 0; ni < 4; ++ni)
#pragma unroll
            for (int jx = 0; jx < 4; ++jx) red[(wid * 32 + 16 * mi + 4 * qd + jx) * 68 + 16 * ni + r] = acc[mi][ni][jx];
    __syncthreads();
    {
        const int row = tid >> 4, c4 = (tid & 15) * 4;
        f32x4 v = *(const LAS f32x4*)(red + row * 68 + c4);
#pragma unroll
        for (int w = 1; w < 8; ++w) v += *(const LAS f32x4*)(red + (w * 32 + row) * 68 + c4);
        epi(row0 + row, n0 + c4, v);
    }
    __syncthreads();
}
struct SEpi1 {
    bf16_t* Zb; const float* lbp; float* ln;
    __device__ __forceinline__ void operator()(int row, int col, const f32x4& v) const {
        const int sec = col >> 9, cs = col & 511; const size_t o = (size_t)row * 512 + cs;
        if (sec == 1) {
            const f32x4 p0 = *(const f32x4*)(lbp + cs), p1 = *(const f32x4*)(lbp + 512 + cs); float kk[4], lf[4];
#pragma unroll
            for (int j = 0; j < 4; ++j) { const float lb = sigm(p0[j] - p1[j]), sg = sigm(v[j]), oml = 1.0f - lb; kk[j] = oml * (1.0f - sg); lf[j] = __logf(lb + oml * sg); }
            u32x2 w; w.x = pk2(kk[0], kk[1]); w.y = pk2(kk[2], kk[3]); *(u32x2*)(Zb + ZSZ + o) = w;
            w.x = pk2(lf[0], lf[1]); w.y = pk2(lf[2], lf[3]); *(u32x2*)(Zb + 2 * ZSZ + o) = w;
        } else {
            float rr[4];
#pragma unroll
            for (int j = 0; j < 4; ++j) { const float z = v[j]; const float t = (sec >= 4) ? 1.5957691216f * (z + 0.044715f * z * z * z) : z; const float sg = sigm(t);
                rr[j] = (sec == 2) ? z : ((sec == 3) ? sg : z * sg); }
            u32x2 w; w.x = pk2(rr[0], rr[1]); w.y = pk2(rr[2], rr[3]); *(u32x2*)(Zb + (size_t)(sec == 0 ? 0 : sec + 1) * ZSZ + o) = w;
            if (sec == 5) { float a = (rr[0] + rr[1]) + (rr[2] + rr[3]), b = (rr[0] * rr[0] + rr[1] * rr[1]) + (rr[2] * rr[2] + rr[3] * rr[3]);
                a += __shfl_xor(a, 1); b += __shfl_xor(b, 1); a += __shfl_xor(a, 2); b += __shfl_xor(b, 2); a += __shfl_xor(a, 4); b += __shfl_xor(b, 4); a += __shfl_xor(a, 8); b += __shfl_xor(b, 8);
                if ((threadIdx.x & 15) == 0) { atomicAdd(ln + row, a); atomicAdd(ln + MT + row, b); } }
        }
    }
};
template <bool RB> struct SEpiRes {
    const float* resf; bf16_t* xb; float* ss;
    __device__ __forceinline__ void operator()(int row, int col, const f32x4& a) const {
        const size_t o = (size_t)row * 1024 + col; f32x4 v;
        if (RB) { const u32x2 rr = *(const u32x2*)(xb + o); v = (f32x4){bflo(rr.x), bfhi(rr.x), bflo(rr.y), bfhi(rr.y)} + a; }
        else v = *(const f32x4*)(resf + o) + a;
        u32x2 w; w.x = pk2(v[0], v[1]); w.y = pk2(v[2], v[3]); *(u32x2*)(xb + o) = w;
        float s = (v[0] * v[0] + v[1] * v[1]) + (v[2] * v[2] + v[3] * v[3]);
        s += __shfl_xor(s, 1); s += __shfl_xor(s, 2); s += __shfl_xor(s, 4); s += __shfl_xor(s, 8);
        if ((threadIdx.x & 15) == 0) atomicAdd(ss + row, s);
    }
};
template <int ACT> struct SEpiScale {
    bf16_t* O; int ldc; const float* ss; float scale;
    __device__ __forceinline__ void operator()(int row, int col, const f32x4& a) const {
        const float rs = rsqrtf(ss[row] * (1.0f / 1024.0f) + EPS) * scale; f32x4 v = a * rs;
        if (ACT == 1) {
#pragma unroll
            for (int j = 0; j < 4; ++j) { const float x = fmaxf(v[j], 0.f); v[j] = x * x; } }
        u32x2 w; w.x = pk2(v[0], v[1]); w.y = pk2(v[2], v[3]); *(u32x2*)(O + (size_t)row * ldc + col) = w;
    }
};


__device__ __forceinline__ void panel_wait(unsigned* cnt, unsigned want) {
    if (threadIdx.x == 0) {
        __hip_atomic_fetch_add(cnt, 1u, __ATOMIC_RELAXED, __HIP_MEMORY_SCOPE_AGENT);
        unsigned sp = 0;
        while (__hip_atomic_load(cnt, __ATOMIC_RELAXED, __HIP_MEMORY_SCOPE_AGENT) < want) { __builtin_amdgcn_s_sleep(2); if (++sp > (1u << 22)) break; }
        __builtin_amdgcn_fence(__ATOMIC_ACQUIRE, "agent");
        asm volatile("s_waitcnt vmcnt(0)" ::: "memory");
    }
}
struct EpiFinal {
    static constexpr bool PERM = false, AFTER_DRAIN = true;
    const bf16_t* res; float* out; float* ss; unsigned* cnt; const float* gfin;
    __device__ __forceinline__ void fused(f32x4 (&acc)[2][2][4][2], const pg8::Unit& u, int wr, int wc, int fr, int fq, LAS unsigned char* lds, int wid, int lane) const {
        const int row0 = u.pm * 256 + wr * 64 + fr, col0 = u.pn * 256 + wc * 32 + 4 * fq;
#pragma unroll
        for (int ai = 0; ai < 2; ++ai)
#pragma unroll
            for (int m = 0; m < 4; ++m) {
                const int row = row0 + ai * 128 + m * 16; const size_t o = (size_t)row * 1024 + col0; float s = 0.f;
#pragma unroll
                for (int bj = 0; bj < 2; ++bj)
#pragma unroll
                    for (int n = 0; n < 2; ++n) { const u32x2 rr = *(const u32x2*)(res + o + bj * 128 + n * 16); const f32x4 v = (f32x4){bflo(rr.x), bfhi(rr.x), bflo(rr.y), bfhi(rr.y)} + acc[ai][bj][m][n]; acc[ai][bj][m][n] = v;
                        s += (v[0] * v[0] + v[1] * v[1]) + (v[2] * v[2] + v[3] * v[3]); }
                s += __shfl_xor(s, 16); s += __shfl_xor(s, 32);
                if (fq == 0) atomicAdd(ss + row, s);
            }
        asm volatile("s_waitcnt vmcnt(0)" ::: "memory");
        __syncthreads();
        panel_wait(cnt + 64 * u.pm, 4u);
        __syncthreads();
        f32x4 gv[2][2];
#pragma unroll
        for (int bj = 0; bj < 2; ++bj)
#pragma unroll
            for (int n = 0; n < 2; ++n) gv[bj][n] = *(const f32x4*)(gfin + col0 + bj * 128 + n * 16);
        float ssv[2][4];
#pragma unroll
        for (int ai = 0; ai < 2; ++ai)
#pragma unroll
            for (int m = 0; m < 4; ++m) ssv[ai][m] = __hip_atomic_load(ss + row0 + ai * 128 + m * 16, __ATOMIC_RELAXED, __HIP_MEMORY_SCOPE_AGENT);
#pragma unroll
        for (int ai = 0; ai < 2; ++ai)
#pragma unroll
            for (int m = 0; m < 4; ++m) {
                const int row = row0 + ai * 128 + m * 16; const size_t o = (size_t)row * 1024 + col0;
                const float rs = rsqrtf(ssv[ai][m] * (1.0f / 1024.0f) + EPS);
#pragma unroll
                for (int bj = 0; bj < 2; ++bj)
#pragma unroll
                    for (int n = 0; n < 2; ++n) *(f32x4*)(out + o + bj * 128 + n * 16) = acc[ai][bj][m][n] * rs * gv[bj][n];
            }
    }
};
struct SEpiFinal {
    const bf16_t* res; float* out; float* ss; unsigned* cnt; const float* gfin;
    __device__ __forceinline__ void operator()(int row, int col, const f32x4& a) const {
        const size_t o = (size_t)row * 1024 + col; const u32x2 rr = *(const u32x2*)(res + o); const f32x4 v = (f32x4){bflo(rr.x), bfhi(rr.x), bflo(rr.y), bfhi(rr.y)} + a;
        float s = (v[0] * v[0] + v[1] * v[1]) + (v[2] * v[2] + v[3] * v[3]);
        s += __shfl_xor(s, 1); s += __shfl_xor(s, 2); s += __shfl_xor(s, 4); s += __shfl_xor(s, 8);
        if ((threadIdx.x & 15) == 0) atomicAdd(ss + row, s);
        asm volatile("s_waitcnt vmcnt(0)" ::: "memory");
        __syncthreads();
        panel_wait(cnt + 64 * ((row - MP) >> 5), 16u);
        __syncthreads();
        const float rs = rsqrtf(__hip_atomic_load(ss + row, __ATOMIC_RELAXED, __HIP_MEMORY_SCOPE_AGENT) * (1.0f / 1024.0f) + EPS);
        *(f32x4*)(out + o) = v * rs * *(const f32x4*)(gfin + col);
    }
};

#define XB_TMO      128
#define XB_XCNT(j)  (256  + 64 * (j))
#define XB_XSUB(j)  (1280 + 64 * (j))
#define XB_XGEN(j)  (2304 + 64 * (j))
#define XB_TOP      3328
#define XB_TOPGEN   3392
#define XCD_BAR_WORDS 3456
#define XB_SPIN_CAP (1u << 18)

__device__ __forceinline__ unsigned xb_ld(unsigned* p)              { return __hip_atomic_load(p, __ATOMIC_RELAXED, __HIP_MEMORY_SCOPE_AGENT); }
__device__ __forceinline__ unsigned xb_add(unsigned* p, unsigned v) { return __hip_atomic_fetch_add(p, v, __ATOMIC_RELAXED, __HIP_MEMORY_SCOPE_AGENT); }
__device__ __forceinline__ unsigned xb_xcc_id() { return (unsigned)__builtin_amdgcn_s_getreg((3 << 11) | 20) & 0xFu; }
#define XB_SPIN(cond, bar) do { unsigned _sp = 0; while (cond) { __builtin_amdgcn_s_sleep(1); \
    if ((++_sp & 255u) == 0u) { if (xb_ld(&(bar)[XB_TMO])) break; if (_sp > XB_SPIN_CAP) { atomicAdd(&(bar)[XB_TMO], 1u); break; } } } } while (0)

struct XcdBarrier {
    unsigned* bar; unsigned x;
    volatile LAS unsigned* st;
};

__device__ __forceinline__ XcdBarrier xcd_barrier_post(unsigned* bar, volatile LAS unsigned* st) {
    XcdBarrier b; b.bar = bar; b.x = xb_xcc_id(); b.st = st;
    if (threadIdx.x == 0) (void)xb_add(&bar[XB_XCNT(b.x)], 1u);
    return b;
}
__device__ __forceinline__ void xcd_barrier_complete(unsigned* bar, unsigned x, unsigned& nloc, unsigned& nx) {
    const unsigned G = gridDim.x * gridDim.y * gridDim.z;
    unsigned sum, cnt, mine, sp = 0u;
    for (;;) {
        sum = 0u; cnt = 0u; mine = 0u;
#pragma unroll
        for (unsigned j = 0; j < 16; ++j) { const unsigned c = xb_ld(&bar[XB_XCNT(j)]); sum += c; cnt += (c > 0u) ? 1u : 0u; mine = (j == x) ? c : mine; }
        if (sum == G) break;
        __builtin_amdgcn_s_sleep(1);
        if ((++sp & 255u) == 0u) { if (xb_ld(&bar[XB_TMO])) break; if (sp > XB_SPIN_CAP) { atomicAdd(&bar[XB_TMO], 1u); break; } }
    }
    nloc = mine > 0u ? mine : 1u; nx = cnt > 0u ? cnt : 1u;
}

__device__ __forceinline__ void xcd_barrier(const XcdBarrier& b) {
    asm volatile("s_waitcnt vmcnt(0)" ::: "memory");
    __syncthreads();
    if (threadIdx.x == 0) {
        unsigned* bar = b.bar;
        __builtin_amdgcn_s_waitcnt(0);
        unsigned nloc = b.st[0], nx = b.st[1];
        if (nloc == 0u) { xcd_barrier_complete(bar, b.x, nloc, nx); b.st[0] = nloc; b.st[1] = nx; }
        const unsigned old = xb_add(&bar[XB_XSUB(b.x)], 1u);
        const unsigned gen = old / nloc;
        if (old + 1u == (gen + 1u) * nloc) {
            __builtin_amdgcn_fence(__ATOMIC_RELEASE, "agent");
            asm volatile("s_waitcnt vmcnt(0)" ::: "memory");
            const unsigned og = xb_add(&bar[XB_TOP], 1u);
            const unsigned tg = og / nx;
            if (og + 1u == (tg + 1u) * nx) xb_add(&bar[XB_TOPGEN], 1u);
            else XB_SPIN(xb_ld(&bar[XB_TOPGEN]) == tg, bar);
            __builtin_amdgcn_fence(__ATOMIC_ACQUIRE, "agent");
            xb_add(&bar[XB_XGEN(b.x)], 1u);
            asm volatile("s_waitcnt vmcnt(0)" ::: "memory");
        } else {
            XB_SPIN(xb_ld(&bar[XB_XGEN(b.x)]) == gen, bar);
            __builtin_amdgcn_fence(__ATOMIC_ACQUIRE, "agent");
            asm volatile("s_waitcnt vmcnt(0)" ::: "memory");
        }
    }
    __syncthreads();
}


constexpr int NPH = 11;
constexpr size_t WS_BAR = WS_END + 4096 - (WS_END % 4096);
constexpr int BAR_BYTES = 65536;
constexpr int LDS_ST_OFF = LDS_BYTES - 16;
static_assert(WS_BAR + BAR_BYTES < 512 * MB && XCD_BAR_WORDS <= 4096 && (4096 + 80 * 64) * 4 <= BAR_BYTES, "barrier words");
__global__ void __launch_bounds__(NTHR, 2) mega(Params P) {
    extern __shared__ __attribute__((aligned(16))) unsigned char smem[];
    LAS unsigned char* lds = (LAS unsigned char*)smem;
    cg::grid_group grid = cg::this_grid();
    const Ctx& C = P;
    const int lo = P.ph_lo, hi = P.ph_hi; const int G = gridDim.x, bx = blockIdx.x;
    if (threadIdx.x < 4) ((LAS unsigned*)(lds + LDS_ST_OFF))[threadIdx.x] = 0u;
    __syncthreads();
    XcdBarrier bar = xcd_barrier_post((unsigned*)(P.ws + WS_BAR), (volatile LAS unsigned*)(lds + LDS_ST_OFF));
    if (lo < 0) grid.sync();
#define IN(k) (lo <= (k) && (k) < hi)
#ifndef REP_PHASE
#define REP_PHASE -1
#endif
#define REPEAT(k) for (int rep_ = 0; rep_ < ((REP_PHASE == (k)) ? 2 : 1); ++rep_, (REP_PHASE == (k) && rep_ == 1) ? xcd_barrier(bar) : (void)0)
#define SEAM(k) do { if (IN(k) && IN((k) + 1)) xcd_barrier(bar); } while (0)
    if (IN(0)) REPEAT(0) phase_prep(C, lds);
    SEAM(0);
#define P1_MEM() do { pg8::Gemm g{C.wsb(WS_MEMN), C.wsb(WS_WCKV), NMR, 2048, DM}; pg8::StaticOrder S; S.init(NMR, 2048, G, bx); \
          EpiMem E{C.out + OUT_MK, C.out + OUT_MV, C.wsb(WS_KB), C.wsb(WS_VT)}; pg8::gemm_phase<EpiMem, pg8::StaticOrder>(lds, g, S, E, nullptr); } while (0)
#define P1_BIG() do { pg8::Gemm g{C.wsb(WS_HN), C.wsb(WS_WIN), MP, NIN, DM}; pg8::StaticOrder S; S.init(MP, NIN, G, bx); \
        Epi1 E{C.Z(0), C.in[6], C.wsf(WS_LN)}; pg8::gemm_phase<Epi1, pg8::StaticOrder>(lds, g, S, E, nullptr); } while (0)
    if (IN(1)) {
        const int grp = (bx >> 3) & 3; SEpi1 SE{C.Z(0), C.in[6], C.wsf(WS_LN)};
        const int t0 = (G > 128) ? bx - 64 : bx, tstep = (G > 128) ? G - 64 : G; const bool tiles = (G <= 128) || bx >= 64;
        int t = t0, k = 0;
        if (tiles) for (; t < 768 && k < grp; t += tstep, ++k) sgemm_tile(C.wsb(WS_HN), C.wsb(WS_WIN), DM, NIN, t, lds, SE);
        if (grp & 1) { P1_MEM(); P1_BIG(); } else { P1_BIG(); P1_MEM(); }
        if (tiles) for (; t < 768; t += tstep) sgemm_tile(C.wsb(WS_HN), C.wsb(WS_WIN), DM, NIN, t, lds, SE);
    }
    SEAM(1);
    if (IN(2)) {
        unsigned rq[16], rk[16], rl[16], rv[16];
        if (bx < 1024) hg_load(C, bx, rq, rk, rl, rv);
        for (int it = bx; it < 1024; it += G) hg_intra(C, lds, it, it + G, rq, rk, rl, rv);
    }
    SEAM(2);
    if (IN(3)) REPEAT(3) {
        hg_scan(C);
        if ((bx >> 3) & 1) { for (int it = bx; it < 512; it += G) hg_sample_item(C, lds, it); for (int it = bx; it < 512; it += G) gmlp_item(C, lds, it); }
        else { for (int it = bx; it < 512; it += G) gmlp_item(C, lds, it); for (int it = bx; it < 512; it += G) hg_sample_item(C, lds, it); }
        for (int it = bx; it < 128; it += G) gmlp_sample_item(C, lds, it);
    }
    SEAM(3);
    if (IN(4)) REPEAT(4) hg_out(C, lds);
    SEAM(4);
    if (IN(5)) {
#define PBIG() do { pg8::Gemm g{C.wsb(WS_O), C.wsb(WS_WOUT), MP, DM, DM}; pg8::StaticOrder S; S.init(MP, DM, G, bx); EpiRes<false> E{C.in[0], C.wsb(WS_XB), C.wsf(WS_SS)}; pg8::gemm_phase<EpiRes<false>, pg8::StaticOrder>(lds, g, S, E, nullptr); } while (0)
#define PTILE() do { SEpiRes<false> SE{C.in[1] - (size_t)MP * 1024, C.wsb(WS_XB), C.wsf(WS_SS)}; for (int t = bx; t < 256; t += G) sgemm_tile(C.wsb(WS_O), C.wsb(WS_WOUT), DM, DM, t, lds, SE); } while (0)
        if ((bx >> 3) & 1) { PTILE(); PBIG(); } else { PBIG(); PTILE(); }
#undef PBIG
#undef PTILE
    }
    SEAM(5);
    if (IN(6)) {
#define PBIG() do { pg8::Gemm g{C.wsb(WS_XB), C.wsb(WS_WCQ), MP, DM, DM}; pg8::StaticOrder S; S.init(MP, DM, G, bx); EpiScale<0> E{C.wsb(WS_HQ), DM, C.wsf(WS_SS), 0.0625f}; pg8::gemm_phase<EpiScale<0>, pg8::StaticOrder>(lds, g, S, E, nullptr); } while (0)
#define PTILE() do { SEpiScale<0> SE{C.wsb(WS_HQ), DM, C.wsf(WS_SS), 0.0625f}; for (int t = bx; t < 256; t += G) sgemm_tile(C.wsb(WS_XB), C.wsb(WS_WCQ), DM, DM, t, lds, SE); } while (0)
        if ((bx >> 3) & 1) { PTILE(); PBIG(); } else { PBIG(); PTILE(); }
#undef PBIG
#undef PTILE
    }
    SEAM(6);
    if (IN(7)) REPEAT(7) {
        if ((bx >> 3) & 1) { for (int it = bx; it < 256; it += G) attn_sample_item(C, lds, it); for (int it = bx; it < 256; it += G) attn_prompt_item(C, lds, it); }
        else { for (int it = bx; it < 256; it += G) attn_prompt_item(C, lds, it); for (int it = bx; it < 256; it += G) attn_sample_item(C, lds, it); }
    }
    SEAM(7);
    if (IN(8)) {
#define PBIG() do { pg8::Gemm g{C.wsb(WS_CA), C.wsb(WS_WCO), MP, DM, DM}; pg8::StaticOrder S; S.init(MP, DM, G, bx); EpiRes<true> E{nullptr, C.wsb(WS_XB), C.wsf(WS_SS) + MT}; pg8::gemm_phase<EpiRes<true>, pg8::StaticOrder>(lds, g, S, E, nullptr); } while (0)
#define PTILE() do { SEpiRes<true> SE{nullptr, C.wsb(WS_XB), C.wsf(WS_SS) + MT}; for (int t = bx; t < 256; t += G) sgemm_tile(C.wsb(WS_CA), C.wsb(WS_WCO), DM, DM, t, lds, SE); } while (0)
        if ((bx >> 3) & 1) { PTILE(); PBIG(); } else { PBIG(); PTILE(); }
#undef PBIG
#undef PTILE
    }
    SEAM(8);
    if (IN(9)) {
        const int grp = (bx >> 3) & 3; SEpiScale<1> SE{C.wsb(WS_H), DFF, C.wsf(WS_SS) + MT, 1.0f};
        int t = bx, k = 0;
        for (; t < 1024 && k < grp; t += G, ++k) sgemm_tile(C.wsb(WS_XB), C.wsb(WS_WUP), DM, DFF, t, lds, SE);
        { pg8::Gemm g{C.wsb(WS_XB), C.wsb(WS_WUP), MP, DFF, DM}; pg8::StaticOrder S; S.init(MP, DFF, G, bx);
          EpiScale<1> E{C.wsb(WS_H), DFF, C.wsf(WS_SS) + MT, 1.0f}; pg8::gemm_phase<EpiScale<1>, pg8::StaticOrder>(lds, g, S, E, nullptr); }
        for (; t < 1024; t += G) sgemm_tile(C.wsb(WS_XB), C.wsb(WS_WUP), DM, DFF, t, lds, SE);
    }
    SEAM(9);
    if (IN(10)) { pg8::Gemm g{C.wsb(WS_H), C.wsb(WS_WDN), MP, DM, DFF}; pg8::StaticOrder S; S.init(MP, DM, G, bx);
        unsigned* pc = (unsigned*)(P.ws + WS_BAR) + 4096;
        EpiFinal E{C.wsb(WS_XB), C.out + OUT_YP, C.wsf(WS_SS) + 2 * MT, pc, C.in[24]}; pg8::gemm_phase<EpiFinal, pg8::StaticOrder>(lds, g, S, E, nullptr);
        SEpiFinal SE{C.wsb(WS_XB), C.out + OUT_YP, C.wsf(WS_SS) + 2 * MT, pc + 64 * 64, C.in[24]};
        for (int t = bx; t < 256; t += G) sgemm_tile(C.wsb(WS_H), C.wsb(WS_WDN), DFF, DM, t, lds, SE); }
#undef IN
#undef SEAM
}

#ifndef MULTI_LAUNCH
#define MULTI_LAUNCH 0
#endif
extern "C" void kernel_launch(void* const* d_in, const int* in_sizes, int n_in, void* d_out, int out_size, void* d_ws, size_t ws_size, hipStream_t stream) {
    static int grid = 0;
    if (grid == 0) {
        int dev = 0, cus = 0, per_cu = 0;
        (void)hipGetDevice(&dev);
        (void)hipDeviceGetAttribute(&cus, hipDeviceAttributeMultiprocessorCount, dev);
        if (hipFuncSetAttribute((const void*)mega, hipFuncAttributeMaxDynamicSharedMemorySize, LDS_BYTES) != hipSuccess) fprintf(stderr, "hipFuncSetAttribute failed\n");
        if (hipOccupancyMaxActiveBlocksPerMultiprocessor(&per_cu, (const void*)mega, NTHR, LDS_BYTES) != hipSuccess || per_cu < 1) { fprintf(stderr, "occupancy query: %d\n", per_cu); per_cu = 1; }
        (void)hipGetLastError();
        grid = cus * per_cu;
        if (grid <= 0) grid = 256;
    }
    Params p{};
    for (int i = 0; i < 25; ++i) p.in[i] = (const float*)d_in[i];
    p.out = (float*)d_out; p.ws = (unsigned char*)d_ws;
    (void)hipMemsetAsync((unsigned char*)d_ws + WS_BAR, 0, BAR_BYTES, stream);
#if MULTI_LAUNCH
    for (int ph = 0; ph < NPH; ++ph) { p.ph_lo = ph; p.ph_hi = ph + 1; hipLaunchKernelGGL(mega, dim3(grid), dim3(NTHR), LDS_BYTES, stream, p); }
#else
    p.ph_lo = 0; p.ph_hi = NPH;
    void* args[] = {&p};
    hipError_t e = hipLaunchCooperativeKernel((const void*)mega, dim3(grid), dim3(NTHR), args, LDS_BYTES, stream);
    if (e != hipSuccess) fprintf(stderr, "cooperative launch failed: %s (grid %d)\n", hipGetErrorString(e), grid);
#endif
}
```

```cpp
#include <hip/hip_runtime.h>
#include <hip/hip_cooperative_groups.h>
#include <cstdio>
namespace cg = cooperative_groups;
namespace pg8 {
#define PG8_LAS __attribute__((address_space(3)))
typedef unsigned short bf16_t;
typedef short bf16x8 __attribute__((ext_vector_type(8)));
typedef float f32x4 __attribute__((ext_vector_type(4)));
typedef unsigned u32x4 __attribute__((ext_vector_type(4)));
constexpr int BM = 256, BK = 64, HALF = 128, HTB = HALF * BK * 2  , STAGE_BYTES = 8 * HTB, NXCD = 8, WGM = 8;

__host__ __device__ __forceinline__ int lds_byte(int r, int c) { const int st = (r >> 4) * 2 + (c >> 5), rr = r & 15, cc = c & 31, ob = rr * 64 + cc * 2; return st * 1024 + (ob ^ (((ob >> 9) & 1) << 5)); }
__host__ __device__ __forceinline__ void stage_rc(int b, int& R, int& C) { const int st = b / 1024, sb = b % 1024, swz = sb ^ (((sb >> 9) & 1) << 5); R = (st >> 1) * 16 + swz / 64; C = (st & 1) * 32 + (swz % 64) / 2; }
__host__ __device__ __forceinline__ int perm32(int rho) { const int n = rho >> 4, i = rho & 15; return 8 * (i >> 2) + 4 * n + (i & 3); }

struct Unit { int pm, pn; };
struct Gemm { const bf16_t* A; const bf16_t* Bt; int M, N, K; };

struct StaticOrder {
    int nM, nN, nwg, G, c;
    __host__ __device__ void init(int M, int N, int G_, int c_) { nM = M / BM; nN = N / BM; nwg = nM * nN; G = G_; c = c_; }
    __host__ __device__ bool next(int i, Unit& u) const {
        const long L = (long)i * G + c; if (L >= nwg) return false;
        int wgid = (int)L; { const int q = nwg / NXCD, r = nwg % NXCD, xcd = wgid % NXCD, off = wgid / NXCD; wgid = (xcd < r ? xcd * (q + 1) : r * (q + 1) + (xcd - r) * q) + off; }
        const int nig = WGM * nN, gid = wgid / nig, fm = gid * WGM, gsz = (nM - fm) < WGM ? (nM - fm) : WGM;
        u.pm = fm + ((wgid % nig) % gsz); u.pn = (wgid % nig) / gsz; return true;
    }
    __device__ __forceinline__ void a_ready(const Unit&) const {}
    __device__ __forceinline__ void done(const Unit&) const {}
};
template <class Epi, class Sched, bool STAMP = false>
__device__ __forceinline__ void gemm_phase(PG8_LAS unsigned char* lds, const Gemm g, const Sched& S, const Epi& E, unsigned long long* stamps) {
    const int tid = threadIdx.x, wid = __builtin_amdgcn_readfirstlane(tid >> 6), lane = tid & 63, wr = wid >> 2, wc = wid & 3, fr = lane & 15, fq = lane >> 4;
    const int K = g.K, nt = K / BK;
    int ts_lo = 0, ts_hi = 0, nts = 0; const unsigned long long rt_entry = STAMP ? (unsigned long long)wall_clock64() : 0ull;
#define PG8_STAMP() do { if (STAMP && wid == 0 && nts < 64) { const unsigned long long _c = (unsigned long long)clock64(); \
        ts_lo = (lane == nts) ? (int)(unsigned)_c : ts_lo; ts_hi = (lane == nts) ? (int)(unsigned)(_c >> 32) : ts_hi; ++nts; } } while (0)
    PG8_STAMP();
    unsigned voffA[2], voffB[2];
#pragma unroll
    for (int i = 0; i < 2; ++i) { int R, C; stage_rc(tid * 16 + i * 8192, R, C); const int Rb = Epi::PERM ? ((R & ~31) + perm32(R & 31)) : R;
        voffA[i] = (unsigned)(R * K + C) * 2u; voffB[i] = (unsigned)(Rb * K + C) * 2u; }
    const size_t kstep = (size_t)(BK * 2);
    const size_t hstep = (size_t)HALF * K * 2;
    const size_t tstep = 2 * hstep;
    const unsigned ldsw = (unsigned)wid * 1024u;
    const int aoff = lds_byte(wr * 64 + fr, fq * 8), boff = lds_byte(wc * 32 + fr, fq * 8);
#define PG8_SA(b, h) (((b) * 2 + (h)) * HTB)
#define PG8_SB(b, h) ((4 + (b) * 2 + (h)) * HTB)
#define PG8_STAGE(bufoff, gbase, voff) do { _Pragma("unroll") for (int _i = 0; _i < 2; ++_i) \
        __builtin_amdgcn_global_load_lds((const unsigned*)((const char*)(gbase) + (voff)[_i]), (PG8_LAS unsigned*)(lds + (bufoff) + ldsw + _i * 8192), 16, 0, 0); } while (0)
#define PG8_LDA(dst, b, h) do { _Pragma("unroll") for (int m = 0; m < 4; ++m) _Pragma("unroll") for (int k = 0; k < 2; ++k) dst[m][k] = *(const PG8_LAS bf16x8*)(lds + PG8_SA(b, h) + aoff + m * 2048 + k * 1024); } while (0)
#define PG8_LDB(dst, b, h) do { _Pragma("unroll") for (int n = 0; n < 2; ++n) _Pragma("unroll") for (int k = 0; k < 2; ++k) dst[n][k] = *(const PG8_LAS bf16x8*)(lds + PG8_SB(b, h) + boff + n * 2048 + k * 1024); } while (0)
#define PG8_MMA(ai, bj, At, Bt) do { __builtin_amdgcn_s_setprio(1); _Pragma("unroll") for (int m = 0; m < 4; ++m) _Pragma("unroll") for (int n = 0; n < 2; ++n) _Pragma("unroll") for (int k = 0; k < 2; ++k) \
        acc[ai][bj][m][n] = __builtin_amdgcn_mfma_f32_16x16x32_bf16(Bt[n][k], At[m][k], acc[ai][bj][m][n], 0, 0, 0); __builtin_amdgcn_s_setprio(0); } while (0)
#define PG8_WAIT_V(n) asm volatile("s_waitcnt vmcnt(" #n ")" ::: "memory")
#define PG8_WAIT_L(n) asm volatile("s_waitcnt lgkmcnt(" #n ")" ::: "memory")
#define PG8_BAR __builtin_amdgcn_s_barrier()
#define PG8_SCHED __builtin_amdgcn_sched_barrier(0)
    Unit cur, nxt; int ui = 0;
    if (!S.next(0, cur)) return;
    f32x4 acc[2][2][4][2];
#pragma unroll
    for (int a = 0; a < 2; ++a)
#pragma unroll
        for (int b = 0; b < 2; ++b)
#pragma unroll
            for (int m = 0; m < 4; ++m)
#pragma unroll
                for (int n = 0; n < 2; ++n) acc[a][b][m][n] = (f32x4){0.f, 0.f, 0.f, 0.f};
    bf16x8 At[4][2], B0[2][2], B1[2][2];
    const char* cA = (const char*)g.A + (size_t)cur.pm * tstep; const char* cB = (const char*)g.Bt + (size_t)cur.pn * tstep;
    S.a_ready(cur);
    PG8_STAGE(PG8_SB(0, 0), cB, voffB); PG8_STAGE(PG8_SA(0, 0), cA, voffA); PG8_STAGE(PG8_SB(0, 1), cB + hstep, voffB); PG8_STAGE(PG8_SA(0, 1), cA + hstep, voffA);
    if (wr == 1) PG8_BAR;
    PG8_WAIT_V(4); PG8_BAR;
    PG8_STAGE(PG8_SB(1, 0), cB + kstep, voffB); PG8_STAGE(PG8_SA(1, 0), cA + kstep, voffA); PG8_STAGE(PG8_SB(1, 1), cB + hstep + kstep, voffB);
    PG8_WAIT_V(6); PG8_BAR;
    PG8_STAMP();
    for (;;) {
        const bool has_next = S.next(ui + 1, nxt);
        const char* nA = has_next ? (const char*)g.A + (size_t)nxt.pm * tstep : cA; const char* nB = has_next ? (const char*)g.Bt + (size_t)nxt.pn * tstep : cB;
        for (int t = 0; t < nt; t += 2) {
            const bool last = (t == nt - 2);
            const char* a1 = cA + (size_t)(t + 1) * kstep;
            const char* a2 = last ? nA : cA + (size_t)(t + 2) * kstep; const char* b2 = last ? nB : cB + (size_t)(t + 2) * kstep;
            const char* a3 = a2 + kstep; const char* b3 = b2 + kstep;
            if (last && has_next) S.a_ready(nxt);
            PG8_LDB(B0, 0, 0); PG8_SCHED; PG8_LDA(At, 0, 0); PG8_STAGE(PG8_SA(1, 1), a1 + hstep, voffA);
            PG8_WAIT_L(8); PG8_BAR; PG8_WAIT_L(0); PG8_MMA(0, 0, At, B0); PG8_BAR; PG8_SCHED;
            PG8_LDB(B1, 0, 1); PG8_STAGE(PG8_SB(0, 0), b2, voffB);
            PG8_BAR; PG8_WAIT_L(0); PG8_MMA(0, 1, At, B1); PG8_BAR;
            PG8_LDA(At, 0, 1); PG8_STAGE(PG8_SA(0, 0), a2, voffA);
            PG8_BAR; PG8_WAIT_L(0); PG8_MMA(1, 0, At, B0); PG8_BAR; PG8_SCHED;
            PG8_STAGE(PG8_SB(0, 1), b2 + hstep, voffB);
            PG8_WAIT_V(6); PG8_BAR; PG8_MMA(1, 1, At, B1); PG8_BAR;
            PG8_LDB(B0, 1, 0); PG8_SCHED; PG8_LDA(At, 1, 0); PG8_STAGE(PG8_SA(0, 1), a2 + hstep, voffA);
            PG8_WAIT_L(8); PG8_BAR; PG8_WAIT_L(0); PG8_MMA(0, 0, At, B0); PG8_BAR; PG8_SCHED;
            PG8_LDB(B1, 1, 1); PG8_STAGE(PG8_SB(1, 0), b3, voffB);
            PG8_BAR; PG8_WAIT_L(0); PG8_MMA(0, 1, At, B1); PG8_BAR;
            PG8_LDA(At, 1, 1); PG8_STAGE(PG8_SA(1, 0), a3, voffA);
            PG8_BAR; PG8_WAIT_L(0); PG8_MMA(1, 0, At, B0); PG8_BAR; PG8_SCHED;
            PG8_STAGE(PG8_SB(1, 1), b3 + hstep, voffB);
            PG8_WAIT_V(6); PG8_BAR; PG8_MMA(1, 1, At, B1); PG8_BAR;
        }
        PG8_STAMP();
        if constexpr (!Epi::AFTER_DRAIN) { E(acc, cur, wr, wc, fr, fq); S.done(cur); }
        PG8_STAMP();
        if (!has_next) break;
#pragma unroll
        for (int a = 0; a < 2; ++a)
#pragma unroll
            for (int b = 0; b < 2; ++b)
#pragma unroll
                for (int m = 0; m < 4; ++m)
#pragma unroll
                    for (int n = 0; n < 2; ++n) acc[a][b][m][n] = (f32x4){0.f, 0.f, 0.f, 0.f};
        cur = nxt; cA = nA; cB = nB; ++ui;
    }
    PG8_WAIT_V(0);
    if (wr == 0) PG8_BAR;
    PG8_BAR;
    if constexpr (Epi::AFTER_DRAIN) { E.fused(acc, cur, wr, wc, fr, fq, lds, wid, lane); S.done(cur); }
    PG8_STAMP();
    if (STAMP && wid == 0) { stamps[lane] = lane < nts ? (((unsigned long long)(unsigned)ts_hi << 32) | (unsigned)ts_lo) : 0ull;
        if (lane == 62) stamps[62] = rt_entry; if (lane == 63) stamps[63] = (unsigned long long)wall_clock64(); }
#undef PG8_STAMP
#undef PG8_SA
#undef PG8_SB
#undef PG8_STAGE
#undef PG8_LDA
#undef PG8_LDB
#undef PG8_MMA
#undef PG8_WAIT_V
#undef PG8_WAIT_L
#undef PG8_BAR
#undef PG8_SCHED
}
}

#define LAS __attribute__((address_space(3)))
using pg8::bf16_t; using pg8::bf16x8; using pg8::f32x4; using pg8::u32x4;
typedef unsigned u32x2 __attribute__((ext_vector_type(2)));
constexpr int DM = 1024, MP = 16384, MS = 512, MT = MP + MS, NMR = 2048, DFF = 4096, NIN = 3072;
constexpr float EPS = 1e-6f;
constexpr int NTHR = 512;
constexpr int LDS_BYTES = 144 * 1024;
constexpr size_t MB = 1024 * 1024;
constexpr size_t WS_WIN = 0, WS_WOUT = 6 * MB, WS_WCQ = 8 * MB, WS_WCKV = 10 * MB, WS_WCO = 14 * MB, WS_WUP = 16 * MB, WS_WDN = 24 * MB;
constexpr size_t WS_HN = 32 * MB;
constexpr size_t SZ_ROWB = (size_t)MT * DM * 2;
constexpr size_t WS_Z = WS_HN + SZ_ROWB;
constexpr size_t ZSZ = (size_t)MT * 512;
constexpr size_t WS_H = WS_HN;
constexpr size_t WS_C = WS_Z + 8 * ZSZ * 2;
constexpr size_t WS_MEMN = WS_C, WS_KB = WS_C + 4 * MB, WS_VT = WS_C + 8 * MB;
constexpr size_t WS_D = WS_C + 12 * MB;
constexpr size_t WS_DS = WS_D, WS_SC = WS_D + 32 * MB, WS_OI = WS_D + 64 * MB, WS_DEC = WS_D + 80 * MB;
constexpr size_t WS_HQ = WS_D, WS_CA = WS_D + 36 * MB;
constexpr size_t WS_E = WS_D + 81 * MB;
constexpr size_t WS_O = WS_E, WS_X1 = WS_O + SZ_ROWB, WS_XB = WS_X1 + 2 * SZ_ROWB, WS_SS = WS_XB + SZ_ROWB, WS_LN = WS_SS + 3 * MT * 4, WS_END = WS_LN + 2 * MT * 4;
static_assert(SZ_ROWB * 4 >= (size_t)MT * DFF * 2 && WS_END < 512 * MB, "workspace map");
constexpr size_t OUT_YP = 0, OUT_YS = 16777216, OUT_SP = 17301504, OUT_SSMP = 17825792, OUT_MK = 26214400, OUT_MV = 28311552, OUT_CMV = 30408704;

struct Params { const float* in[25]; float* out; unsigned char* ws; int ph_lo, ph_hi;
    __device__ __forceinline__ bf16_t* wsb(size_t off) const { return (bf16_t*)(ws + off); }
    __device__ __forceinline__ float* wsf(size_t off) const { return (float*)(ws + off); }
    __device__ __forceinline__ bf16_t* Z(int a) const { return (bf16_t*)(ws + WS_Z) + (size_t)a * ZSZ; }
};
typedef Params Ctx;


__device__ __forceinline__ float bf2f(bf16_t b) { return __uint_as_float(((unsigned)b) << 16); }
typedef float f32x2c __attribute__((ext_vector_type(2)));
typedef __bf16 bf16x2c __attribute__((ext_vector_type(2)));
__device__ __forceinline__ unsigned pk2(float lo, float hi) { const f32x2c v = {lo, hi}; const bf16x2c b = __builtin_convertvector(v, bf16x2c); return __builtin_bit_cast(unsigned, b); }
__device__ __forceinline__ bf16_t f2bf(float f) { return (bf16_t)(pk2(f, f) & 0xffffu); }
__device__ __forceinline__ float sigm(float x) { return __builtin_amdgcn_rcpf(1.0f + __expf(-x)); }
__device__ __forceinline__ float bflo(unsigned w) { return __uint_as_float(w << 16); }
__device__ __forceinline__ float bfhi(unsigned w) { return __uint_as_float(w & 0xffff0000u); }

struct Epi1 {
    static constexpr bool PERM = true, AFTER_DRAIN = false;
    bf16_t* Zb; const float* lbp; float* ln;
    __device__ __forceinline__ void operator()(const f32x4 (&acc)[2][2][4][2], const pg8::Unit& u, int wr, int wc, int fr, int fq) const {
        const int sec = u.pn >> 1;
        const int row0 = u.pm * 256 + wr * 64 + fr;
        const int cs0 = (u.pn & 1) * 256 + wc * 32 + 8 * fq;
        if (sec == 1) {
            bf16_t* Zk = Zb + ZSZ; bf16_t* Zl = Zb + 2 * ZSZ;
            f32x4 pp[2][4];
#pragma unroll
            for (int bj = 0; bj < 2; ++bj) { const int cs = cs0 + bj * 128; pp[bj][0] = *(const f32x4*)(lbp + cs); pp[bj][1] = *(const f32x4*)(lbp + cs + 4); pp[bj][2] = *(const f32x4*)(lbp + 512 + cs); pp[bj][3] = *(const f32x4*)(lbp + 512 + cs + 4); }
#pragma unroll
            for (int bj = 0; bj < 2; ++bj) {
                const int cs = cs0 + bj * 128;
                const f32x4 p0a = pp[bj][0], p0b = pp[bj][1], p1a = pp[bj][2], p1b = pp[bj][3];
                float lb[8];
#pragma unroll
                for (int j = 0; j < 4; ++j) { lb[j] = sigm(p0a[j] - p1a[j]); lb[4 + j] = sigm(p0b[j] - p1b[j]); }
#pragma unroll
                for (int ai = 0; ai < 2; ++ai)
#pragma unroll
                    for (int m = 0; m < 4; ++m) {
                        const size_t o = (size_t)(row0 + ai * 128 + m * 16) * 512 + cs;
                        float kk[8], lf[8];
#pragma unroll
                        for (int j = 0; j < 8; ++j) { const float z = (j < 4) ? acc[ai][bj][m][0][j] : acc[ai][bj][m][1][j - 4];
                            const float sg = sigm(z), oml = 1.0f - lb[j]; kk[j] = oml * (1.0f - sg); lf[j] = __logf(lb[j] + oml * sg); }
                        u32x4 w; w.x = pk2(kk[0], kk[1]); w.y = pk2(kk[2], kk[3]); w.z = pk2(kk[4], kk[5]); w.w = pk2(kk[6], kk[7]);
                        *(u32x4*)(Zk + o) = w;
                        w.x = pk2(lf[0], lf[1]); w.y = pk2(lf[2], lf[3]); w.z = pk2(lf[4], lf[5]); w.w = pk2(lf[6], lf[7]);
                        *(u32x4*)(Zl + o) = w;
                    }
            }
        } else {
            bf16_t* Zo = Zb + (size_t)(sec == 0 ? 0 : sec + 1) * ZSZ;
            float l1[2][4], l2[2][4];
#pragma unroll
            for (int ai = 0; ai < 2; ++ai)
#pragma unroll
                for (int m = 0; m < 4; ++m) { l1[ai][m] = 0.f; l2[ai][m] = 0.f; }
#pragma unroll
            for (int bj = 0; bj < 2; ++bj) {
                const int cs = cs0 + bj * 128;
#pragma unroll
                for (int ai = 0; ai < 2; ++ai)
#pragma unroll
                    for (int m = 0; m < 4; ++m) {
                        const size_t o = (size_t)(row0 + ai * 128 + m * 16) * 512 + cs;
                        float r[8];
#pragma unroll
                        for (int j = 0; j < 8; ++j) { const float z = (j < 4) ? acc[ai][bj][m][0][j] : acc[ai][bj][m][1][j - 4];
                            const float t = (sec >= 4) ? 1.5957691216f * (z + 0.044715f * z * z * z) : z;
                            const float sg = sigm(t);
                            r[j] = (sec == 2) ? z : ((sec == 3) ? sg : z * sg); }
                        u32x4 w; w.x = pk2(r[0], r[1]); w.y = pk2(r[2], r[3]); w.z = pk2(r[4], r[5]); w.w = pk2(r[6], r[7]);
                        *(u32x4*)(Zo + o) = w;
                        if (sec == 5) {
#pragma unroll
                            for (int j = 0; j < 8; ++j) { l1[ai][m] += r[j]; l2[ai][m] += r[j] * r[j]; } }
                    }
            }
            if (sec == 5) {
#pragma unroll
                for (int ai = 0; ai < 2; ++ai)
#pragma unroll
                    for (int m = 0; m < 4; ++m) { float a = l1[ai][m], b = l2[ai][m];
                        a += __shfl_xor(a, 16); b += __shfl_xor(b, 16); a += __shfl_xor(a, 32); b += __shfl_xor(b, 32);
                        if (fq == 0) { const int row = row0 + ai * 128 + m * 16; atomicAdd(ln + row, a); atomicAdd(ln + MT + row, b); } }
            }
        }
    }
};

struct EpiMem {
    static constexpr bool PERM = false, AFTER_DRAIN = false;
    float* outK; float* outV; bf16_t* KB; bf16_t* VT;
    __device__ __forceinline__ void operator()(const f32x4 (&acc)[2][2][4][2], const pg8::Unit& u, int wr, int wc, int fr, int fq) const {
        const int row0 = u.pm * 256 + wr * 64 + fr;
        const bool isV = u.pn >= 4;
        const int col0 = (u.pn & 3) * 256 + wc * 32 + 4 * fq;
        float* outp = isV ? outV : outK;
#pragma unroll
        for (int ai = 0; ai < 2; ++ai)
#pragma unroll
            for (int m = 0; m < 4; ++m) {
                const int row = row0 + ai * 128 + m * 16;
#pragma unroll
                for (int bj = 0; bj < 2; ++bj)
#pragma unroll
                    for (int n = 0; n < 2; ++n) {
                        const int c = col0 + bj * 128 + n * 16; const f32x4 v = acc[ai][bj][m][n];
                        *(f32x4*)(outp + (size_t)row * 1024 + c) = v;
                        if (!isV) { u32x2 w; w.x = pk2(v[0], v[1]); w.y = pk2(v[2], v[3]); *(u32x2*)(KB + (size_t)row * 1024 + c) = w; }
                        else { const int b = row >> 8, mm = row & 255;
#pragma unroll
                            for (int j = 0; j < 4; ++j) VT[((size_t)b * 1024 + c + j) * 256 + mm] = f2bf(v[j]); }
                    }
            }
    }
};

template <bool RB> struct EpiRes {
    static constexpr bool PERM = false, AFTER_DRAIN = false;
    const float* resf; bf16_t* xb; float* ss;
    __device__ __forceinline__ void operator()(const f32x4 (&acc)[2][2][4][2], const pg8::Unit& u, int wr, int wc, int fr, int fq) const {
        const int row0 = u.pm * 256 + wr * 64 + fr, col0 = u.pn * 256 + wc * 32 + 4 * fq;
#pragma unroll
        for (int ai = 0; ai < 2; ++ai) {
            f32x4 rv[4][2][2];
#pragma unroll
            for (int m = 0; m < 4; ++m)
#pragma unroll
                for (int bj = 0; bj < 2; ++bj)
#pragma unroll
                    for (int n = 0; n < 2; ++n) { const size_t oo = (size_t)(row0 + ai * 128 + m * 16) * 1024 + col0 + bj * 128 + n * 16;
                        if (RB) { const u32x2 rr = *(const u32x2*)(xb + oo); rv[m][bj][n] = (f32x4){bflo(rr.x), bfhi(rr.x), bflo(rr.y), bfhi(rr.y)}; }
                        else rv[m][bj][n] = *(const f32x4*)(resf + oo); }
#pragma unroll
            for (int m = 0; m < 4; ++m) {
                const int row = row0 + ai * 128 + m * 16; const size_t o = (size_t)row * 1024 + col0; float s = 0.f;
#pragma unroll
                for (int bj = 0; bj < 2; ++bj)
#pragma unroll
                    for (int n = 0; n < 2; ++n) {
                        const size_t oo = o + bj * 128 + n * 16; const f32x4 v = rv[m][bj][n] + acc[ai][bj][m][n];
                        u32x2 w; w.x = pk2(v[0], v[1]); w.y = pk2(v[2], v[3]); *(u32x2*)(xb + oo) = w;
                        s += (v[0] * v[0] + v[1] * v[1]) + (v[2] * v[2] + v[3] * v[3]);
                    }
                s += __shfl_xor(s, 16); s += __shfl_xor(s, 32);
                if (fq == 0) atomicAdd(ss + row, s);
            }
        }
    }
};

template <int ACT> struct EpiScale {
    static constexpr bool PERM = true, AFTER_DRAIN = false;
    bf16_t* O; int ldc; const float* ss; float scale;
    __device__ __forceinline__ void operator()(const f32x4 (&acc)[2][2][4][2], const pg8::Unit& u, int wr, int wc, int fr, int fq) const {
        const int row0 = u.pm * 256 + wr * 64 + fr, col0 = u.pn * 256 + wc * 32 + 8 * fq;
        float ssv[2][4];
#pragma unroll
        for (int ai = 0; ai < 2; ++ai)
#pragma unroll
            for (int m = 0; m < 4; ++m) ssv[ai][m] = ss[row0 + ai * 128 + m * 16];
#pragma unroll
        for (int ai = 0; ai < 2; ++ai)
#pragma unroll
            for (int m = 0; m < 4; ++m) {
                const int row = row0 + ai * 128 + m * 16;
                const float rs = rsqrtf(ssv[ai][m] * (1.0f / 1024.0f) + EPS) * scale;
                bf16_t* rowp = O + (size_t)row * ldc + col0;
#pragma unroll
                for (int bj = 0; bj < 2; ++bj) {
                    f32x4 v0 = acc[ai][bj][m][0] * rs, v1 = acc[ai][bj][m][1] * rs;
                    if (ACT == 1) {
#pragma unroll
                        for (int j = 0; j < 4; ++j) { const float a = fmaxf(v0[j], 0.f), b = fmaxf(v1[j], 0.f); v0[j] = a * a; v1[j] = b * b; } }
                    u32x4 w; w.x = pk2(v0[0], v0[1]); w.y = pk2(v0[2], v0[3]); w.z = pk2(v1[0], v1[1]); w.w = pk2(v1[2], v1[3]);
                    *(u32x4*)(rowp + bj * 128) = w;
                }
            }
    }
};

struct WDesc { const float* W; const float* gain; bf16_t* Wt; int K, N, t; };
__device__ __forceinline__ WDesc wdesc(const Ctx& C, int t) {
    WDesc d;
    if (t < 768) d = WDesc{C.in[8], nullptr, C.wsb(WS_WIN), 1024, 3072, t};
    else if (t < 1024) d = WDesc{C.in[14], nullptr, C.wsb(WS_WOUT), 1024, 1024, t - 768};
    else if (t < 1280) d = WDesc{C.in[17], C.in[15], C.wsb(WS_WCQ), 1024, 1024, t - 1024};
    else if (t < 1536) d = WDesc{C.in[18], nullptr, C.wsb(WS_WCKV), 1024, 1024, t - 1280};
    else if (t < 1792) d = WDesc{C.in[19], nullptr, C.wsb(WS_WCKV) + 1024 * 1024, 1024, 1024, t - 1536};
    else if (t < 2048) d = WDesc{C.in[20], nullptr, C.wsb(WS_WCO), 1024, 1024, t - 1792};
    else if (t < 3072) d = WDesc{C.in[22], C.in[21], C.wsb(WS_WUP), 1024, 4096, t - 2048};
    else d = WDesc{C.in[23], nullptr, C.wsb(WS_WDN), 4096, 1024, t - 3072};
    return d;
}
__device__ __forceinline__ void cvt_load(const WDesc& d, f32x4 (&v)[2], float (&gq)[2]) {
    const int tid = threadIdx.x; const int ntn = d.N >> 6; const int kt = d.t / ntn, nt = d.t - kt * ntn; const int k0 = kt * 64, n0 = nt * 64;
#pragma unroll
    for (int p = 0; p < 2; ++p) { const int k = p * 32 + (tid >> 4), n4 = (tid & 15) * 4;
        v[p] = *(const f32x4*)(d.W + (size_t)(k0 + k) * d.N + n0 + n4); gq[p] = d.gain ? d.gain[k0 + k] : 1.0f; }
}
__device__ __forceinline__ void cvt_store(const WDesc& d, const f32x4 (&v)[2], const float (&gq)[2], LAS float* tl) {
    const int tid = threadIdx.x; const int ntn = d.N >> 6; const int kt = d.t / ntn, nt = d.t - kt * ntn; const int k0 = kt * 64, n0 = nt * 64;
#pragma unroll
    for (int p = 0; p < 2; ++p) { const int k = p * 32 + (tid >> 4), n4 = (tid & 15) * 4; const f32x4 x = v[p] * gq[p];
        tl[k * 65 + n4 + 0] = x[0]; tl[k * 65 + n4 + 1] = x[1]; tl[k * 65 + n4 + 2] = x[2]; tl[k * 65 + n4 + 3] = x[3]; }
    __syncthreads();
    {
        const int n = tid >> 3, k8 = (tid & 7) * 8; float r[8];
#pragma unroll
        for (int j = 0; j < 8; ++j) r[j] = tl[(k8 + j) * 65 + n];
        u32x4 w; w.x = pk2(r[0], r[1]); w.y = pk2(r[2], r[3]); w.z = pk2(r[4], r[5]); w.w = pk2(r[6], r[7]);
        *(u32x4*)(d.Wt + (size_t)(n0 + n) * d.K + k0 + k8) = w;
    }
    __syncthreads();
}

__device__ __forceinline__ void phase_prep(const Ctx& C, LAS unsigned char* lds) {
    const int tid = threadIdx.x, lane = tid & 63, wid = tid >> 6;
    LAS float* tl = (LAS float*)lds;
    {
        int t = blockIdx.x; WDesc d = wdesc(C, t < 4096 ? t : 0); f32x4 v[2]; float gq[2];
        if (t < 4096) cvt_load(d, v, gq);
        for (; t < 4096; t += gridDim.x) {
            const int tn = t + gridDim.x; WDesc dn = wdesc(C, tn < 4096 ? tn : 0); f32x4 vn[2]; float gn[2];
            if (tn < 4096) cvt_load(dn, vn, gn); else { vn[0] = v[0]; vn[1] = v[1]; gn[0] = gq[0]; gn[1] = gq[1]; }
            cvt_store(d, v, gq, tl);
            d = dn; v[0] = vn[0]; v[1] = vn[1]; gq[0] = gn[0]; gq[1] = gn[1];
        }
    }
    {
        const int NR = MT + NMR, stride = gridDim.x * 8; int r = blockIdx.x * 8 + wid;
        f32x4 v[4];
#define ROWSRC(rr) ((rr) < MP ? C.in[0] + (size_t)(rr) * 1024 : ((rr) < MT ? C.in[1] + (size_t)((rr) - MP) * 1024 : C.in[2] + (size_t)((rr) - MT) * 1024))
        if (r < NR) { const float* src = ROWSRC(r);
#pragma unroll
            for (int i = 0; i < 4; ++i) v[i] = *(const f32x4*)(src + i * 256 + lane * 4); }
        for (; r < NR; r += stride) {
            const int rn = r + stride; f32x4 vn[4];
            if (rn < NR) { const float* src = ROWSRC(rn);
#pragma unroll
                for (int i = 0; i < 4; ++i) vn[i] = *(const f32x4*)(src + i * 256 + lane * 4); }
            else {
#pragma unroll
                for (int i = 0; i < 4; ++i) vn[i] = v[i]; }
            const float* g = (r < MT) ? C.in[7] : C.in[16]; bf16_t* dst = (r < MT) ? C.wsb(WS_HN) + (size_t)r * 1024 : C.wsb(WS_MEMN) + (size_t)(r - MT) * 1024;
            f32x4 gg[4];
#pragma unroll
            for (int i = 0; i < 4; ++i) gg[i] = *(const f32x4*)(g + i * 256 + lane * 4);
            float s = 0.f;
#pragma unroll
            for (int i = 0; i < 4; ++i) s += (v[i][0] * v[i][0] + v[i][1] * v[i][1]) + (v[i][2] * v[i][2] + v[i][3] * v[i][3]);
#pragma unroll
            for (int o = 32; o >= 1; o >>= 1) s += __shfl_xor(s, o);
            const float rs = rsqrtf(s * (1.0f / 1024.0f) + EPS);
#pragma unroll
            for (int i = 0; i < 4; ++i) { const f32x4 y = v[i] * rs * gg[i]; u32x2 w; w.x = pk2(y[0], y[1]); w.y = pk2(y[2], y[3]); *(u32x2*)(dst + i * 256 + lane * 4) = w; }
#pragma unroll
            for (int i = 0; i < 4; ++i) v[i] = vn[i];
        }
#undef ROWSRC
    }
    float* ss = C.wsf(WS_SS);
    for (int i = blockIdx.x * NTHR + tid; i < 5 * MT; i += gridDim.x * NTHR) ss[i] = 0.f;
}

__device__ __forceinline__ bf16x8 ld8(const LAS bf16_t* p) { return *(const LAS bf16x8*)p; }
__device__ __forceinline__ bf16x8 gld8(const bf16_t* p) { return *(const bf16x8*)p; }
#define MFMA16(a, b, c) __builtin_amdgcn_mfma_f32_16x16x32_bf16((a), (b), (c), 0, 0, 0)

__device__ __forceinline__ void hg_load(const Ctx& C, int item, unsigned (&rq)[16], unsigned (&rk)[16], unsigned (&rl)[16], unsigned (&rv)[16]) {
    const int tid = threadIdx.x; const int b = item >> 7, c = (item >> 2) & 31, h = item & 3; const int k = tid & 127, i = tid >> 7;
    const size_t o = ((size_t)b * 2048 + c * 64 + 16 * i) * 512 + h * 128 + k;
    const bf16_t* pq = C.Z(0) + o; const bf16_t* pk = C.Z(1) + o; const bf16_t* pl = C.Z(2) + o; const bf16_t* pv = C.Z(3) + o;
#pragma unroll
    for (int t = 0; t < 16; ++t) { rq[t] = pq[t * 512]; rk[t] = pk[t * 512]; rl[t] = pl[t * 512]; rv[t] = pv[t * 512]; }
}
__device__ __forceinline__ void hg_intra(const Ctx& C, LAS unsigned char* lds, int item, int next_item, unsigned (&rq)[16], unsigned (&rk)[16], unsigned (&rl)[16], unsigned (&rv)[16]) {
    const int tid = threadIdx.x, lane = tid & 63, wid = tid >> 6, r = lane & 15, qd = lane >> 4;
    const int b = item >> 7, c = (item >> 2) & 31, h = item & 3;
    const size_t row0 = (size_t)b * 2048 + c * 64; const int hc = h * 128;
    LAS bf16_t* sQV = (LAS bf16_t*)lds;
    LAS bf16_t* sKE = sQV + 7 * 2176;
    LAS bf16_t* sKD = sKE + 3 * 2176;
    LAS bf16_t* sKT = sKD + 4 * 2176;
    LAS bf16_t* sVT = sKT + 128 * 72;
    LAS bf16_t* sA = sVT + 128 * 72;
    LAS float* sTot = (LAS float*)(sA + 64 * 72);
    const int k = tid & 127, i = tid >> 7;
    float q[16], kk[16], bl[16];
    {
        float lf[16]; unsigned vv[16];
#pragma unroll
        for (int t = 0; t < 16; ++t) { q[t] = __uint_as_float(rq[t] << 16); kk[t] = __uint_as_float(rk[t] << 16); lf[t] = __uint_as_float(rl[t] << 16); vv[t] = rv[t]; }
        if (next_item < 1024) hg_load(C, next_item, rq, rk, rl, rv);
        float cum = 0.f;
#pragma unroll
        for (int t = 0; t < 16; ++t) { cum += lf[t]; bl[t] = cum; }
        sTot[i * 128 + k] = cum;
        u32x4 w0, w1;
        w0.x = vv[0] | (vv[1] << 16); w0.y = vv[2] | (vv[3] << 16); w0.z = vv[4] | (vv[5] << 16); w0.w = vv[6] | (vv[7] << 16);
        w1.x = vv[8] | (vv[9] << 16); w1.y = vv[10] | (vv[11] << 16); w1.z = vv[12] | (vv[13] << 16); w1.w = vv[14] | (vv[15] << 16);
        *(LAS u32x4*)(sVT + k * 72 + 16 * i) = w0; *(LAS u32x4*)(sVT + k * 72 + 16 * i + 8) = w1;
    }
    __syncthreads();
    {
        const float t0 = sTot[k], t1 = sTot[128 + k], t2 = sTot[256 + k], t3 = sTot[384 + k];
        const float bend0 = t0, bend1 = t0 + t1, bend2 = bend1 + t2, blast = bend2 + t3;
        const float bstart = (i == 0) ? 0.f : ((i == 1) ? bend0 : ((i == 2) ? bend1 : bend2));
        const float cum = bl[15];
        const float cE = __expf(bstart), c0 = __expf(bstart - bend0), c1 = __expf(bstart - bend1), cdec = __expf(blast - (bstart + cum));
        const int idD = (i == 0) ? 0 : (1 + ((i - 1) * i) / 2 + (i - 1));
        const int id0 = 1 + ((i - 1) * i) / 2;
        bf16_t* pqe = C.Z(7) + (row0 + 16 * i) * 512 + hc + k;
        unsigned kd16[16];
#pragma unroll
        for (int t = 0; t < 16; ++t) {
            const float e = __expf(bl[t]), ei = __expf(-bl[t]), ek = __expf(cum - bl[t]);
            const float qdv = q[t] * e, kdv = kk[t] * ei, kev = kk[t] * ek;
            sQV[(idD * 16 + t) * 136 + k] = f2bf(qdv);
            if (i >= 2) sQV[(id0 * 16 + t) * 136 + k] = f2bf(qdv * c0);
            if (i == 3) sQV[(5 * 16 + t) * 136 + k] = f2bf(qdv * c1);
            sKD[(i * 16 + t) * 136 + k] = f2bf(kdv);
            if (i < 3) sKE[(i * 16 + t) * 136 + k] = f2bf(kev);
            kd16[t] = f2bf(kev * cdec);
            pqe[t * 512] = f2bf(qdv * cE);
        }
        u32x4 w0, w1;
        w0.x = kd16[0] | (kd16[1] << 16); w0.y = kd16[2] | (kd16[3] << 16); w0.z = kd16[4] | (kd16[5] << 16); w0.w = kd16[6] | (kd16[7] << 16);
        w1.x = kd16[8] | (kd16[9] << 16); w1.y = kd16[10] | (kd16[11] << 16); w1.z = kd16[12] | (kd16[13] << 16); w1.w = kd16[14] | (kd16[15] << 16);
        *(LAS u32x4*)(sKT + k * 72 + 16 * i) = w0; *(LAS u32x4*)(sKT + k * 72 + 16 * i + 8) = w1;
        if (i == 0) C.wsf(WS_DEC)[(size_t)item * 128 + k] = __expf(blast);
    }
    __syncthreads();
#pragma unroll
    for (int x = 0; x < 2; ++x) {
        const int tile = wid * 2 + x, ti = tile >> 2, tj = tile & 3;
        f32x4 d = {0.f, 0.f, 0.f, 0.f};
        if (tj <= ti) {
            const int ida = (ti == 0) ? 0 : (1 + ((ti - 1) * ti) / 2 + ((tj == ti) ? ti - 1 : tj));
            const LAS bf16_t* Aop = sQV + ida * 2176 + r * 136 + qd * 8;
            const LAS bf16_t* Bop = ((tj == ti) ? (sKD + ti * 2176) : (sKE + tj * 2176)) + r * 136 + qd * 8;
#pragma unroll
            for (int k4 = 0; k4 < 4; ++k4) d = MFMA16(ld8(Aop + k4 * 32), ld8(Bop + k4 * 32), d);
        }
#pragma unroll
        for (int jx = 0; jx < 4; ++jx) { const int t = 4 * qd + jx; const bool keep = (tj < ti) || (tj == ti && r <= t);
            sA[(16 * ti + t) * 72 + 16 * tj + r] = f2bf(keep ? d[jx] : 0.f); }
    }
    __syncthreads();
    {
        bf16_t* OI = C.wsb(WS_OI); bf16_t* DS = C.wsb(WS_DS) + (size_t)item * 16384;
        const bf16x8 v0 = ld8(sVT + (16 * wid + r) * 72 + qd * 8), v1 = ld8(sVT + (16 * wid + r) * 72 + 32 + qd * 8);
#pragma unroll
        for (int ti = 0; ti < 4; ++ti) {
            f32x4 d = {0.f, 0.f, 0.f, 0.f};
            d = MFMA16(v0, ld8(sA + (16 * ti + r) * 72 + qd * 8), d);
            d = MFMA16(v1, ld8(sA + (16 * ti + r) * 72 + 32 + qd * 8), d);
            u32x2 w; w.x = pk2(d[0], d[1]); w.y = pk2(d[2], d[3]);
            *(u32x2*)(OI + (row0 + 16 * ti + r) * 512 + hc + 16 * wid + 4 * qd) = w;
        }
#pragma unroll
        for (int kt = 0; kt < 8; ++kt) {
            f32x4 d = {0.f, 0.f, 0.f, 0.f};
            d = MFMA16(ld8(sKT + (16 * kt + r) * 72 + qd * 8), v0, d);
            d = MFMA16(ld8(sKT + (16 * kt + r) * 72 + 32 + qd * 8), v1, d);
            u32x2 w; w.x = pk2(d[0], d[1]); w.y = pk2(d[2], d[3]);
            *(u32x2*)(DS + (16 * wid + r) * 128 + 16 * kt + 4 * qd) = w;
        }
    }
    __syncthreads();
}

__device__ __forceinline__ void hg_scan(const Ctx& C) {
    const bf16_t* __restrict__ DS = C.wsb(WS_DS); bf16_t* __restrict__ SC = C.wsb(WS_SC); const float* __restrict__ DEC = C.wsf(WS_DEC);
    float* __restrict__ outS = C.out + OUT_SP;
    for (int g = blockIdx.x * NTHR + threadIdx.x; g < 32 * 4096; g += gridDim.x * NTHR) {
        const int bh = g >> 12, e = g & 4095, v = e >> 5, k4 = (e & 31) * 4, b = bh >> 2, h = bh & 3;
        float S0 = 0.f, S1 = 0.f, S2 = 0.f, S3 = 0.f;
#pragma unroll 1
        for (int half = 0; half < 2; ++half) {
            u32x2 dsv[16]; f32x4 dcv[16];
#pragma unroll
            for (int j = 0; j < 16; ++j) { const int item = b * 128 + (half * 16 + j) * 4 + h;
                dsv[j] = *(const u32x2*)(DS + (size_t)item * 16384 + v * 128 + k4); dcv[j] = *(const f32x4*)(DEC + (size_t)item * 128 + k4); }
#pragma unroll
            for (int j = 0; j < 16; ++j) { const int item = b * 128 + (half * 16 + j) * 4 + h; const size_t off = (size_t)item * 16384 + v * 128 + k4;
                u32x2 w; w.x = pk2(S0, S1); w.y = pk2(S2, S3); *(u32x2*)(SC + off) = w;
                S0 = dcv[j][0] * S0 + bflo(dsv[j].x); S1 = dcv[j][1] * S1 + bfhi(dsv[j].x); S2 = dcv[j][2] * S2 + bflo(dsv[j].y); S3 = dcv[j][3] * S3 + bfhi(dsv[j].y); }
        }
        float* o = outS + ((size_t)(b * 4 + h) * 128 + k4) * 128 + v;
        o[0] = S0; o[128] = S1; o[256] = S2; o[384] = S3;
    }
}

__device__ __forceinline__ void gmlp_item(const Ctx& C, LAS unsigned char* lds, int item) {
    const int tid = threadIdx.x, lane = tid & 63, wid = tid >> 6, r = lane & 15, qd = lane >> 4;
    const int n = item >> 2, g = item & 3; const size_t rb = (size_t)n * 128;
    LAS bf16_t* sW = (LAS bf16_t*)lds;
    LAS bf16_t* sVN = sW + 128 * 136;
    LAS float* sSt = (LAS float*)(sVN + 128 * 136);
    const bf16_t* Zgv = C.Z(6); const bf16_t* Zu = C.Z(5);
    u32x4 gvt[4]; u32x2 uu8[8]; float bb8[8];
#pragma unroll
    for (int it = 0; it < 4; ++it) { const int e = it * NTHR + tid; gvt[it] = *(const u32x4*)(Zgv + (rb + (e >> 4)) * 512 + g * 128 + (e & 15) * 8); }
#pragma unroll
    for (int ti = 0; ti < 8; ++ti) { uu8[ti] = *(const u32x2*)(Zu + (rb + 16 * ti + r) * 512 + g * 128 + 16 * wid + 4 * qd); bb8[ti] = C.in[13][g * 128 + 16 * ti + r]; }
    if (tid < 128) {
        const float* ln = C.wsf(WS_LN); const float s1 = ln[rb + tid], s2 = ln[MT + rb + tid];
        const float mean = s1 * (1.0f / 512.0f), var = fmaxf(s2 * (1.0f / 512.0f) - mean * mean, 0.f);
        sSt[tid * 2] = mean; sSt[tid * 2 + 1] = rsqrtf(var + EPS);
    }
    {
        const float* W = C.in[12] + (size_t)g * 16384;
#pragma unroll
        for (int it = 0; it < 8; ++it) { const int e = (it * NTHR + tid) * 4, t = e >> 7, s = e & 127; const f32x4 v = *(const f32x4*)(W + e);
            u32x2 w; w.x = pk2(s <= t ? v[0] : 0.f, s + 1 <= t ? v[1] : 0.f); w.y = pk2(s + 2 <= t ? v[2] : 0.f, s + 3 <= t ? v[3] : 0.f);
            *(LAS u32x2*)(sW + t * 136 + s) = w; }
    }
    __syncthreads();
    {
        const float* lgp = C.in[10] + g * 128; const float* lbp2 = C.in[11] + g * 128;
#pragma unroll
        for (int it = 0; it < 4; ++it) { const int e = it * NTHR + tid, sx = e >> 4, c8 = (e & 15) * 8;
            const u32x4 w = gvt[it]; const float mean = sSt[sx * 2], rs = sSt[sx * 2 + 1];
            const f32x4 g0 = *(const f32x4*)(lgp + c8), g1 = *(const f32x4*)(lgp + c8 + 4), b0 = *(const f32x4*)(lbp2 + c8), b1 = *(const f32x4*)(lbp2 + c8 + 4);
            u32x4 o;
            o.x = pk2((bflo(w.x) - mean) * rs * g0[0] + b0[0], (bfhi(w.x) - mean) * rs * g0[1] + b0[1]);
            o.y = pk2((bflo(w.y) - mean) * rs * g0[2] + b0[2], (bfhi(w.y) - mean) * rs * g0[3] + b0[3]);
            o.z = pk2((bflo(w.z) - mean) * rs * g1[0] + b1[0], (bfhi(w.z) - mean) * rs * g1[1] + b1[1]);
            o.w = pk2((bflo(w.w) - mean) * rs * g1[2] + b1[2], (bfhi(w.w) - mean) * rs * g1[3] + b1[3]);
            *(LAS u32x4*)(sVN + sx * 136 + c8) = o; }
    }
    __syncthreads();
    {
        bf16_t* O = C.wsb(WS_O);
        bf16x8 bfr[4];
#pragma unroll
        for (int k4 = 0; k4 < 4; ++k4) { unsigned x[8];
#pragma unroll
            for (int j = 0; j < 8; ++j) x[j] = sVN[(k4 * 32 + qd * 8 + j) * 136 + 16 * wid + r];
            u32x4 w; w.x = x[0] | (x[1] << 16); w.y = x[2] | (x[3] << 16); w.z = x[4] | (x[5] << 16); w.w = x[6] | (x[7] << 16);
            bfr[k4] = __builtin_bit_cast(bf16x8, w); }
#pragma unroll
        for (int ti = 0; ti < 8; ++ti) {
            f32x4 d = {0.f, 0.f, 0.f, 0.f};
#pragma unroll
            for (int k4 = 0; k4 < 4; ++k4) if (k4 <= (ti >> 1)) d = MFMA16(bfr[k4], ld8(sW + (16 * ti + r) * 136 + k4 * 32 + qd * 8), d);
            const int t = 16 * ti + r, cc = g * 128 + 16 * wid + 4 * qd; const float bb = bb8[ti];
            const u32x2 uu = uu8[ti];
            u32x2 w; w.x = pk2(bflo(uu.x) * (d[0] + bb), bfhi(uu.x) * (d[1] + bb)); w.y = pk2(bflo(uu.y) * (d[2] + bb), bfhi(uu.y) * (d[3] + bb));
            *(u32x2*)(O + (rb + t) * 1024 + 512 + cc) = w;
        }
    }
    __syncthreads();
}

__device__ __forceinline__ void hg_sample_item(const Ctx& C, LAS unsigned char* lds, int item) {
    const int tid = threadIdx.x, lane = tid & 63, wid = tid >> 6;
    const int bs = item >> 2, h = item & 3, hc = h * 128; const size_t r0 = (size_t)MP + bs * 4;
    LAS float* sq = (LAS float*)lds; LAS float* sk = sq + 512; LAS float* sf = sk + 512;
    LAS float* sp = sf + 512;
    LAS float* sred = sp + 2048;
    {
        const int t = tid >> 7, k = tid & 127; const size_t o = (r0 + t) * 512 + hc + k;
        sq[tid] = bf2f(C.Z(0)[o]); sk[tid] = bf2f(C.Z(1)[o]); sf[tid] = __expf(bf2f(C.Z(2)[o]));
    }
    const int v = tid & 127, kq = tid >> 7;
    const float gg_pre = bf2f(C.Z(4)[(r0 + (tid >> 7)) * 512 + hc + v]), hgn_pre = C.in[9][hc + v];
    float S[32];
    const float* sin = C.in[3] + (size_t)item * 16384 + (size_t)(kq * 32) * 128 + v;
#pragma unroll
    for (int j = 0; j < 32; ++j) S[j] = sin[j * 128];
    float vt[4];
#pragma unroll
    for (int t = 0; t < 4; ++t) vt[t] = bf2f(C.Z(3)[(r0 + t) * 512 + hc + v]);
    __syncthreads();
#pragma unroll
    for (int t = 0; t < 4; ++t) {
        float po = 0.f;
#pragma unroll
        for (int j = 0; j < 32; ++j) { const int k = kq * 32 + j; S[j] = sf[t * 128 + k] * S[j] + sk[t * 128 + k] * vt[t]; po += S[j] * sq[t * 128 + k]; }
        sp[(kq * 4 + t) * 128 + v] = po;
    }
    float* sout = C.out + OUT_SSMP + (size_t)item * 16384 + (size_t)(kq * 32) * 128 + v;
#pragma unroll
    for (int j = 0; j < 32; ++j) sout[j * 128] = S[j];
    __syncthreads();
    {
        const int t = tid >> 7;
        const float o = sp[(0 * 4 + t) * 128 + v] + sp[(1 * 4 + t) * 128 + v] + sp[(2 * 4 + t) * 128 + v] + sp[(3 * 4 + t) * 128 + v];
        float s = o * o;
#pragma unroll
        for (int x = 32; x >= 1; x >>= 1) s += __shfl_xor(s, x);
        if (lane == 0) sred[wid] = s;
        __syncthreads();
        const float ms = (sred[2 * t] + sred[2 * t + 1]) * (1.0f / 128.0f);
        C.wsb(WS_O)[(r0 + t) * 1024 + hc + v] = f2bf(o * rsqrtf(ms + EPS) * hgn_pre * gg_pre);
    }
    __syncthreads();
}

__device__ __forceinline__ void gmlp_sample_item(const Ctx& C, LAS unsigned char* lds, int bs) {
    const int tid = threadIdx.x, lane = tid & 63, wid = tid >> 6; const size_t r0 = (size_t)MP + bs * 4;
    LAS float* sred = (LAS float*)lds;
    const int c = tid, g = c >> 7;
    float gv[4], s[4], s2[4], uuv[4], bsv[4], wv[10];
    const float lg = C.in[10][c], lbb = C.in[11][c];
    { const float* W = C.in[12] + (size_t)g * 16384; const float* bsp = C.in[13] + g * 128; int q = 0;
#pragma unroll
      for (int t = 0; t < 4; ++t) { bsv[t] = bsp[t]; uuv[t] = bf2f(C.Z(5)[(r0 + t) * 512 + c]);
#pragma unroll
          for (int sx = 0; sx < 4; ++sx) if (sx <= t) wv[q++] = W[t * 128 + sx]; } }
#pragma unroll
    for (int t = 0; t < 4; ++t) { gv[t] = bf2f(C.Z(6)[(r0 + t) * 512 + c]); s[t] = gv[t]; s2[t] = gv[t] * gv[t]; }
#pragma unroll
    for (int t = 0; t < 4; ++t)
#pragma unroll
        for (int x = 32; x >= 1; x >>= 1) { s[t] += __shfl_xor(s[t], x); s2[t] += __shfl_xor(s2[t], x); }
    if (lane == 0) {
#pragma unroll
        for (int t = 0; t < 4; ++t) { sred[wid * 8 + t] = s[t]; sred[wid * 8 + 4 + t] = s2[t]; } }
    __syncthreads();
    float vn[4];
#pragma unroll
    for (int t = 0; t < 4; ++t) { float a = 0.f, a2 = 0.f;
#pragma unroll
        for (int w = 0; w < 8; ++w) { a += sred[w * 8 + t]; a2 += sred[w * 8 + 4 + t]; }
        const float mean = a * (1.0f / 512.0f), var = fmaxf(a2 * (1.0f / 512.0f) - mean * mean, 0.f);
        vn[t] = (gv[t] - mean) * rsqrtf(var + EPS) * lg + lbb;
        C.out[OUT_CMV + ((size_t)bs * 4 + t) * 512 + c] = vn[t]; }
    { int q = 0;
#pragma unroll
      for (int t = 0; t < 4; ++t) { float mix = bsv[t];
#pragma unroll
          for (int sx = 0; sx < 4; ++sx) if (sx <= t) mix += wv[q++] * vn[sx];
          C.wsb(WS_O)[(r0 + t) * 1024 + 512 + c] = f2bf(uuv[t] * mix); } }
    __syncthreads();
}

__device__ __forceinline__ void hg_out(const Ctx& C, LAS unsigned char* lds) {
    const int tid = threadIdx.x, lane = tid & 63, wid = tid >> 6, r = lane & 15, qd = lane >> 4;
    const bf16_t* __restrict__ QE = C.Z(7); const bf16_t* __restrict__ SC = C.wsb(WS_SC); const bf16_t* __restrict__ OI = C.wsb(WS_OI); const bf16_t* __restrict__ Zg = C.Z(4); bf16_t* __restrict__ O = C.wsb(WS_O);
    const float* hgn = C.in[9];
    LAS bf16_t* sS = (LAS bf16_t*)lds;
    const int sv = (tid >> 4) & 127, sk8 = (tid & 15) * 8;
    u32x4 st[8];
    int p = blockIdx.x;
#define HGO_LOAD(pp) do { _Pragma("unroll") for (int it = 0; it < 8; ++it) { const int e = it * NTHR + tid; \
        st[it] = *(const u32x4*)(SC + (size_t)(2 * (pp) + (e >> 11)) * 16384 + ((e & 2047) >> 4) * 128 + (e & 15) * 8); } } while (0)
    if (p < 512) HGO_LOAD(p);
    for (; p < 512; p += gridDim.x) {
        const int item = 2 * p + (wid >> 2), ti = wid & 3; const int b = item >> 7, c = (item >> 2) & 31, h = item & 3, hc = h * 128;
        const size_t row = (size_t)b * 2048 + c * 64 + 16 * ti + r;
        bf16x8 a[4];
#pragma unroll
        for (int k4 = 0; k4 < 4; ++k4) a[k4] = gld8(QE + row * 512 + hc + k4 * 32 + qd * 8);
        u32x2 oi[8], gg[8];
#pragma unroll
        for (int vt = 0; vt < 8; ++vt) { oi[vt] = *(const u32x2*)(OI + row * 512 + hc + 16 * vt + 4 * qd); gg[vt] = *(const u32x2*)(Zg + row * 512 + hc + 16 * vt + 4 * qd); }
        __syncthreads();
#pragma unroll
        for (int it = 0; it < 8; ++it) { const int e = it * NTHR + tid; *(LAS u32x4*)(sS + (e >> 11) * (128 * 136) + ((e & 2047) >> 4) * 136 + (e & 15) * 8) = st[it]; }
        __syncthreads();
        if (p + (int)gridDim.x < 512) HGO_LOAD(p + gridDim.x);
        const LAS bf16_t* sT = sS + (wid >> 2) * (128 * 136);
        f32x4 d[8];
#pragma unroll
        for (int vt = 0; vt < 8; ++vt) { d[vt] = (f32x4){0.f, 0.f, 0.f, 0.f};
#pragma unroll
            for (int k4 = 0; k4 < 4; ++k4) d[vt] = MFMA16(ld8(sT + (16 * vt + r) * 136 + k4 * 32 + qd * 8), a[k4], d[vt]); }
        float sq = 0.f;
#pragma unroll
        for (int vt = 0; vt < 8; ++vt) {
            d[vt][0] += bflo(oi[vt].x); d[vt][1] += bfhi(oi[vt].x); d[vt][2] += bflo(oi[vt].y); d[vt][3] += bfhi(oi[vt].y);
            sq += (d[vt][0] * d[vt][0] + d[vt][1] * d[vt][1]) + (d[vt][2] * d[vt][2] + d[vt][3] * d[vt][3]); }
        sq += __shfl_xor(sq, 16); sq += __shfl_xor(sq, 32);
        const float rs = rsqrtf(sq * (1.0f / 128.0f) + EPS);
#pragma unroll
        for (int vt = 0; vt < 8; ++vt) { const int cc = hc + 16 * vt + 4 * qd; const f32x4 gn = *(const f32x4*)(hgn + cc);
            u32x2 w; w.x = pk2(d[vt][0] * rs * gn[0] * bflo(gg[vt].x), d[vt][1] * rs * gn[1] * bfhi(gg[vt].x)); w.y = pk2(d[vt][2] * rs * gn[2] * bflo(gg[vt].y), d[vt][3] * rs * gn[3] * bfhi(gg[vt].y));
            *(u32x2*)(O + row * 1024 + cc) = w; }
    }
#undef HGO_LOAD
    __syncthreads();
    (void)sv; (void)sk8;
}

__device__ __forceinline__ void attn_prompt_item(const Ctx& C, LAS unsigned char* lds, int item) {
    const int tid = threadIdx.x, lane = tid & 63, wid = tid >> 6, r = lane & 15, qd = lane >> 4;
    const int b = item >> 5, h = (item >> 3) & 3, qt = item & 7;
    int opq = 0; asm volatile("" : "+v"(opq));
    LAS bf16_t* sK = (LAS bf16_t*)lds + opq;
    const bf16_t* KB = C.wsb(WS_KB); const bf16_t* VT = C.wsb(WS_VT); const bf16_t* HQ = C.wsb(WS_HQ); bf16_t* CA = C.wsb(WS_CA);
    const size_t q0 = (size_t)b * 2048 + qt * 256 + wid * 32;
    {   const bf16_t* gsrc = KB + ((size_t)b * 256 + (tid >> 5)) * 1024 + h * 256 + (tid & 31) * 8; LAS bf16_t* ldst = sK + (tid >> 5) * 264 + (tid & 31) * 8;
        u32x4 stg[16];
#pragma unroll
        for (int it = 0; it < 16; ++it) stg[it] = *(const u32x4*)(gsrc + (size_t)it * 16 * 1024);
#pragma unroll
        for (int it = 0; it < 16; ++it) *(LAS u32x4*)(ldst + it * 16 * 264) = stg[it]; }
    bf16x8 qf[2][8];
#pragma unroll
    for (int x = 0; x < 2; ++x)
#pragma unroll
        for (int k8 = 0; k8 < 8; ++k8) qf[x][k8] = gld8(HQ + (q0 + x * 16 + r) * 1024 + h * 256 + k8 * 32 + qd * 8);
    __syncthreads();
    bf16x8 pf[2][8];
    {
        f32x4 s[2][16];
#pragma unroll
        for (int mt = 0; mt < 16; ++mt) { s[0][mt] = (f32x4){0.f, 0.f, 0.f, 0.f}; s[1][mt] = (f32x4){0.f, 0.f, 0.f, 0.f};
#pragma unroll
            for (int k8 = 0; k8 < 8; ++k8) { const bf16x8 kf = ld8(sK + (16 * mt + r) * 264 + k8 * 32 + qd * 8);
                s[0][mt] = MFMA16(kf, qf[0][k8], s[0][mt]); s[1][mt] = MFMA16(kf, qf[1][k8], s[1][mt]); } }
#pragma unroll
        for (int x = 0; x < 2; ++x) {
            float mx = -3.0e38f;
#pragma unroll
            for (int mt = 0; mt < 16; ++mt)
#pragma unroll
                for (int jx = 0; jx < 4; ++jx) mx = fmaxf(mx, s[x][mt][jx]);
            mx = fmaxf(mx, __shfl_xor(mx, 16)); mx = fmaxf(mx, __shfl_xor(mx, 32));
            float sum = 0.f;
#pragma unroll
            for (int mt = 0; mt < 16; ++mt)
#pragma unroll
                for (int jx = 0; jx < 4; ++jx) { const float e = __expf(s[x][mt][jx] - mx); s[x][mt][jx] = e; sum += e; }
            sum += __shfl_xor(sum, 16); sum += __shfl_xor(sum, 32);
            const float inv = __builtin_amdgcn_rcpf(sum);
#pragma unroll
            for (int k8 = 0; k8 < 8; ++k8) { u32x4 w; w.x = pk2(s[x][2 * k8][0] * inv, s[x][2 * k8][1] * inv); w.y = pk2(s[x][2 * k8][2] * inv, s[x][2 * k8][3] * inv);
                w.z = pk2(s[x][2 * k8 + 1][0] * inv, s[x][2 * k8 + 1][1] * inv); w.w = pk2(s[x][2 * k8 + 1][2] * inv, s[x][2 * k8 + 1][3] * inv);
                pf[x][k8] = __builtin_bit_cast(bf16x8, w); }
        }
    }
    __syncthreads();
    {   const bf16_t* gsrc = VT + ((size_t)b * 1024 + h * 256 + (tid >> 5)) * 256 + (tid & 31) * 8; LAS bf16_t* ldst = sK + (tid >> 5) * 264 + (tid & 31) * 8;
        u32x4 stg[16];
#pragma unroll
        for (int it = 0; it < 16; ++it) stg[it] = *(const u32x4*)(gsrc + (size_t)it * 16 * 256);
#pragma unroll
        for (int it = 0; it < 16; ++it) *(LAS u32x4*)(ldst + it * 16 * 264) = stg[it]; }
    __syncthreads();
#pragma unroll 2
    for (int dt = 0; dt < 16; ++dt) {
        f32x4 o0 = {0.f, 0.f, 0.f, 0.f}, o1 = {0.f, 0.f, 0.f, 0.f};
        bf16x8 vf[8];
#pragma unroll
        for (int k8 = 0; k8 < 8; ++k8) {
            const LAS bf16_t* vp = sK + (16 * dt + r) * 264 + 32 * k8 + 4 * qd;
            const u32x2 lo = *(const LAS u32x2*)vp, hi = *(const LAS u32x2*)(vp + 16);
            u32x4 w; w.x = lo.x; w.y = lo.y; w.z = hi.x; w.w = hi.y; vf[k8] = __builtin_bit_cast(bf16x8, w);
        }
#pragma unroll
        for (int k8 = 0; k8 < 8; ++k8) { o0 = MFMA16(vf[k8], pf[0][k8], o0); o1 = MFMA16(vf[k8], pf[1][k8], o1); }
        u32x2 w0, w1; w0.x = pk2(o0[0], o0[1]); w0.y = pk2(o0[2], o0[3]); w1.x = pk2(o1[0], o1[1]); w1.y = pk2(o1[2], o1[3]);
        *(u32x2*)(CA + (q0 + r) * 1024 + h * 256 + 16 * dt + 4 * qd) = w0;
        *(u32x2*)(CA + (q0 + 16 + r) * 1024 + h * 256 + 16 * dt + 4 * qd) = w1;
    }
    __syncthreads();
}

__device__ __forceinline__ void attn_sample_item(const Ctx& C, LAS unsigned char* lds, int item) {
    const int tid = threadIdx.x, lane = tid & 63, wid = tid >> 6, r = lane & 15, qd = lane >> 4;
    const int bs = item >> 1, hp = item & 1, hl = wid & 1, h = 2 * hp + hl, kq = wid >> 1;
    LAS float* sP = (LAS float*)lds;
    LAS float* sMx = sP + 2048;
    LAS float* sSm = sMx + 32;
    LAS float* sO = sSm + 32;
    const bf16_t* HQ = C.wsb(WS_HQ); const size_t r0 = (size_t)MP + bs * 4;
    const float* Kc = C.in[4] + (size_t)bs * 262144; const float* Vc = C.in[5] + (size_t)bs * 262144;
    bf16x8 qf[8];
#pragma unroll
    for (int k8 = 0; k8 < 8; ++k8) { if (r < 4) qf[k8] = gld8(HQ + (r0 + r) * 1024 + h * 256 + k8 * 32 + qd * 8); else qf[k8] = (bf16x8){0, 0, 0, 0, 0, 0, 0, 0}; }
    f32x4 s[4];
    const float* kp = Kc + ((size_t)(kq * 64 + r) * 4 + h) * 256 + qd * 8;
    const float* vp = Vc + ((size_t)(kq * 64) * 4 + h) * 256 + lane * 4;
    f32x4 ka[16], kb[16];
#define LOADK(dst, mt) do { _Pragma("unroll") for (int k8 = 0; k8 < 8; ++k8) { dst[2 * k8] = *(const f32x4*)(kp + (size_t)(mt) * 16384 + k8 * 32); dst[2 * k8 + 1] = *(const f32x4*)(kp + (size_t)(mt) * 16384 + k8 * 32 + 4); } } while (0)
#define MMAK(src, mt) do { s[mt] = (f32x4){0.f, 0.f, 0.f, 0.f}; _Pragma("unroll") for (int k8 = 0; k8 < 8; ++k8) { u32x4 w; w.x = pk2(src[2 * k8][0], src[2 * k8][1]); w.y = pk2(src[2 * k8][2], src[2 * k8][3]); \
        w.z = pk2(src[2 * k8 + 1][0], src[2 * k8 + 1][1]); w.w = pk2(src[2 * k8 + 1][2], src[2 * k8 + 1][3]); s[mt] = MFMA16(__builtin_bit_cast(bf16x8, w), qf[k8], s[mt]); } } while (0)
#define LOADV(dst, m0) do { _Pragma("unroll") for (int m = 0; m < 16; ++m) dst[m] = *(const f32x4*)(vp + (size_t)((m0) + m) * 1024); } while (0)
#define FMAV(src, m0) do { _Pragma("unroll") for (int m = 0; m < 16; ++m) { _Pragma("unroll") for (int t = 0; t < 4; ++t) acc[t] += src[m] * sP[(wid * 4 + t) * 64 + (m0) + m]; } } while (0)
    LOADK(ka, 0); LOADK(kb, 1);
    MMAK(ka, 0); LOADK(ka, 2);
    MMAK(kb, 1); LOADK(kb, 3);
    MMAK(ka, 2); LOADV(ka, 0);
    MMAK(kb, 3); LOADV(kb, 16);
    float mx = -3.0e38f;
#pragma unroll
    for (int mt = 0; mt < 4; ++mt)
#pragma unroll
        for (int jx = 0; jx < 4; ++jx) mx = fmaxf(mx, s[mt][jx]);
    mx = fmaxf(mx, __shfl_xor(mx, 16)); mx = fmaxf(mx, __shfl_xor(mx, 32));
    float sum = 0.f;
#pragma unroll
    for (int mt = 0; mt < 4; ++mt)
#pragma unroll
        for (int jx = 0; jx < 4; ++jx) { const float e = __expf(s[mt][jx] - mx); s[mt][jx] = e; sum += e; }
    sum += __shfl_xor(sum, 16); sum += __shfl_xor(sum, 32);
    if (lane < 4) { sMx[(hl * 4 + kq) * 4 + lane] = mx; sSm[(hl * 4 + kq) * 4 + lane] = sum; }
    if (r < 4) {
#pragma unroll
        for (int mt = 0; mt < 4; ++mt)
#pragma unroll
            for (int jx = 0; jx < 4; ++jx) sP[(wid * 4 + r) * 64 + 16 * mt + 4 * qd + jx] = s[mt][jx];
    }
    {
        f32x4 acc[4];
#pragma unroll
        for (int t = 0; t < 4; ++t) acc[t] = (f32x4){0.f, 0.f, 0.f, 0.f};
        FMAV(ka, 0); LOADV(ka, 32);
        FMAV(kb, 16); LOADV(kb, 48);
        FMAV(ka, 32); FMAV(kb, 48);
#pragma unroll
        for (int t = 0; t < 4; ++t) *(LAS f32x4*)(sO + ((hl * 4 + kq) * 4 + t) * 256 + lane * 4) = acc[t];
    }
#undef LOADK
#undef MMAK
#undef LOADV
#undef FMAV
    __syncthreads();
    {
        const int e = tid * 4, hl2 = e >> 10, t = (e >> 8) & 3, d = e & 255;
        float m4[4], w4[4]; float gm = -3.0e38f, den = 0.f;
#pragma unroll
        for (int q4 = 0; q4 < 4; ++q4) { m4[q4] = sMx[(hl2 * 4 + q4) * 4 + t]; gm = fmaxf(gm, m4[q4]); }
#pragma unroll
        for (int q4 = 0; q4 < 4; ++q4) { w4[q4] = __expf(m4[q4] - gm); den += w4[q4] * sSm[(hl2 * 4 + q4) * 4 + t]; }
        const float inv = __builtin_amdgcn_rcpf(den);
        f32x4 o = {0.f, 0.f, 0.f, 0.f};
#pragma unroll
        for (int q4 = 0; q4 < 4; ++q4) o += *(const LAS f32x4*)(sO + ((hl2 * 4 + q4) * 4 + t) * 256 + d) * (w4[q4] * inv);
        u32x2 w; w.x = pk2(o[0], o[1]); w.y = pk2(o[2], o[3]);
        *(u32x2*)(C.wsb(WS_CA) + (r0 + t) * 1024 + (2 * hp + hl2) * 256 + d) = w;
    }
    __syncthreads();
}

template <class F> __device__ __forceinline__ void sgemm_tile(const bf16_t* A, const bf16_t* Bt, int K, int N, int tile, LAS unsigned char* lds, const F& epi) {
    const int tid = threadIdx.x, lane = tid & 63, wid = tid >> 6, r = lane & 15, qd = lane >> 4;
    const int ntn = N >> 6; const int mt = tile / ntn, nt = tile - mt * ntn;
    const int row0 = MP + 32 * mt, n0 = 64 * nt; const int KW = K >> 3;
    f32x4 acc[2][4];
#pragma unroll
    for (int mi = 0; mi < 2; ++mi)
#pragma unroll
        for (int ni = 0; ni < 4; ++ni) acc[mi][ni] = (f32x4){0.f, 0.f, 0.f, 0.f};
    const bf16_t* ap = A + (size_t)(row0 + r) * K + wid * KW + qd * 8;
    const bf16_t* bp = Bt + (size_t)(n0 + r) * K + wid * KW + qd * 8;
#pragma unroll 1
    for (int kc = 0; kc < KW; kc += 128) {
        bf16x8 a[2][4], b[4][4];
#pragma unroll
        for (int ks = 0; ks < 4; ++ks) {
#pragma unroll
            for (int mi = 0; mi < 2; ++mi) a[mi][ks] = gld8(ap + (size_t)mi * 16 * K + kc + ks * 32);
#pragma unroll
            for (int ni = 0; ni < 4; ++ni) b[ni][ks] = gld8(bp + (size_t)ni * 16 * K + kc + ks * 32);
        }
#pragma unroll
        for (int ks = 0; ks < 4; ++ks)
#pragma unroll
            for (int mi = 0; mi < 2; ++mi)
#pragma unroll
                for (int ni = 0; ni < 4; ++ni) acc[mi][ni] = MFMA16(a[mi][ks], b[ni][ks], acc[mi][ni]);
    }
    LAS float* red = (LAS float*)lds;
#pragma unroll
    for (int mi = 0; mi < 2; ++mi)
#pragma unroll
        for (int ni = 0; ni < 4; ++ni)
#pragma unroll
            for (int jx = 0; jx < 4; ++jx) red[(wid * 32 + 16 * mi + 4 * qd + jx) * 68 + 16 * ni + r] = acc[mi][ni][jx];
    __syncthreads();
    {
        const int row = tid >> 4, c4 = (tid & 15) * 4;
        f32x4 v = *(const LAS f32x4*)(red + row * 68 + c4);
#pragma unroll
        for (int w = 1; w < 8; ++w) v += *(const LAS f32x4*)(red + (w * 32 + row) * 68 + c4);
        epi(row0 + row, n0 + c4, v);
    }
    __syncthreads();
}
struct SEpi1 {
    bf16_t* Zb; const float* lbp; float* ln;
    __device__ __forceinline__ void operator()(int row, int col, const f32x4& v) const {
        const int sec = col >> 9, cs = col & 511; const size_t o = (size_t)row * 512 + cs;
        if (sec == 1) {
            const f32x4 p0 = *(const f32x4*)(lbp + cs), p1 = *(const f32x4*)(lbp + 512 + cs); float kk[4], lf[4];
#pragma unroll
            for (int j = 0; j < 4; ++j) { const float lb = sigm(p0[j] - p1[j]), sg = sigm(v[j]), oml = 1.0f - lb; kk[j] = oml * (1.0f - sg); lf[j] = __logf(lb + oml * sg); }
            u32x2 w; w.x = pk2(kk[0], kk[1]); w.y = pk2(kk[2], kk[3]); *(u32x2*)(Zb + ZSZ + o) = w;
            w.x = pk2(lf[0], lf[1]); w.y = pk2(lf[2], lf[3]); *(u32x2*)(Zb + 2 * ZSZ + o) = w;
        } else {
            float rr[4];
#pragma unroll
            for (int j = 0; j < 4; ++j) { const float z = v[j]; const float t = (sec >= 4) ? 1.5957691216f * (z + 0.044715f * z * z * z) : z; const float sg = sigm(t);
                rr[j] = (sec == 2) ? z : ((sec == 3) ? sg : z * sg); }
            u32x2 w; w.x = pk2(rr[0], rr[1]); w.y = pk2(rr[2], rr[3]); *(u32x2*)(Zb + (size_t)(sec == 0 ? 0 : sec + 1) * ZSZ + o) = w;
            if (sec == 5) { float a = (rr[0] + rr[1]) + (rr[2] + rr[3]), b = (rr[0] * rr[0] + rr[1] * rr[1]) + (rr[2] * rr[2] + rr[3] * rr[3]);
                a += __shfl_xor(a, 1); b += __shfl_xor(b, 1); a += __shfl_xor(a, 2); b += __shfl_xor(b, 2); a += __shfl_xor(a, 4); b += __shfl_xor(b, 4); a += __shfl_xor(a, 8); b += __shfl_xor(b, 8);
                if ((threadIdx.x & 15) == 0) { atomicAdd(ln + row, a); atomicAdd(ln + MT + row, b); } }
        }
    }
};
template <bool RB> struct SEpiRes {
    const float* resf; bf16_t* xb; float* ss;
    __device__ __forceinline__ void operator()(int row, int col, const f32x4& a) const {
        const size_t o = (size_t)row * 1024 + col; f32x4 v;
        if (RB) { const u32x2 rr = *(const u32x2*)(xb + o); v = (f32x4){bflo(rr.x), bfhi(rr.x), bflo(rr.y), bfhi(rr.y)} + a; }
        else v = *(const f32x4*)(resf + o) + a;
        u32x2 w; w.x = pk2(v[0], v[1]); w.y = pk2(v[2], v[3]); *(u32x2*)(xb + o) = w;
        float s = (v[0] * v[0] + v[1] * v[1]) + (v[2] * v[2] + v[3] * v[3]);
        s += __shfl_xor(s, 1); s += __shfl_xor(s, 2); s += __shfl_xor(s, 4); s += __shfl_xor(s, 8);
        if ((threadIdx.x & 15) == 0) atomicAdd(ss + row, s);
    }
};
template <int ACT> struct SEpiScale {
    bf16_t* O; int ldc; const float* ss; float scale;
    __device__ __forceinline__ void operator()(int row, int col, const f32x4& a) const {
        const float rs = rsqrtf(ss[row] * (1.0f / 1024.0f) + EPS) * scale; f32x4 v = a * rs;
        if (ACT == 1) {
#pragma unroll
            for (int j = 0; j < 4; ++j) { const float x = fmaxf(v[j], 0.f); v[j] = x * x; } }
        u32x2 w; w.x = pk2(v[0], v[1]); w.y = pk2(v[2], v[3]); *(u32x2*)(O + (size_t)row * ldc + col) = w;
    }
};


__device__ __forceinline__ void panel_wait(unsigned* cnt, unsigned want) {
    if (threadIdx.x == 0) {
        __hip_atomic_fetch_add(cnt, 1u, __ATOMIC_RELAXED, __HIP_MEMORY_SCOPE_AGENT);
        unsigned sp = 0;
        while (__hip_atomic_load(cnt, __ATOMIC_RELAXED, __HIP_MEMORY_SCOPE_AGENT) < want) { __builtin_amdgcn_s_sleep(2); if (++sp > (1u << 22)) break; }
        __builtin_amdgcn_fence(__ATOMIC_ACQUIRE, "agent");
        asm volatile("s_waitcnt vmcnt(0)" ::: "memory");
    }
}
struct EpiFinal {
    static constexpr bool PERM = false, AFTER_DRAIN = true;
    const bf16_t* res; float* out; float* ss; unsigned* cnt; const float* gfin;
    __device__ __forceinline__ void fused(f32x4 (&acc)[2][2][4][2], const pg8::Unit& u, int wr, int wc, int fr, int fq, LAS unsigned char* lds, int wid, int lane) const {
        const int row0 = u.pm * 256 + wr * 64 + fr, col0 = u.pn * 256 + wc * 32 + 4 * fq;
#pragma unroll
        for (int ai = 0; ai < 2; ++ai)
#pragma unroll
            for (int m = 0; m < 4; ++m) {
                const int row = row0 + ai * 128 + m * 16; const size_t o = (size_t)row * 1024 + col0; float s = 0.f;
#pragma unroll
                for (int bj = 0; bj < 2; ++bj)
#pragma unroll
                    for (int n = 0; n < 2; ++n) { const u32x2 rr = *(const u32x2*)(res + o + bj * 128 + n * 16); const f32x4 v = (f32x4){bflo(rr.x), bfhi(rr.x), bflo(rr.y), bfhi(rr.y)} + acc[ai][bj][m][n]; acc[ai][bj][m][n] = v;
                        s += (v[0] * v[0] + v[1] * v[1]) + (v[2] * v[2] + v[3] * v[3]); }
                s += __shfl_xor(s, 16); s += __shfl_xor(s, 32);
                if (fq == 0) atomicAdd(ss + row, s);
            }
        asm volatile("s_waitcnt vmcnt(0)" ::: "memory");
        __syncthreads();
        panel_wait(cnt + 64 * u.pm, 4u);
        __syncthreads();
        f32x4 gv[2][2];
#pragma unroll
        for (int bj = 0; bj < 2; ++bj)
#pragma unroll
            for (int n = 0; n < 2; ++n) gv[bj][n] = *(const f32x4*)(gfin + col0 + bj * 128 + n * 16);
        float ssv[2][4];
#pragma unroll
        for (int ai = 0; ai < 2; ++ai)
#pragma unroll
            for (int m = 0; m < 4; ++m) ssv[ai][m] = __hip_atomic_load(ss + row0 + ai * 128 + m * 16, __ATOMIC_RELAXED, __HIP_MEMORY_SCOPE_AGENT);
#pragma unroll
        for (int ai = 0; ai < 2; ++ai)
#pragma unroll
            for (int m = 0; m < 4; ++m) {
                const int row = row0 + ai * 128 + m * 16; const size_t o = (size_t)row * 1024 + col0;
                const float rs = rsqrtf(ssv[ai][m] * (1.0f / 1024.0f) + EPS);
#pragma unroll
                for (int bj = 0; bj < 2; ++bj)
#pragma unroll
                    for (int n = 0; n < 2; ++n) *(f32x4*)(out + o + bj * 128 + n * 16) = acc[ai][bj][m][n] * rs * gv[bj][n];
            }
    }
};
struct SEpiFinal {
    const bf16_t* res; float* out; float* ss; unsigned* cnt; const float* gfin;
    __device__ __forceinline__ void operator()(int row, int col, const f32x4& a) const {
        const size_t o = (size_t)row * 1024 + col; const u32x2 rr = *(const u32x2*)(res + o); const f32x4 v = (f32x4){bflo(rr.x), bfhi(rr.x), bflo(rr.y), bfhi(rr.y)} + a;
        float s = (v[0] * v[0] + v[1] * v[1]) + (v[2] * v[2] + v[3] * v[3]);
        s += __shfl_xor(s, 1); s += __shfl_xor(s, 2); s += __shfl_xor(s, 4); s += __shfl_xor(s, 8);
        if ((threadIdx.x & 15) == 0) atomicAdd(ss + row, s);
        asm volatile("s_waitcnt vmcnt(0)" ::: "memory");
        __syncthreads();
        panel_wait(cnt + 64 * ((row - MP) >> 5), 16u);
        __syncthreads();
        const float rs = rsqrtf(__hip_atomic_load(ss + row, __ATOMIC_RELAXED, __HIP_MEMORY_SCOPE_AGENT) * (1.0f / 1024.0f) + EPS);
        *(f32x4*)(out + o) = v * rs * *(const f32x4*)(gfin + col);
    }
};

#define XB_TMO      128
#define XB_XCNT(j)  (256  + 64 * (j))
#define XB_XSUB(j)  (1280 + 64 * (j))
#define XB_XGEN(j)  (2304 + 64 * (j))
#define XB_TOP      3328
#define XB_TOPGEN   3392
#define XCD_BAR_WORDS 3456
#define XB_SPIN_CAP (1u << 18)

__device__ __forceinline__ unsigned xb_ld(unsigned* p)              { return __hip_atomic_load(p, __ATOMIC_RELAXED, __HIP_MEMORY_SCOPE_AGENT); }
__device__ __forceinline__ unsigned xb_add(unsigned* p, unsigned v) { return __hip_atomic_fetch_add(p, v, __ATOMIC_RELAXED, __HIP_MEMORY_SCOPE_AGENT); }
__device__ __forceinline__ unsigned xb_xcc_id() { return (unsigned)__builtin_amdgcn_s_getreg((3 << 11) | 20) & 0xFu; }
#define XB_SPIN(cond, bar) do { unsigned _sp = 0; while (cond) { __builtin_amdgcn_s_sleep(1); \
    if ((++_sp & 255u) == 0u) { if (xb_ld(&(bar)[XB_TMO])) break; if (_sp > XB_SPIN_CAP) { atomicAdd(&(bar)[XB_TMO], 1u); break; } } } } while (0)

struct XcdBarrier {
    unsigned* bar; unsigned x;
    volatile LAS unsigned* st;
};

__device__ __forceinline__ XcdBarrier xcd_barrier_post(unsigned* bar, volatile LAS unsigned* st) {
    XcdBarrier b; b.bar = bar; b.x = xb_xcc_id(); b.st = st;
    if (threadIdx.x == 0) (void)xb_add(&bar[XB_XCNT(b.x)], 1u);
    return b;
}
__device__ __forceinline__ void xcd_barrier_complete(unsigned* bar, unsigned x, unsigned& nloc, unsigned& nx) {
    const unsigned G = gridDim.x * gridDim.y * gridDim.z;
    unsigned sum, cnt, mine, sp = 0u;
    for (;;) {
        sum = 0u; cnt = 0u; mine = 0u;
#pragma unroll
        for (unsigned j = 0; j < 16; ++j) { const unsigned c = xb_ld(&bar[XB_XCNT(j)]); sum += c; cnt += (c > 0u) ? 1u : 0u; mine = (j == x) ? c : mine; }
        if (sum == G) break;
        __builtin_amdgcn_s_sleep(1);
        if ((++sp & 255u) == 0u) { if (xb_ld(&bar[XB_TMO])) break; if (sp > XB_SPIN_CAP) { atomicAdd(&bar[XB_TMO], 1u); break; } }
    }
    nloc = mine > 0u ? mine : 1u; nx = cnt > 0u ? cnt : 1u;
}

__device__ __forceinline__ void xcd_barrier(const XcdBarrier& b) {
    asm volatile("s_waitcnt vmcnt(0)" ::: "memory");
    __syncthreads();
    if (threadIdx.x == 0) {
        unsigned* bar = b.bar;
        __builtin_amdgcn_s_waitcnt(0);
        unsigned nloc = b.st[0], nx = b.st[1];
        if (nloc == 0u) { xcd_barrier_complete(bar, b.x, nloc, nx); b.st[0] = nloc; b.st[1] = nx; }
        const unsigned old = xb_add(&bar[XB_XSUB(b.x)], 1u);
        const unsigned gen = old / nloc;
        if (old + 1u == (gen + 1u) * nloc) {
            __builtin_amdgcn_fence(__ATOMIC_RELEASE, "agent");
            asm volatile("s_waitcnt vmcnt(0)" ::: "memory");
            const unsigned og = xb_add(&bar[XB_TOP], 1u);
            const unsigned tg = og / nx;
            if (og + 1u == (tg + 1u) * nx) xb_add(&bar[XB_TOPGEN], 1u);
            else XB_SPIN(xb_ld(&bar[XB_TOPGEN]) == tg, bar);
            __builtin_amdgcn_fence(__ATOMIC_ACQUIRE, "agent");
            xb_add(&bar[XB_XGEN(b.x)], 1u);
            asm volatile("s_waitcnt vmcnt(0)" ::: "memory");
        } else {
            XB_SPIN(xb_ld(&bar[XB_XGEN(b.x)]) == gen, bar);
            __builtin_amdgcn_fence(__ATOMIC_ACQUIRE, "agent");
            asm volatile("s_waitcnt vmcnt(0)" ::: "memory");
        }
    }
    __syncthreads();
}


constexpr int NPH = 11;
constexpr size_t WS_BAR = WS_END + 4096 - (WS_END % 4096);
constexpr int BAR_BYTES = 65536;
constexpr int LDS_ST_OFF = LDS_BYTES - 16;
static_assert(WS_BAR + BAR_BYTES < 512 * MB && XCD_BAR_WORDS <= 4096 && (4096 + 80 * 64) * 4 <= BAR_BYTES, "barrier words");
__global__ void __launch_bounds__(NTHR, 2) mega(Params P) {
    extern __shared__ __attribute__((aligned(16))) unsigned char smem[];
    LAS unsigned char* lds = (LAS unsigned char*)smem;
    cg::grid_group grid = cg::this_grid();
    const Ctx& C = P;
    const int lo = P.ph_lo, hi = P.ph_hi; const int G = gridDim.x, bx = blockIdx.x;
    if (threadIdx.x < 4) ((LAS unsigned*)(lds + LDS_ST_OFF))[threadIdx.x] = 0u;
    __syncthreads();
    XcdBarrier bar = xcd_barrier_post((unsigned*)(P.ws + WS_BAR), (volatile LAS unsigned*)(lds + LDS_ST_OFF));
    if (lo < 0) grid.sync();
#define IN(k) (lo <= (k) && (k) < hi)
#ifndef REP_PHASE
#define REP_PHASE -1
#endif
#define REPEAT(k) for (int rep_ = 0; rep_ < ((REP_PHASE == (k)) ? 2 : 1); ++rep_, (REP_PHASE == (k) && rep_ == 1) ? xcd_barrier(bar) : (void)0)
#define SEAM(k) do { if (IN(k) && IN((k) + 1)) xcd_barrier(bar); } while (0)
    if (IN(0)) REPEAT(0) phase_prep(C, lds);
    SEAM(0);
#define P1_MEM() do { pg8::Gemm g{C.wsb(WS_MEMN), C.wsb(WS_WCKV), NMR, 2048, DM}; pg8::StaticOrder S; S.init(NMR, 2048, G, bx); \
          EpiMem E{C.out + OUT_MK, C.out + OUT_MV, C.wsb(WS_KB), C.wsb(WS_VT)}; pg8::gemm_phase<EpiMem, pg8::StaticOrder>(lds, g, S, E, nullptr); } while (0)
#define P1_BIG() do { pg8::Gemm g{C.wsb(WS_HN), C.wsb(WS_WIN), MP, NIN, DM}; pg8::StaticOrder S; S.init(MP, NIN, G, bx); \
        Epi1 E{C.Z(0), C.in[6], C.wsf(WS_LN)}; pg8::gemm_phase<Epi1, pg8::StaticOrder>(lds, g, S, E, nullptr); } while (0)
    if (IN(1)) {
        const int grp = (bx >> 3) & 3; SEpi1 SE{C.Z(0), C.in[6], C.wsf(WS_LN)};
        const int t0 = (G > 128) ? bx - 64 : bx, tstep = (G > 128) ? G - 64 : G; const bool tiles = (G <= 128) || bx >= 64;
        int t = t0, k = 0;
        if (tiles) for (; t < 768 && k < grp; t += tstep, ++k) sgemm_tile(C.wsb(WS_HN), C.wsb(WS_WIN), DM, NIN, t, lds, SE);
        if (grp & 1) { P1_MEM(); P1_BIG(); } else { P1_BIG(); P1_MEM(); }
        if (tiles) for (; t < 768; t += tstep) sgemm_tile(C.wsb(WS_HN), C.wsb(WS_WIN), DM, NIN, t, lds, SE);
    }
    SEAM(1);
    if (IN(2)) {
        unsigned rq[16], rk[16], rl[16], rv[16];
        if (bx < 1024) hg_load(C, bx, rq, rk, rl, rv);
        for (int it = bx; it < 1024; it += G) hg_intra(C, lds, it, it + G, rq, rk, rl, rv);
    }
    SEAM(2);
    if (IN(3)) REPEAT(3) {
        hg_scan(C);
        if ((bx >> 3) & 1) { for (int it = bx; it < 512; it += G) hg_sample_item(C, lds, it); for (int it = bx; it < 512; it += G) gmlp_item(C, lds, it); }
        else { for (int it = bx; it < 512; it += G) gmlp_item(C, lds, it); for (int it = bx; it < 512; it += G) hg_sample_item(C, lds, it); }
        for (int it = bx; it < 128; it += G) gmlp_sample_item(C, lds, it);
    }
    SEAM(3);
    if (IN(4)) REPEAT(4) hg_out(C, lds);
    SEAM(4);
    if (IN(5)) {
#define PBIG() do { pg8::Gemm g{C.wsb(WS_O), C.wsb(WS_WOUT), MP, DM, DM}; pg8::StaticOrder S; S.init(MP, DM, G, bx); EpiRes<false> E{C.in[0], C.wsb(WS_XB), C.wsf(WS_SS)}; pg8::gemm_phase<EpiRes<false>, pg8::StaticOrder>(lds, g, S, E, nullptr); } while (0)
#define PTILE() do { SEpiRes<false> SE{C.in[1] - (size_t)MP * 1024, C.wsb(WS_XB), C.wsf(WS_SS)}; for (int t = bx; t < 256; t += G) sgemm_tile(C.wsb(WS_O), C.wsb(WS_WOUT), DM, DM, t, lds, SE); } while (0)
        if ((bx >> 3) & 1) { PTILE(); PBIG(); } else { PBIG(); PTILE(); }
#undef PBIG
#undef PTILE
    }
    SEAM(5);
    if (IN(6)) {
#define PBIG() do { pg8::Gemm g{C.wsb(WS_XB), C.wsb(WS_WCQ), MP, DM, DM}; pg8::StaticOrder S; S.init(MP, DM, G, bx); EpiScale<0> E{C.wsb(WS_HQ), DM, C.wsf(WS_SS), 0.0625f}; pg8::gemm_phase<EpiScale<0>, pg8::StaticOrder>(lds, g, S, E, nullptr); } while (0)
#define PTILE() do { SEpiScale<0> SE{C.wsb(WS_HQ), DM, C.wsf(WS_SS), 0.0625f}; for (int t = bx; t < 256; t += G) sgemm_tile(C.wsb(WS_XB), C.wsb(WS_WCQ), DM, DM, t, lds, SE); } while (0)
        if ((bx >> 3) & 1) { PTILE(); PBIG(); } else { PBIG(); PTILE(); }
#undef PBIG
#undef PTILE
    }
    SEAM(6);
    if (IN(7)) REPEAT(7) {
        if ((bx >> 3) & 1) { for (int it = bx; it < 256; it += G) attn_sample_item(C, lds, it); for (int it = bx; it < 256; it += G) attn_prompt_item(C, lds, it); }
        else { for (int it = bx; it < 256; it += G) attn_prompt_item(C, lds, it); for (int it = bx; it < 256; it += G) attn_sample_item(C, lds, it); }
    }
    SEAM(7);
    if (IN(8)) {
#define PBIG() do { pg8::Gemm g{C.wsb(WS_CA), C.wsb(WS_WCO), MP, DM, DM}; pg8::StaticOrder S; S.init(MP, DM, G, bx); EpiRes<true> E{nullptr, C.wsb(WS_XB), C.wsf(WS_SS) + MT}; pg8::gemm_phase<EpiRes<true>, pg8::StaticOrder>(lds, g, S, E, nullptr); } while (0)
#define PTILE() do { SEpiRes<true> SE{nullptr, C.wsb(WS_XB), C.wsf(WS_SS) + MT}; for (int t = bx; t < 256; t += G) sgemm_tile(C.wsb(WS_CA), C.wsb(WS_WCO), DM, DM, t, lds, SE); } while (0)
        if ((bx >> 3) & 1) { PTILE(); PBIG(); } else { PBIG(); PTILE(); }
#undef PBIG
#undef PTILE
    }
    SEAM(8);
    if (IN(9)) {
        const int grp = (bx >> 3) & 3; SEpiScale<1> SE{C.wsb(WS_H), DFF, C.wsf(WS_SS) + MT, 1.0f};
        int t = bx, k = 0;
        for (; t < 1024 && k < grp; t += G, ++k) sgemm_tile(C.wsb(WS_XB), C.wsb(WS_WUP), DM, DFF, t, lds, SE);
        { pg8::Gemm g{C.wsb(WS_XB), C.wsb(WS_WUP), MP, DFF, DM}; pg8::StaticOrder S; S.init(MP, DFF, G, bx);
          EpiScale<1> E{C.wsb(WS_H), DFF, C.wsf(WS_SS) + MT, 1.0f}; pg8::gemm_phase<EpiScale<1>, pg8::StaticOrder>(lds, g, S, E, nullptr); }
        for (; t < 1024; t += G) sgemm_tile(C.wsb(WS_XB), C.wsb(WS_WUP), DM, DFF, t, lds, SE);
    }
    SEAM(9);
    if (IN(10)) { pg8::Gemm g{C.wsb(WS_H), C.wsb(WS_WDN), MP, DM, DFF}; pg8::StaticOrder S; S.init(MP, DM, G, bx);
        unsigned* pc = (unsigned*)(P.ws + WS_BAR) + 4096;
        EpiFinal E{C.wsb(WS_XB), C.out + OUT_YP, C.wsf(WS_SS) + 2 * MT, pc, C.in[24]}; pg8::gemm_phase<EpiFinal, pg8::StaticOrder>(lds, g, S, E, nullptr);
        SEpiFinal SE{C.wsb(WS_XB), C.out + OUT_YP, C.wsf(WS_SS) + 2 * MT, pc + 64 * 64, C.in[24]};
        for (int t = bx; t < 256; t += G) sgemm_tile(C.wsb(WS_H), C.wsb(WS_WDN), DFF, DM, t, lds, SE); }
#undef IN
#undef SEAM
}

#ifndef MULTI_LAUNCH
#define MULTI_LAUNCH 0
#endif
extern "C" void kernel_launch(void* const* d_in, const int* in_sizes, int n_in, void* d_out, int out_size, void* d_ws, size_t ws_size, hipStream_t stream) {
    static int grid = 0;
    if (grid == 0) {
        int dev = 0, cus = 0, per_cu = 0;
        (void)hipGetDevice(&dev);
        (void)hipDeviceGetAttribute(&cus, hipDeviceAttributeMultiprocessorCount, dev);
        if (hipFuncSetAttribute((const void*)mega, hipFuncAttributeMaxDynamicSharedMemorySize, LDS_BYTES) != hipSuccess) fprintf(stderr, "hipFuncSetAttribute failed\n");
        if (hipOccupancyMaxActiveBlocksPerMultiprocessor(&per_cu, (const void*)mega, NTHR, LDS_BYTES) != hipSuccess || per_cu < 1) { fprintf(stderr, "occupancy query: %d\n", per_cu); per_cu = 1; }
        (void)hipGetLastError();
        grid = cus * per_cu;
        if (grid <= 0) grid = 256;
    }
    Params p{};
    for (int i = 0; i < 25; ++i) p.in[i] = (const float*)d_in[i];
    p.out = (float*)d_out; p.ws = (unsigned char*)d_ws;
    (void)hipMemsetAsync((unsigned char*)d_ws + WS_BAR, 0, BAR_BYTES, stream);
#if MULTI_LAUNCH
    for (int ph = 0; ph < NPH; ++ph) { p.ph_lo = ph; p.ph_hi = ph + 1; hipLaunchKernelGGL(mega, dim3(grid), dim3(NTHR), LDS_BYTES, stream, p); }
#else
    p.ph_lo = 0; p.ph_hi = NPH;
    void* args[] = {&p};
    hipError_t e = hipLaunchCooperativeKernel((const void*)mega, dim3(grid), dim3(NTHR), args, LDS_BYTES, stream);
    if (e != hipSuccess) fprintf(stderr, "cooperative launch failed: %s (grid %d)\n", hipGetErrorString(e), grid);
#endif
}
```

```cpp
#include <hip/hip_runtime.h>
#include <hip/hip_cooperative_groups.h>
#include <cstdio>
namespace cg = cooperative_groups;
namespace pg8 {
#define PG8_LAS __attribute__((address_space(3)))
typedef unsigned short bf16_t;
typedef short bf16x8 __attribute__((ext_vector_type(8)));
typedef float f32x4 __attribute__((ext_vector_type(4)));
typedef unsigned u32x4 __attribute__((ext_vector_type(4)));
constexpr int BM = 256, BK = 64, HALF = 128, HTB = HALF * BK * 2  , STAGE_BYTES = 8 * HTB, NXCD = 8, WGM = 8;

__host__ __device__ __forceinline__ int lds_byte(int r, int c) { const int st = (r >> 4) * 2 + (c >> 5), rr = r & 15, cc = c & 31, ob = rr * 64 + cc * 2; return st * 1024 + (ob ^ (((ob >> 9) & 1) << 5)); }
__host__ __device__ __forceinline__ void stage_rc(int b, int& R, int& C) { const int st = b / 1024, sb = b % 1024, swz = sb ^ (((sb >> 9) & 1) << 5); R = (st >> 1) * 16 + swz / 64; C = (st & 1) * 32 + (swz % 64) / 2; }
__host__ __device__ __forceinline__ int perm32(int rho) { const int n = rho >> 4, i = rho & 15; return 8 * (i >> 2) + 4 * n + (i & 3); }

struct Unit { int pm, pn; };
struct Gemm { const bf16_t* A; const bf16_t* Bt; int M, N, K; };

struct StaticOrder {
    int nM, nN, nwg, G, c;
    __host__ __device__ void init(int M, int N, int G_, int c_) { nM = M / BM; nN = N / BM; nwg = nM * nN; G = G_; c = c_; }
    __host__ __device__ bool next(int i, Unit& u) const {
        const long L = (long)i * G + c; if (L >= nwg) return false;
        int wgid = (int)L; { const int q = nwg / NXCD, r = nwg % NXCD, xcd = wgid % NXCD, off = wgid / NXCD; wgid = (xcd < r ? xcd * (q + 1) : r * (q + 1) + (xcd - r) * q) + off; }
        const int nig = WGM * nN, gid = wgid / nig, fm = gid * WGM, gsz = (nM - fm) < WGM ? (nM - fm) : WGM;
        u.pm = fm + ((wgid % nig) % gsz); u.pn = (wgid % nig) / gsz; return true;
    }
    __device__ __forceinline__ void a_ready(const Unit&) const {}
    __device__ __forceinline__ void done(const Unit&) const {}
};
template <class Epi, class Sched, bool STAMP = false>
__device__ __forceinline__ void gemm_phase(PG8_LAS unsigned char* lds, const Gemm g, const Sched& S, const Epi& E, unsigned long long* stamps) {
    const int tid = threadIdx.x, wid = __builtin_amdgcn_readfirstlane(tid >> 6), lane = tid & 63, wr = wid >> 2, wc = wid & 3, fr = lane & 15, fq = lane >> 4;
    const int K = g.K, nt = K / BK;
    int ts_lo = 0, ts_hi = 0, nts = 0; const unsigned long long rt_entry = STAMP ? (unsigned long long)wall_clock64() : 0ull;
#define PG8_STAMP() do { if (STAMP && wid == 0 && nts < 64) { const unsigned long long _c = (unsigned long long)clock64(); \
        ts_lo = (lane == nts) ? (int)(unsigned)_c : ts_lo; ts_hi = (lane == nts) ? (int)(unsigned)(_c >> 32) : ts_hi; ++nts; } } while (0)
    PG8_STAMP();
    unsigned voffA[2], voffB[2];
#pragma unroll
    for (int i = 0; i < 2; ++i) { int R, C; stage_rc(tid * 16 + i * 8192, R, C); const int Rb = Epi::PERM ? ((R & ~31) + perm32(R & 31)) : R;
        voffA[i] = (unsigned)(R * K + C) * 2u; voffB[i] = (unsigned)(Rb * K + C) * 2u; }
    const size_t kstep = (size_t)(BK * 2);
    const size_t hstep = (size_t)HALF * K * 2;
    const size_t tstep = 2 * hstep;
    const unsigned ldsw = (unsigned)wid * 1024u;
    const int aoff = lds_byte(wr * 64 + fr, fq * 8), boff = lds_byte(wc * 32 + fr, fq * 8);
#define PG8_SA(b, h) (((b) * 2 + (h)) * HTB)
#define PG8_SB(b, h) ((4 + (b) * 2 + (h)) * HTB)
#define PG8_STAGE(bufoff, gbase, voff) do { _Pragma("unroll") for (int _i = 0; _i < 2; ++_i) \
        __builtin_amdgcn_global_load_lds((const unsigned*)((const char*)(gbase) + (voff)[_i]), (PG8_LAS unsigned*)(lds + (bufoff) + ldsw + _i * 8192), 16, 0, 0); } while (0)
#define PG8_LDA(dst, b, h) do { _Pragma("unroll") for (int m = 0; m < 4; ++m) _Pragma("unroll") for (int k = 0; k < 2; ++k) dst[m][k] = *(const PG8_LAS bf16x8*)(lds + PG8_SA(b, h) + aoff + m * 2048 + k * 1024); } while (0)
#define PG8_LDB(dst, b, h) do { _Pragma("unroll") for (int n = 0; n < 2; ++n) _Pragma("unroll") for (int k = 0; k < 2; ++k) dst[n][k] = *(const PG8_LAS bf16x8*)(lds + PG8_SB(b, h) + boff + n * 2048 + k * 1024); } while (0)
#define PG8_MMA(ai, bj, At, Bt) do { __builtin_amdgcn_s_setprio(1); _Pragma("unroll") for (int m = 0; m < 4; ++m) _Pragma("unroll") for (int n = 0; n < 2; ++n) _Pragma("unroll") for (int k = 0; k < 2; ++k) \
        acc[ai][bj][m][n] = __builtin_amdgcn_mfma_f32_16x16x32_bf16(Bt[n][k], At[m][k], acc[ai][bj][m][n], 0, 0, 0); __builtin_amdgcn_s_setprio(0); } while (0)
#define PG8_WAIT_V(n) asm volatile("s_waitcnt vmcnt(" #n ")" ::: "memory")
#define PG8_WAIT_L(n) asm volatile("s_waitcnt lgkmcnt(" #n ")" ::: "memory")
#define PG8_BAR __builtin_amdgcn_s_barrier()
#define PG8_SCHED __builtin_amdgcn_sched_barrier(0)
    Unit cur, nxt; int ui = 0;
    if (!S.next(0, cur)) return;
    f32x4 acc[2][2][4][2];
#pragma unroll
    for (int a = 0; a < 2; ++a)
#pragma unroll
        for (int b = 0; b < 2; ++b)
#pragma unroll
            for (int m = 0; m < 4; ++m)
#pragma unroll
                for (int n = 0; n < 2; ++n) acc[a][b][m][n] = (f32x4){0.f, 0.f, 0.f, 0.f};
    bf16x8 At[4][2], B0[2][2], B1[2][2];
    const char* cA = (const char*)g.A + (size_t)cur.pm * tstep; const char* cB = (const char*)g.Bt + (size_t)cur.pn * tstep;
    S.a_ready(cur);
    PG8_STAGE(PG8_SB(0, 0), cB, voffB); PG8_STAGE(PG8_SA(0, 0), cA, voffA); PG8_STAGE(PG8_SB(0, 1), cB + hstep, voffB); PG8_STAGE(PG8_SA(0, 1), cA + hstep, voffA);
    if (wr == 1) PG8_BAR;
    PG8_WAIT_V(4); PG8_BAR;
    PG8_STAGE(PG8_SB(1, 0), cB + kstep, voffB); PG8_STAGE(PG8_SA(1, 0), cA + kstep, voffA); PG8_STAGE(PG8_SB(1, 1), cB + hstep + kstep, voffB);
    PG8_WAIT_V(6); PG8_BAR;
    PG8_STAMP();
    for (;;) {
        const bool has_next = S.next(ui + 1, nxt);
        const char* nA = has_next ? (const char*)g.A + (size_t)nxt.pm * tstep : cA; const char* nB = has_next ? (const char*)g.Bt + (size_t)nxt.pn * tstep : cB;
        for (int t = 0; t < nt; t += 2) {
            const bool last = (t == nt - 2);
            const char* a1 = cA + (size_t)(t + 1) * kstep;
            const char* a2 = last ? nA : cA + (size_t)(t + 2) * kstep; const char* b2 = last ? nB : cB + (size_t)(t + 2) * kstep;
            const char* a3 = a2 + kstep; const char* b3 = b2 + kstep;
            if (last && has_next) S.a_ready(nxt);
            PG8_LDB(B0, 0, 0); PG8_SCHED; PG8_LDA(At, 0, 0); PG8_STAGE(PG8_SA(1, 1), a1 + hstep, voffA);
            PG8_WAIT_L(8); PG8_BAR; PG8_WAIT_L(0); PG8_MMA(0, 0, At, B0); PG8_BAR; PG8_SCHED;
            PG8_LDB(B1, 0, 1); PG8_STAGE(PG8_SB(0, 0), b2, voffB);
            PG8_BAR; PG8_WAIT_L(0); PG8_MMA(0, 1, At, B1); PG8_BAR;
            PG8_LDA(At, 0, 1); PG8_STAGE(PG8_SA(0, 0), a2, voffA);
            PG8_BAR; PG8_WAIT_L(0); PG8_MMA(1, 0, At, B0); PG8_BAR; PG8_SCHED;
            PG8_STAGE(PG8_SB(0, 1), b2 + hstep, voffB);
            PG8_WAIT_V(6); PG8_BAR; PG8_MMA(1, 1, At, B1); PG8_BAR;
            PG8_LDB(B0, 1, 0); PG8_SCHED; PG8_LDA(At, 1, 0); PG8_STAGE(PG8_SA(0, 1), a2 + hstep, voffA);
            PG8_WAIT_L(8); PG8_BAR; PG8_WAIT_L(0); PG8_MMA(0, 0, At, B0); PG8_BAR; PG8_SCHED;
            PG8_LDB(B1, 1, 1); PG8_STAGE(PG8_SB(1, 0), b3, voffB);
            PG8_BAR; PG8_WAIT_L(0); PG8_MMA(0, 1, At, B1); PG8_BAR;
            PG8_LDA(At, 1, 1); PG8_STAGE(PG8_SA(1, 0), a3, voffA);
            PG8_BAR; PG8_WAIT_L(0); PG8_MMA(1, 0, At, B0); PG8_BAR; PG8_SCHED;
            PG8_STAGE(PG8_SB(1, 1), b3 + hstep, voffB);
            PG8_WAIT_V(6); PG8_BAR; PG8_MMA(1, 1, At, B1); PG8_BAR;
        }
        PG8_STAMP();
        if constexpr (!Epi::AFTER_DRAIN) { E(acc, cur, wr, wc, fr, fq); S.done(cur); }
        PG8_STAMP();
        if (!has_next) break;
#pragma unroll
        for (int a = 0; a < 2; ++a)
#pragma unroll
            for (int b = 0; b < 2; ++b)
#pragma unroll
                for (int m = 0; m < 4; ++m)
#pragma unroll
                    for (int n = 0; n < 2; ++n) acc[a][b][m][n] = (f32x4){0.f, 0.f, 0.f, 0.f};
        cur = nxt; cA = nA; cB = nB; ++ui;
    }
    PG8_WAIT_V(0);
    if (wr == 0) PG8_BAR;
    PG8_BAR;
    if constexpr (Epi::AFTER_DRAIN) { E.fused(acc, cur, wr, wc, fr, fq, lds, wid, lane); S.done(cur); }
    PG8_STAMP();
    if (STAMP && wid == 0) { stamps[lane] = lane < nts ? (((unsigned long long)(unsigned)ts_hi << 32) | (unsigned)ts_lo) : 0ull;
        if (lane == 62) stamps[62] = rt_entry; if (lane == 63) stamps[63] = (unsigned long long)wall_clock64(); }
#undef PG8_STAMP
#undef PG8_SA
#undef PG8_SB
#undef PG8_STAGE
#undef PG8_LDA
#undef PG8_LDB
#undef PG8_MMA
#undef PG8_WAIT_V
#undef PG8_WAIT_L
#undef PG8_BAR
#undef PG8_SCHED
}
}

#define LAS __attribute__((address_space(3)))
using pg8::bf16_t; using pg8::bf16x8; using pg8::f32x4; using pg8::u32x4;
typedef unsigned u32x2 __attribute__((ext_vector_type(2)));
constexpr int DM = 1024, MP = 16384, MS = 512, MT = MP + MS, NMR = 2048, DFF = 4096, NIN = 3072;
constexpr float EPS = 1e-6f;
constexpr int NTHR = 512;
constexpr int LDS_BYTES = 144 * 1024;
constexpr size_t MB = 1024 * 1024;
constexpr size_t WS_WIN = 0, WS_WOUT = 6 * MB, WS_WCQ = 8 * MB, WS_WCKV = 10 * MB, WS_WCO = 14 * MB, WS_WUP = 16 * MB, WS_WDN = 24 * MB;
constexpr size_t WS_HN = 32 * MB;
constexpr size_t SZ_ROWB = (size_t)MT * DM * 2;
constexpr size_t WS_Z = WS_HN + SZ_ROWB;
constexpr size_t ZSZ = (size_t)MT * 512;
constexpr size_t WS_H = WS_HN;
constexpr size_t WS_C = WS_Z + 8 * ZSZ * 2;
constexpr size_t WS_MEMN = WS_C, WS_KB = WS_C + 4 * MB, WS_VT = WS_C + 8 * MB;
constexpr size_t WS_D = WS_C + 12 * MB;
constexpr size_t WS_DS = WS_D, WS_SC = WS_D + 32 * MB, WS_OI = WS_D + 64 * MB, WS_DEC = WS_D + 80 * MB;
constexpr size_t WS_HQ = WS_D, WS_CA = WS_D + 36 * MB;
constexpr size_t WS_E = WS_D + 81 * MB;
constexpr size_t WS_O = WS_E, WS_X1 = WS_O + SZ_ROWB, WS_XB = WS_X1 + 2 * SZ_ROWB, WS_SS = WS_XB + SZ_ROWB, WS_LN = WS_SS + 3 * MT * 4, WS_END = WS_LN + 2 * MT * 4;
static_assert(SZ_ROWB * 4 >= (size_t)MT * DFF * 2 && WS_END < 512 * MB, "workspace map");
constexpr size_t OUT_YP = 0, OUT_YS = 16777216, OUT_SP = 17301504, OUT_SSMP = 17825792, OUT_MK = 26214400, OUT_MV = 28311552, OUT_CMV = 30408704;

struct Params { const float* in[25]; float* out; unsigned char* ws; int ph_lo, ph_hi;
    __device__ __forceinline__ bf16_t* wsb(size_t off) const { return (bf16_t*)(ws + off); }
    __device__ __forceinline__ float* wsf(size_t off) const { return (float*)(ws + off); }
    __device__ __forceinline__ bf16_t* Z(int a) const { return (bf16_t*)(ws + WS_Z) + (size_t)a * ZSZ; }
};
typedef Params Ctx;


__device__ __forceinline__ float bf2f(bf16_t b) { return __uint_as_float(((unsigned)b) << 16); }
typedef float f32x2c __attribute__((ext_vector_type(2)));
typedef __bf16 bf16x2c __attribute__((ext_vector_type(2)));
__device__ __forceinline__ unsigned pk2(float lo, float hi) { const f32x2c v = {lo, hi}; const bf16x2c b = __builtin_convertvector(v, bf16x2c); return __builtin_bit_cast(unsigned, b); }
__device__ __forceinline__ bf16_t f2bf(float f) { return (bf16_t)(pk2(f, f) & 0xffffu); }
__device__ __forceinline__ float sigm(float x) { return __builtin_amdgcn_rcpf(1.0f + __expf(-x)); }
__device__ __forceinline__ float bflo(unsigned w) { return __uint_as_float(w << 16); }
__device__ __forceinline__ float bfhi(unsigned w) { return __uint_as_float(w & 0xffff0000u); }

struct Epi1 {
    static constexpr bool PERM = true, AFTER_DRAIN = false;
    bf16_t* Zb; const float* lbp; float* ln;
    __device__ __forceinline__ void operator()(const f32x4 (&acc)[2][2][4][2], const pg8::Unit& u, int wr, int wc, int fr, int fq) const {
        const int sec = u.pn >> 1;
        const int row0 = u.pm * 256 + wr * 64 + fr;
        const int cs0 = (u.pn & 1) * 256 + wc * 32 + 8 * fq;
        if (sec == 1) {
            bf16_t* Zk = Zb + ZSZ; bf16_t* Zl = Zb + 2 * ZSZ;
            f32x4 pp[2][4];
#pragma unroll
            for (int bj = 0; bj < 2; ++bj) { const int cs = cs0 + bj * 128; pp[bj][0] = *(const f32x4*)(lbp + cs); pp[bj][1] = *(const f32x4*)(lbp + cs + 4); pp[bj][2] = *(const f32x4*)(lbp + 512 + cs); pp[bj][3] = *(const f32x4*)(lbp + 512 + cs + 4); }
#pragma unroll
            for (int bj = 0; bj < 2; ++bj) {
                const int cs = cs0 + bj * 128;
                const f32x4 p0a = pp[bj][0], p0b = pp[bj][1], p1a = pp[bj][2], p1b = pp[bj][3];
                float lb[8];
#pragma unroll
                for (int j = 0; j < 4; ++j) { lb[j] = sigm(p0a[j] - p1a[j]); lb[4 + j] = sigm(p0b[j] - p1b[j]); }
#pragma unroll
                for (int ai = 0; ai < 2; ++ai)
#pragma unroll
                    for (int m = 0; m < 4; ++m) {
                        const size_t o = (size_t)(row0 + ai * 128 + m * 16) * 512 + cs;
                        float kk[8], lf[8];
#pragma unroll
                        for (int j = 0; j < 8; ++j) { const float z = (j < 4) ? acc[ai][bj][m][0][j] : acc[ai][bj][m][1][j - 4];
                            const float sg = sigm(z), oml = 1.0f - lb[j]; kk[j] = oml * (1.0f - sg); lf[j] = __logf(lb[j] + oml * sg); }
                        u32x4 w; w.x = pk2(kk[0], kk[1]); w.y = pk2(kk[2], kk[3]); w.z = pk2(kk[4], kk[5]); w.w = pk2(kk[6], kk[7]);
                        *(u32x4*)(Zk + o) = w;
                        w.x = pk2(lf[0], lf[1]); w.y = pk2(lf[2], lf[3]); w.z = pk2(lf[4], lf[5]); w.w = pk2(lf[6], lf[7]);
                        *(u32x4*)(Zl + o) = w;
                    }
            }
        } else {
            bf16_t* Zo = Zb + (size_t)(sec == 0 ? 0 : sec + 1) * ZSZ;
            float l1[2][4], l2[2][4];
#pragma unroll
            for (int ai = 0; ai < 2; ++ai)
#pragma unroll
                for (int m = 0; m < 4; ++m) { l1[ai][m] = 0.f; l2[ai][m] = 0.f; }
#pragma unroll
            for (int bj = 0; bj < 2; ++bj) {
                const int cs = cs0 + bj * 128;
#pragma unroll
                for (int ai = 0; ai < 2; ++ai)
#pragma unroll
                    for (int m = 0; m < 4; ++m) {
                        const size_t o = (size_t)(row0 + ai * 128 + m * 16) * 512 + cs;
                        float r[8];
#pragma unroll
                        for (int j = 0; j < 8; ++j) { const float z = (j < 4) ? acc[ai][bj][m][0][j] : acc[ai][bj][m][1][j - 4];
                            const float t = (sec >= 4) ? 1.5957691216f * (z + 0.044715f * z * z * z) : z;
                            const float sg = sigm(t);
                            r[j] = (sec == 2) ? z : ((sec == 3) ? sg : z * sg); }
                        u32x4 w; w.x = pk2(r[0], r[1]); w.y = pk2(r[2], r[3]); w.z = pk2(r[4], r[5]); w.w = pk2(r[6], r[7]);
                        *(u32x4*)(Zo + o) = w;
                        if (sec == 5) {
#pragma unroll
                            for (int j = 0; j < 8; ++j) { l1[ai][m] += r[j]; l2[ai][m] += r[j] * r[j]; } }
                    }
            }
            if (sec == 5) {
#pragma unroll
                for (int ai = 0; ai < 2; ++ai)
#pragma unroll
                    for (int m = 0; m < 4; ++m) { float a = l1[ai][m], b = l2[ai][m];
                        a += __shfl_xor(a, 16); b += __shfl_xor(b, 16); a += __shfl_xor(a, 32); b += __shfl_xor(b, 32);
                        if (fq == 0) { const int row = row0 + ai * 128 + m * 16; atomicAdd(ln + row, a); atomicAdd(ln + MT + row, b); } }
            }
        }
    }
};

struct EpiMem {
    static constexpr bool PERM = false, AFTER_DRAIN = false;
    float* outK; float* outV; bf16_t* KB; bf16_t* VT;
    __device__ __forceinline__ void operator()(const f32x4 (&acc)[2][2][4][2], const pg8::Unit& u, int wr, int wc, int fr, int fq) const {
        const int row0 = u.pm * 256 + wr * 64 + fr;
        const bool isV = u.pn >= 4;
        const int col0 = (u.pn & 3) * 256 + wc * 32 + 4 * fq;
        float* outp = isV ? outV : outK;
#pragma unroll
        for (int ai = 0; ai < 2; ++ai)
#pragma unroll
            for (int m = 0; m < 4; ++m) {
                const int row = row0 + ai * 128 + m * 16;
#pragma unroll
                for (int bj = 0; bj < 2; ++bj)
#pragma unroll
                    for (int n = 0; n < 2; ++n) {
                        const int c = col0 + bj * 128 + n * 16; const f32x4 v = acc[ai][bj][m][n];
                        *(f32x4*)(outp + (size_t)row * 1024 + c) = v;
                        if (!isV) { u32x2 w; w.x = pk2(v[0], v[1]); w.y = pk2(v[2], v[3]); *(u32x2*)(KB + (size_t)row * 1024 + c) = w; }
                        else { const int b = row >> 8, mm = row & 255;
#pragma unroll
                            for (int j = 0; j < 4; ++j) VT[((size_t)b * 1024 + c + j) * 256 + mm] = f2bf(v[j]); }
                    }
            }
    }
};

template <bool RB> struct EpiRes {
    static constexpr bool PERM = false, AFTER_DRAIN = false;
    const float* resf; bf16_t* xb; float* ss;
    __device__ __forceinline__ void operator()(const f32x4 (&acc)[2][2][4][2], const pg8::Unit& u, int wr, int wc, int fr, int fq) const {
        const int row0 = u.pm * 256 + wr * 64 + fr, col0 = u.pn * 256 + wc * 32 + 4 * fq;
#pragma unroll
        for (int ai = 0; ai < 2; ++ai) {
            f32x4 rv[4][2][2];
#pragma unroll
            for (int m = 0; m < 4; ++m)
#pragma unroll
                for (int bj = 0; bj < 2; ++bj)
#pragma unroll
                    for (int n = 0; n < 2; ++n) { const size_t oo = (size_t)(row0 + ai * 128 + m * 16) * 1024 + col0 + bj * 128 + n * 16;
                        if (RB) { const u32x2 rr = *(const u32x2*)(xb + oo); rv[m][bj][n] = (f32x4){bflo(rr.x), bfhi(rr.x), bflo(rr.y), bfhi(rr.y)}; }
                        else rv[m][bj][n] = *(const f32x4*)(resf + oo); }
#pragma unroll
            for (int m = 0; m < 4; ++m) {
                const int row = row0 + ai * 128 + m * 16; const size_t o = (size_t)row * 1024 + col0; float s = 0.f;
#pragma unroll
                for (int bj = 0; bj < 2; ++bj)
#pragma unroll
                    for (int n = 0; n < 2; ++n) {
                        const size_t oo = o + bj * 128 + n * 16; const f32x4 v = rv[m][bj][n] + acc[ai][bj][m][n];
                        u32x2 w; w.x = pk2(v[0], v[1]); w.y = pk2(v[2], v[3]); *(u32x2*)(xb + oo) = w;
                        s += (v[0] * v[0] + v[1] * v[1]) + (v[2] * v[2] + v[3] * v[3]);
                    }
                s += __shfl_xor(s, 16); s += __shfl_xor(s, 32);
                if (fq == 0) atomicAdd(ss + row, s);
            }
        }
    }
};

template <int ACT> struct EpiScale {
    static constexpr bool PERM = true, AFTER_DRAIN = false;
    bf16_t* O; int ldc; const float* ss; float scale;
    __device__ __forceinline__ void operator()(const f32x4 (&acc)[2][2][4][2], const pg8::Unit& u, int wr, int wc, int fr, int fq) const {
        const int row0 = u.pm * 256 + wr * 64 + fr, col0 = u.pn * 256 + wc * 32 + 8 * fq;
        float ssv[2][4];
#pragma unroll
        for (int ai = 0; ai < 2; ++ai)
#pragma unroll
            for (int m = 0; m < 4; ++m) ssv[ai][m] = ss[row0 + ai * 128 + m * 16];
#pragma unroll
        for (int ai = 0; ai < 2; ++ai)
#pragma unroll
            for (int m = 0; m < 4; ++m) {
                const int row = row0 + ai * 128 + m * 16;
                const float rs = rsqrtf(ssv[ai][m] * (1.0f / 1024.0f) + EPS) * scale;
                bf16_t* rowp = O + (size_t)row * ldc + col0;
#pragma unroll
                for (int bj = 0; bj < 2; ++bj) {
                    f32x4 v0 = acc[ai][bj][m][0] * rs, v1 = acc[ai][bj][m][1] * rs;
                    if (ACT == 1) {
#pragma unroll
                        for (int j = 0; j < 4; ++j) { const float a = fmaxf(v0[j], 0.f), b = fmaxf(v1[j], 0.f); v0[j] = a * a; v1[j] = b * b; } }
                    u32x4 w; w.x = pk2(v0[0], v0[1]); w.y = pk2(v0[2], v0[3]); w.z = pk2(v1[0], v1[1]); w.w = pk2(v1[2], v1[3]);
                    *(u32x4*)(rowp + bj * 128) = w;
                }
            }
    }
};

struct WDesc { const float* W; const float* gain; bf16_t* Wt; int K, N, t; };
__device__ __forceinline__ WDesc wdesc(const Ctx& C, int t) {
    WDesc d;
    if (t < 768) d = WDesc{C.in[8], nullptr, C.wsb(WS_WIN), 1024, 3072, t};
    else if (t < 1024) d = WDesc{C.in[14], nullptr, C.wsb(WS_WOUT), 1024, 1024, t - 768};
    else if (t < 1280) d = WDesc{C.in[17], C.in[15], C.wsb(WS_WCQ), 1024, 1024, t - 1024};
    else if (t < 1536) d = WDesc{C.in[18], nullptr, C.wsb(WS_WCKV), 1024, 1024, t - 1280};
    else if (t < 1792) d = WDesc{C.in[19], nullptr, C.wsb(WS_WCKV) + 1024 * 1024, 1024, 1024, t - 1536};
    else if (t < 2048) d = WDesc{C.in[20], nullptr, C.wsb(WS_WCO), 1024, 1024, t - 1792};
    else if (t < 3072) d = WDesc{C.in[22], C.in[21], C.wsb(WS_WUP), 1024, 4096, t - 2048};
    else d = WDesc{C.in[23], nullptr, C.wsb(WS_WDN), 4096, 1024, t - 3072};
    return d;
}
__device__ __forceinline__ void cvt_load(const WDesc& d, f32x4 (&v)[2], float (&gq)[2]) {
    const int tid = threadIdx.x; const int ntn = d.N >> 6; const int kt = d.t / ntn, nt = d.t - kt * ntn; const int k0 = kt * 64, n0 = nt * 64;
#pragma unroll
    for (int p = 0; p < 2; ++p) { const int k = p * 32 + (tid >> 4), n4 = (tid & 15) * 4;
        v[p] = *(const f32x4*)(d.W + (size_t)(k0 + k) * d.N + n0 + n4); gq[p] = d.gain ? d.gain[k0 + k] : 1.0f; }
}
__device__ __forceinline__ void cvt_store(const WDesc& d, const f32x4 (&v)[2], const float (&gq)[2], LAS float* tl) {
    const int tid = threadIdx.x; const int ntn = d.N >> 6; const int kt = d.t / ntn, nt = d.t - kt * ntn; const int k0 = kt * 64, n0 = nt * 64;
#pragma unroll
    for (int p = 0; p < 2; ++p) { const int k = p * 32 + (tid >> 4), n4 = (tid & 15) * 4; const f32x4 x = v[p] * gq[p];
        tl[k * 65 + n4 + 0] = x[0]; tl[k * 65 + n4 + 1] = x[1]; tl[k * 65 + n4 + 2] = x[2]; tl[k * 65 + n4 + 3] = x[3]; }
    __syncthreads();
    {
        const int n = tid >> 3, k8 = (tid & 7) * 8; float r[8];
#pragma unroll
        for (int j = 0; j < 8; ++j) r[j] = tl[(k8 + j) * 65 + n];
        u32x4 w; w.x = pk2(r[0], r[1]); w.y = pk2(r[2], r[3]); w.z = pk2(r[4], r[5]); w.w = pk2(r[6], r[7]);
        *(u32x4*)(d.Wt + (size_t)(n0 + n) * d.K + k0 + k8) = w;
    }
    __syncthreads();
}

__device__ __forceinline__ void phase_prep(const Ctx& C, LAS unsigned char* lds) {
    const int tid = threadIdx.x, lane = tid & 63, wid = tid >> 6;
    LAS float* tl = (LAS float*)lds;
    {
        int t = blockIdx.x; WDesc d = wdesc(C, t < 4096 ? t : 0); f32x4 v[2]; float gq[2];
        if (t < 4096) cvt_load(d, v, gq);
        for (; t < 4096; t += gridDim.x) {
            const int tn = t + gridDim.x; WDesc dn = wdesc(C, tn < 4096 ? tn : 0); f32x4 vn[2]; float gn[2];
            if (tn < 4096) cvt_load(dn, vn, gn); else { vn[0] = v[0]; vn[1] = v[1]; gn[0] = gq[0]; gn[1] = gq[1]; }
            cvt_store(d, v, gq, tl);
            d = dn; v[0] = vn[0]; v[1] = vn[1]; gq[0] = gn[0]; gq[1] = gn[1];
        }
    }
    {
        const int NR = MT + NMR, stride = gridDim.x * 8; int r = blockIdx.x * 8 + wid;
        f32x4 v[4];
#define ROWSRC(rr) ((rr) < MP ? C.in[0] + (size_t)(rr) * 1024 : ((rr) < MT ? C.in[1] + (size_t)((rr) - MP) * 1024 : C.in[2] + (size_t)((rr) - MT) * 1024))
        if (r < NR) { const float* src = ROWSRC(r);
#pragma unroll
            for (int i = 0; i < 4; ++i) v[i] = *(const f32x4*)(src + i * 256 + lane * 4); }
        for (; r < NR; r += stride) {
            const int rn = r + stride; f32x4 vn[4];
            if (rn < NR) { const float* src = ROWSRC(rn);
#pragma unroll
                for (int i = 0; i < 4; ++i) vn[i] = *(const f32x4*)(src + i * 256 + lane * 4); }
            else {
#pragma unroll
                for (int i = 0; i < 4; ++i) vn[i] = v[i]; }
            const float* g = (r < MT) ? C.in[7] : C.in[16]; bf16_t* dst = (r < MT) ? C.wsb(WS_HN) + (size_t)r * 1024 : C.wsb(WS_MEMN) + (size_t)(r - MT) * 1024;
            f32x4 gg[4];
#pragma unroll
            for (int i = 0; i < 4; ++i) gg[i] = *(const f32x4*)(g + i * 256 + lane * 4);
            float s = 0.f;
#pragma unroll
            for (int i = 0; i < 4; ++i) s += (v[i][0] * v[i][0] + v[i][1] * v[i][1]) + (v[i][2] * v[i][2] + v[i][3] * v[i][3]);
#pragma unroll
            for (int o = 32; o >= 1; o >>= 1) s += __shfl_xor(s, o);
            const float rs = rsqrtf(s * (1.0f / 1024.0f) + EPS);
#pragma unroll
            for (int i = 0; i < 4; ++i) { const f32x4 y = v[i] * rs * gg[i]; u32x2 w; w.x = pk2(y[0], y[1]); w.y = pk2(y[2], y[3]); *(u32x2*)(dst + i * 256 + lane * 4) = w; }
#pragma unroll
            for (int i = 0; i < 4; ++i) v[i] = vn[i];
        }
#undef ROWSRC
    }
    float* ss = C.wsf(WS_SS);
    for (int i = blockIdx.x * NTHR + tid; i < 5 * MT; i += gridDim.x * NTHR) ss[i] = 0.f;
}

__device__ __forceinline__ bf16x8 ld8(const LAS bf16_t* p) { return *(const LAS bf16x8*)p; }
__device__ __forceinline__ bf16x8 gld8(const bf16_t* p) { return *(const bf16x8*)p; }
#define MFMA16(a, b, c) __builtin_amdgcn_mfma_f32_16x16x32_bf16((a), (b), (c), 0, 0, 0)

__device__ __forceinline__ void hg_load(const Ctx& C, int item, unsigned (&rq)[16], unsigned (&rk)[16], unsigned (&rl)[16], unsigned (&rv)[16]) {
    const int tid = threadIdx.x; const int b = item >> 7, c = (item >> 2) & 31, h = item & 3; const int k = tid & 127, i = tid >> 7;
    const size_t o = ((size_t)b * 2048 + c * 64 + 16 * i) * 512 + h * 128 + k;
    const bf16_t* pq = C.Z(0) + o; const bf16_t* pk = C.Z(1) + o; const bf16_t* pl = C.Z(2) + o; const bf16_t* pv = C.Z(3) + o;
#pragma unroll
    for (int t = 0; t < 16; ++t) { rq[t] = pq[t * 512]; rk[t] = pk[t * 512]; rl[t] = pl[t * 512]; rv[t] = pv[t * 512]; }
}
__device__ __forceinline__ void hg_intra(const Ctx& C, LAS unsigned char* lds, int item, int next_item, unsigned (&rq)[16], unsigned (&rk)[16], unsigned (&rl)[16], unsigned (&rv)[16]) {
    const int tid = threadIdx.x, lane = tid & 63, wid = tid >> 6, r = lane & 15, qd = lane >> 4;
    const int b = item >> 7, c = (item >> 2) & 31, h = item & 3;
    const size_t row0 = (size_t)b * 2048 + c * 64; const int hc = h * 128;
    LAS bf16_t* sQV = (LAS bf16_t*)lds;
    LAS bf16_t* sKE = sQV + 7 * 2176;
    LAS bf16_t* sKD = sKE + 3 * 2176;
    LAS bf16_t* sKT = sKD + 4 * 2176;
    LAS bf16_t* sVT = sKT + 128 * 72;
    LAS bf16_t* sA = sVT + 128 * 72;
    LAS float* sTot = (LAS float*)(sA + 64 * 72);
    const int k = tid & 127, i = tid >> 7;
    float q[16], kk[16], bl[16];
    {
        float lf[16]; unsigned vv[16];
#pragma unroll
        for (int t = 0; t < 16; ++t) { q[t] = __uint_as_float(rq[t] << 16); kk[t] = __uint_as_float(rk[t] << 16); lf[t] = __uint_as_float(rl[t] << 16); vv[t] = rv[t]; }
        if (next_item < 1024) hg_load(C, next_item, rq, rk, rl, rv);
        float cum = 0.f;
#pragma unroll
        for (int t = 0; t < 16; ++t) { cum += lf[t]; bl[t] = cum; }
        sTot[i * 128 + k] = cum;
        u32x4 w0, w1;
        w0.x = vv[0] | (vv[1] << 16); w0.y = vv[2] | (vv[3] << 16); w0.z = vv[4] | (vv[5] << 16); w0.w = vv[6] | (vv[7] << 16);
        w1.x = vv[8] | (vv[9] << 16); w1.y = vv[10] | (vv[11] << 16); w1.z = vv[12] | (vv[13] << 16); w1.w = vv[14] | (vv[15] << 16);
        *(LAS u32x4*)(sVT + k * 72 + 16 * i) = w0; *(LAS u32x4*)(sVT + k * 72 + 16 * i + 8) = w1;
    }
    __syncthreads();
    {
        const float t0 = sTot[k], t1 = sTot[128 + k], t2 = sTot[256 + k], t3 = sTot[384 + k];
        const float bend0 = t0, bend1 = t0 + t1, bend2 = bend1 + t2, blast = bend2 + t3;
        const float bstart = (i == 0) ? 0.f : ((i == 1) ? bend0 : ((i == 2) ? bend1 : bend2));
        const float cum = bl[15];
        const float cE = __expf(bstart), c0 = __expf(bstart - bend0), c1 = __expf(bstart - bend1), cdec = __expf(blast - (bstart + cum));
        const int idD = (i == 0) ? 0 : (1 + ((i - 1) * i) / 2 + (i - 1));
        const int id0 = 1 + ((i - 1) * i) / 2;
        bf16_t* pqe = C.Z(7) + (row0 + 16 * i) * 512 + hc + k;
        unsigned kd16[16];
#pragma unroll
        for (int t = 0; t < 16; ++t) {
            const float e = __expf(bl[t]), ei = __expf(-bl[t]), ek = __expf(cum - bl[t]);
            const float qdv = q[t] * e, kdv = kk[t] * ei, kev = kk[t] * ek;
            sQV[(idD * 16 + t) * 136 + k] = f2bf(qdv);
            if (i >= 2) sQV[(id0 * 16 + t) * 136 + k] = f2bf(qdv * c0);
            if (i == 3) sQV[(5 * 16 + t) * 136 + k] = f2bf(qdv * c1);
            sKD[(i * 16 + t) * 136 + k] = f2bf(kdv);
            if (i < 3) sKE[(i * 16 + t) * 136 + k] = f2bf(kev);
            kd16[t] = f2bf(kev * cdec);
            pqe[t * 512] = f2bf(qdv * cE);
        }
        u32x4 w0, w1;
        w0.x = kd16[0] | (kd16[1] << 16); w0.y = kd16[2] | (kd16[3] << 16); w0.z = kd16[4] | (kd16[5] << 16); w0.w = kd16[6] | (kd16[7] << 16);
        w1.x = kd16[8] | (kd16[9] << 16); w1.y = kd16[10] | (kd16[11] << 16); w1.z = kd16[12] | (kd16[13] << 16); w1.w = kd16[14] | (kd16[15] << 16);
        *(LAS u32x4*)(sKT + k * 72 + 16 * i) = w0; *(LAS u32x4*)(sKT + k * 72 + 16 * i + 8) = w1;
        if (i == 0) C.wsf(WS_DEC)[(size_t)item * 128 + k] = __expf(blast);
    }
    __syncthreads();
#pragma unroll
    for (int x = 0; x < 2; ++x) {
        const int tile = wid * 2 + x, ti = tile >> 2, tj = tile & 3;
        f32x4 d = {0.f, 0.f, 0.f, 0.f};
        if (tj <= ti) {
            const int ida = (ti == 0) ? 0 : (1 + ((ti - 1) * ti) / 2 + ((tj == ti) ? ti - 1 : tj));
            const LAS bf16_t* Aop = sQV + ida * 2176 + r * 136 + qd * 8;
            const LAS bf16_t* Bop = ((tj == ti) ? (sKD + ti * 2176) : (sKE + tj * 2176)) + r * 136 + qd * 8;
#pragma unroll
            for (int k4 = 0; k4 < 4; ++k4) d = MFMA16(ld8(Aop + k4 * 32), ld8(Bop + k4 * 32), d);
        }
#pragma unroll
        for (int jx = 0; jx < 4; ++jx) { const int t = 4 * qd + jx; const bool keep = (tj < ti) || (tj == ti && r <= t);
            sA[(16 * ti + t) * 72 + 16 * tj + r] = f2bf(keep ? d[jx] : 0.f); }
    }
    __syncthreads();
    {
        bf16_t* OI = C.wsb(WS_OI); bf16_t* DS = C.wsb(WS_DS) + (size_t)item * 16384;
        const bf16x8 v0 = ld8(sVT + (16 * wid + r) * 72 + qd * 8), v1 = ld8(sVT + (16 * wid + r) * 72 + 32 + qd * 8);
#pragma unroll
        for (int ti = 0; ti < 4; ++ti) {
            f32x4 d = {0.f, 0.f, 0.f, 0.f};
            d = MFMA16(v0, ld8(sA + (16 * ti + r) * 72 + qd * 8), d);
            d = MFMA16(v1, ld8(sA + (16 * ti + r) * 72 + 32 + qd * 8), d);
            u32x2 w; w.x = pk2(d[0], d[1]); w.y = pk2(d[2], d[3]);
            *(u32x2*)(OI + (row0 + 16 * ti + r) * 512 + hc + 16 * wid + 4 * qd) = w;
        }
#pragma unroll
        for (int kt = 0; kt < 8; ++kt) {
            f32x4 d = {0.f, 0.f, 0.f, 0.f};
            d = MFMA16(ld8(sKT + (16 * kt + r) * 72 + qd * 8), v0, d);
            d = MFMA16(ld8(sKT + (16 * kt + r) * 72 + 32 + qd * 8), v1, d);
            u32x2 w; w.x = pk2(d[0], d[1]); w.y = pk2(d[2], d[3]);
            *(u32x2*)(DS + (16 * wid + r) * 128 + 16 * kt + 4 * qd) = w;
        }
    }
    __syncthreads();
}

__device__ __forceinline__ void hg_scan(const Ctx& C) {
    const bf16_t* __restrict__ DS = C.wsb(WS_DS); bf16_t* __restrict__ SC = C.wsb(WS_SC); const float* __restrict__ DEC = C.wsf(WS_DEC);
    float* __restrict__ outS = C.out + OUT_SP;
    for (int g = blockIdx.x * NTHR + threadIdx.x; g < 32 * 4096; g += gridDim.x * NTHR) {
        const int bh = g >> 12, e = g & 4095, v = e >> 5, k4 = (e & 31) * 4, b = bh >> 2, h = bh & 3;
        float S0 = 0.f, S1 = 0.f, S2 = 0.f, S3 = 0.f;
#pragma unroll 1
        for (int half = 0; half < 2; ++half) {
            u32x2 dsv[16]; f32x4 dcv[16];
#pragma unroll
            for (int j = 0; j < 16; ++j) { const int item = b * 128 + (half * 16 + j) * 4 + h;
                dsv[j] = *(const u32x2*)(DS + (size_t)item * 16384 + v * 128 + k4); dcv[j] = *(const f32x4*)(DEC + (size_t)item * 128 + k4); }
#pragma unroll
            for (int j = 0; j < 16; ++j) { const int item = b * 128 + (half * 16 + j) * 4 + h; const size_t off = (size_t)item * 16384 + v * 128 + k4;
                u32x2 w; w.x = pk2(S0, S1); w.y = pk2(S2, S3); *(u32x2*)(SC + off) = w;
                S0 = dcv[j][0] * S0 + bflo(dsv[j].x); S1 = dcv[j][1] * S1 + bfhi(dsv[j].x); S2 = dcv[j][2] * S2 + bflo(dsv[j].y); S3 = dcv[j][3] * S3 + bfhi(dsv[j].y); }
        }
        float* o = outS + ((size_t)(b * 4 + h) * 128 + k4) * 128 + v;
        o[0] = S0; o[128] = S1; o[256] = S2; o[384] = S3;
    }
}

__device__ __forceinline__ void gmlp_item(const Ctx& C, LAS unsigned char* lds, int item) {
    const int tid = threadIdx.x, lane = tid & 63, wid = tid >> 6, r = lane & 15, qd = lane >> 4;
    const int n = item >> 2, g = item & 3; const size_t rb = (size_t)n * 128;
    LAS bf16_t* sW = (LAS bf16_t*)lds;
    LAS bf16_t* sVN = sW + 128 * 136;
    LAS float* sSt = (LAS float*)(sVN + 128 * 136);
    const bf16_t* Zgv = C.Z(6); const bf16_t* Zu = C.Z(5);
    u32x4 gvt[4]; u32x2 uu8[8]; float bb8[8];
#pragma unroll
    for (int it = 0; it < 4; ++it) { const int e = it * NTHR + tid; gvt[it] = *(const u32x4*)(Zgv + (rb + (e >> 4)) * 512 + g * 128 + (e & 15) * 8); }
#pragma unroll
    for (int ti = 0; ti < 8; ++ti) { uu8[ti] = *(const u32x2*)(Zu + (rb + 16 * ti + r) * 512 + g * 128 + 16 * wid + 4 * qd); bb8[ti] = C.in[13][g * 128 + 16 * ti + r]; }
    if (tid < 128) {
        const float* ln = C.wsf(WS_LN); const float s1 = ln[rb + tid], s2 = ln[MT + rb + tid];
        const float mean = s1 * (1.0f / 512.0f), var = fmaxf(s2 * (1.0f / 512.0f) - mean * mean, 0.f);
        sSt[tid * 2] = mean; sSt[tid * 2 + 1] = rsqrtf(var + EPS);
    }
    {
        const float* W = C.in[12] + (size_t)g * 16384;
        f32x4 wv[8];
#pragma unroll
        for (int it = 0; it < 8; ++it) wv[it] = *(const f32x4*)(W + (it * NTHR + tid) * 4);
#pragma unroll
        for (int it = 0; it < 8; ++it) { const int e = (it * NTHR + tid) * 4, t = e >> 7, s = e & 127; const f32x4 v = wv[it];
            u32x2 w; w.x = pk2(s <= t ? v[0] : 0.f, s + 1 <= t ? v[1] : 0.f); w.y = pk2(s + 2 <= t ? v[2] : 0.f, s + 3 <= t ? v[3] : 0.f);
            *(LAS u32x2*)(sW + t * 136 + s) = w; }
    }
    __syncthreads();
    {
        const float* lgp = C.in[10] + g * 128; const float* lbp2 = C.in[11] + g * 128;
#pragma unroll
        for (int it = 0; it < 4; ++it) { const int e = it * NTHR + tid, sx = e >> 4, c8 = (e & 15) * 8;
            const u32x4 w = gvt[it]; const float mean = sSt[sx * 2], rs = sSt[sx * 2 + 1];
            const f32x4 g0 = *(const f32x4*)(lgp + c8), g1 = *(const f32x4*)(lgp + c8 + 4), b0 = *(const f32x4*)(lbp2 + c8), b1 = *(const f32x4*)(lbp2 + c8 + 4);
            u32x4 o;
            o.x = pk2((bflo(w.x) - mean) * rs * g0[0] + b0[0], (bfhi(w.x) - mean) * rs * g0[1] + b0[1]);
            o.y = pk2((bflo(w.y) - mean) * rs * g0[2] + b0[2], (bfhi(w.y) - mean) * rs * g0[3] + b0[3]);
            o.z = pk2((bflo(w.z) - mean) * rs * g1[0] + b1[0], (bfhi(w.z) - mean) * rs * g1[1] + b1[1]);
            o.w = pk2((bflo(w.w) - mean) * rs * g1[2] + b1[2], (bfhi(w.w) - mean) * rs * g1[3] + b1[3]);
            *(LAS u32x4*)(sVN + sx * 136 + c8) = o; }
    }
    __syncthreads();
    {
        bf16_t* O = C.wsb(WS_O);
        bf16x8 bfr[4];
#pragma unroll
        for (int k4 = 0; k4 < 4; ++k4) { unsigned x[8];
#pragma unroll
            for (int j = 0; j < 8; ++j) x[j] = sVN[(k4 * 32 + qd * 8 + j) * 136 + 16 * wid + r];
            u32x4 w; w.x = x[0] | (x[1] << 16); w.y = x[2] | (x[3] << 16); w.z = x[4] | (x[5] << 16); w.w = x[6] | (x[7] << 16);
            bfr[k4] = __builtin_bit_cast(bf16x8, w); }
#pragma unroll
        for (int ti = 0; ti < 8; ++ti) {
            f32x4 d = {0.f, 0.f, 0.f, 0.f};
#pragma unroll
            for (int k4 = 0; k4 < 4; ++k4) if (k4 <= (ti >> 1)) d = MFMA16(bfr[k4], ld8(sW + (16 * ti + r) * 136 + k4 * 32 + qd * 8), d);
            const int t = 16 * ti + r, cc = g * 128 + 16 * wid + 4 * qd; const float bb = bb8[ti];
            const u32x2 uu = uu8[ti];
            u32x2 w; w.x = pk2(bflo(uu.x) * (d[0] + bb), bfhi(uu.x) * (d[1] + bb)); w.y = pk2(bflo(uu.y) * (d[2] + bb), bfhi(uu.y) * (d[3] + bb));
            *(u32x2*)(O + (rb + t) * 1024 + 512 + cc) = w;
        }
    }
    __syncthreads();
}

__device__ __forceinline__ void hg_sample_item(const Ctx& C, LAS unsigned char* lds, int item) {
    const int tid = threadIdx.x, lane = tid & 63, wid = tid >> 6;
    const int bs = item >> 2, h = item & 3, hc = h * 128; const size_t r0 = (size_t)MP + bs * 4;
    LAS float* sq = (LAS float*)lds; LAS float* sk = sq + 512; LAS float* sf = sk + 512;
    LAS float* sp = sf + 512;
    LAS float* sred = sp + 2048;
    {
        const int t = tid >> 7, k = tid & 127; const size_t o = (r0 + t) * 512 + hc + k;
        sq[tid] = bf2f(C.Z(0)[o]); sk[tid] = bf2f(C.Z(1)[o]); sf[tid] = __expf(bf2f(C.Z(2)[o]));
    }
    const int v = tid & 127, kq = tid >> 7;
    const float gg_pre = bf2f(C.Z(4)[(r0 + (tid >> 7)) * 512 + hc + v]), hgn_pre = C.in[9][hc + v];
    float S[32];
    const float* sin = C.in[3] + (size_t)item * 16384 + (size_t)(kq * 32) * 128 + v;
#pragma unroll
    for (int j = 0; j < 32; ++j) S[j] = sin[j * 128];
    float vt[4];
#pragma unroll
    for (int t = 0; t < 4; ++t) vt[t] = bf2f(C.Z(3)[(r0 + t) * 512 + hc + v]);
    __syncthreads();
#pragma unroll
    for (int t = 0; t < 4; ++t) {
        float po = 0.f;
#pragma unroll
        for (int j = 0; j < 32; ++j) { const int k = kq * 32 + j; S[j] = sf[t * 128 + k] * S[j] + sk[t * 128 + k] * vt[t]; po += S[j] * sq[t * 128 + k]; }
        sp[(kq * 4 + t) * 128 + v] = po;
    }
    float* sout = C.out + OUT_SSMP + (size_t)item * 16384 + (size_t)(kq * 32) * 128 + v;
#pragma unroll
    for (int j = 0; j < 32; ++j) sout[j * 128] = S[j];
    __syncthreads();
    {
        const int t = tid >> 7;
        const float o = sp[(0 * 4 + t) * 128 + v] + sp[(1 * 4 + t) * 128 + v] + sp[(2 * 4 + t) * 128 + v] + sp[(3 * 4 + t) * 128 + v];
        float s = o * o;
#pragma unroll
        for (int x = 32; x >= 1; x >>= 1) s += __shfl_xor(s, x);
        if (lane == 0) sred[wid] = s;
        __syncthreads();
        const float ms = (sred[2 * t] + sred[2 * t + 1]) * (1.0f / 128.0f);
        C.wsb(WS_O)[(r0 + t) * 1024 + hc + v] = f2bf(o * rsqrtf(ms + EPS) * hgn_pre * gg_pre);
    }
    __syncthreads();
}

__device__ __forceinline__ void gmlp_sample_item(const Ctx& C, LAS unsigned char* lds, int bs) {
    const int tid = threadIdx.x, lane = tid & 63, wid = tid >> 6; const size_t r0 = (size_t)MP + bs * 4;
    LAS float* sred = (LAS float*)lds;
    const int c = tid, g = c >> 7;
    float gv[4], s[4], s2[4], uuv[4], bsv[4], wv[10];
    const float lg = C.in[10][c], lbb = C.in[11][c];
    { const float* W = C.in[12] + (size_t)g * 16384; const float* bsp = C.in[13] + g * 128; int q = 0;
#pragma unroll
      for (int t = 0; t < 4; ++t) { bsv[t] = bsp[t]; uuv[t] = bf2f(C.Z(5)[(r0 + t) * 512 + c]);
#pragma unroll
          for (int sx = 0; sx < 4; ++sx) if (sx <= t) wv[q++] = W[t * 128 + sx]; } }
#pragma unroll
    for (int t = 0; t < 4; ++t) { gv[t] = bf2f(C.Z(6)[(r0 + t) * 512 + c]); s[t] = gv[t]; s2[t] = gv[t] * gv[t]; }
#pragma unroll
    for (int t = 0; t < 4; ++t)
#pragma unroll
        for (int x = 32; x >= 1; x >>= 1) { s[t] += __shfl_xor(s[t], x); s2[t] += __shfl_xor(s2[t], x); }
    if (lane == 0) {
#pragma unroll
        for (int t = 0; t < 4; ++t) { sred[wid * 8 + t] = s[t]; sred[wid * 8 + 4 + t] = s2[t]; } }
    __syncthreads();
    float vn[4];
#pragma unroll
    for (int t = 0; t < 4; ++t) { float a = 0.f, a2 = 0.f;
#pragma unroll
        for (int w = 0; w < 8; ++w) { a += sred[w * 8 + t]; a2 += sred[w * 8 + 4 + t]; }
        const float mean = a * (1.0f / 512.0f), var = fmaxf(a2 * (1.0f / 512.0f) - mean * mean, 0.f);
        vn[t] = (gv[t] - mean) * rsqrtf(var + EPS) * lg + lbb;
        C.out[OUT_CMV + ((size_t)bs * 4 + t) * 512 + c] = vn[t]; }
    { int q = 0;
#pragma unroll
      for (int t = 0; t < 4; ++t) { float mix = bsv[t];
#pragma unroll
          for (int sx = 0; sx < 4; ++sx) if (sx <= t) mix += wv[q++] * vn[sx];
          C.wsb(WS_O)[(r0 + t) * 1024 + 512 + c] = f2bf(uuv[t] * mix); } }
    __syncthreads();
}

__device__ __forceinline__ void hg_out(const Ctx& C, LAS unsigned char* lds) {
    const int tid = threadIdx.x, lane = tid & 63, wid = tid >> 6, r = lane & 15, qd = lane >> 4;
    const bf16_t* __restrict__ QE = C.Z(7); const bf16_t* __restrict__ SC = C.wsb(WS_SC); const bf16_t* __restrict__ OI = C.wsb(WS_OI); const bf16_t* __restrict__ Zg = C.Z(4); bf16_t* __restrict__ O = C.wsb(WS_O);
    const float* hgn = C.in[9];
    LAS bf16_t* sS = (LAS bf16_t*)lds;
    const int sv = (tid >> 4) & 127, sk8 = (tid & 15) * 8;
    u32x4 st[8];
    int p = blockIdx.x;
#define HGO_LOAD(pp) do { _Pragma("unroll") for (int it = 0; it < 8; ++it) { const int e = it * NTHR + tid; \
        st[it] = *(const u32x4*)(SC + (size_t)(2 * (pp) + (e >> 11)) * 16384 + ((e & 2047) >> 4) * 128 + (e & 15) * 8); } } while (0)
    if (p < 512) HGO_LOAD(p);
    for (; p < 512; p += gridDim.x) {
        const int item = 2 * p + (wid >> 2), ti = wid & 3; const int b = item >> 7, c = (item >> 2) & 31, h = item & 3, hc = h * 128;
        const size_t row = (size_t)b * 2048 + c * 64 + 16 * ti + r;
        bf16x8 a[4];
#pragma unroll
        for (int k4 = 0; k4 < 4; ++k4) a[k4] = gld8(QE + row * 512 + hc + k4 * 32 + qd * 8);
        u32x2 oi[8], gg[8]; f32x4 gnv[8];
#pragma unroll
        for (int vt = 0; vt < 8; ++vt) { oi[vt] = *(const u32x2*)(OI + row * 512 + hc + 16 * vt + 4 * qd); gg[vt] = *(const u32x2*)(Zg + row * 512 + hc + 16 * vt + 4 * qd); gnv[vt] = *(const f32x4*)(hgn + hc + 16 * vt + 4 * qd); }
        __syncthreads();
#pragma unroll
        for (int it = 0; it < 8; ++it) { const int e = it * NTHR + tid; *(LAS u32x4*)(sS + (e >> 11) * (128 * 136) + ((e & 2047) >> 4) * 136 + (e & 15) * 8) = st[it]; }
        __syncthreads();
        if (p + (int)gridDim.x < 512) HGO_LOAD(p + gridDim.x);
        const LAS bf16_t* sT = sS + (wid >> 2) * (128 * 136);
        f32x4 d[8];
#pragma unroll
        for (int vt = 0; vt < 8; ++vt) { d[vt] = (f32x4){0.f, 0.f, 0.f, 0.f};
#pragma unroll
            for (int k4 = 0; k4 < 4; ++k4) d[vt] = MFMA16(ld8(sT + (16 * vt + r) * 136 + k4 * 32 + qd * 8), a[k4], d[vt]); }
        float sq = 0.f;
#pragma unroll
        for (int vt = 0; vt < 8; ++vt) {
            d[vt][0] += bflo(oi[vt].x); d[vt][1] += bfhi(oi[vt].x); d[vt][2] += bflo(oi[vt].y); d[vt][3] += bfhi(oi[vt].y);
            sq += (d[vt][0] * d[vt][0] + d[vt][1] * d[vt][1]) + (d[vt][2] * d[vt][2] + d[vt][3] * d[vt][3]); }
        sq += __shfl_xor(sq, 16); sq += __shfl_xor(sq, 32);
        const float rs = rsqrtf(sq * (1.0f / 128.0f) + EPS);
#pragma unroll
        for (int vt = 0; vt < 8; ++vt) { const int cc = hc + 16 * vt + 4 * qd; const f32x4 gn = gnv[vt];
            u32x2 w; w.x = pk2(d[vt][0] * rs * gn[0] * bflo(gg[vt].x), d[vt][1] * rs * gn[1] * bfhi(gg[vt].x)); w.y = pk2(d[vt][2] * rs * gn[2] * bflo(gg[vt].y), d[vt][3] * rs * gn[3] * bfhi(gg[vt].y));
            *(u32x2*)(O + row * 1024 + cc) = w; }
    }
#undef HGO_LOAD
    __syncthreads();
    (void)sv; (void)sk8;
}

__device__ __forceinline__ void attn_prompt_item(const Ctx& C, LAS unsigned char* lds, int item) {
    const int tid = threadIdx.x, lane = tid & 63, wid = tid >> 6, r = lane & 15, qd = lane >> 4;
    const int b = item >> 5, h = (item >> 3) & 3, qt = item & 7;
    int opq = 0; asm volatile("" : "+v"(opq));
    LAS bf16_t* sK = (LAS bf16_t*)lds + opq;
    const bf16_t* KB = C.wsb(WS_KB); const bf16_t* VT = C.wsb(WS_VT); const bf16_t* HQ = C.wsb(WS_HQ); bf16_t* CA = C.wsb(WS_CA);
    const size_t q0 = (size_t)b * 2048 + qt * 256 + wid * 32;
    {   const bf16_t* gsrc = KB + ((size_t)b * 256 + (tid >> 5)) * 1024 + h * 256 + (tid & 31) * 8; LAS bf16_t* ldst = sK + (tid >> 5) * 264 + (tid & 31) * 8;
        u32x4 stg[16];
#pragma unroll
        for (int it = 0; it < 16; ++it) stg[it] = *(const u32x4*)(gsrc + (size_t)it * 16 * 1024);
#pragma unroll
        for (int it = 0; it < 16; ++it) *(LAS u32x4*)(ldst + it * 16 * 264) = stg[it]; }
    bf16x8 qf[2][8];
#pragma unroll
    for (int x = 0; x < 2; ++x)
#pragma unroll
        for (int k8 = 0; k8 < 8; ++k8) qf[x][k8] = gld8(HQ + (q0 + x * 16 + r) * 1024 + h * 256 + k8 * 32 + qd * 8);
    __syncthreads();
    bf16x8 pf[2][8];
    {
        f32x4 s[2][16];
#pragma unroll
        for (int mt = 0; mt < 16; ++mt) { s[0][mt] = (f32x4){0.f, 0.f, 0.f, 0.f}; s[1][mt] = (f32x4){0.f, 0.f, 0.f, 0.f};
#pragma unroll
            for (int k8 = 0; k8 < 8; ++k8) { const bf16x8 kf = ld8(sK + (16 * mt + r) * 264 + k8 * 32 + qd * 8);
                s[0][mt] = MFMA16(kf, qf[0][k8], s[0][mt]); s[1][mt] = MFMA16(kf, qf[1][k8], s[1][mt]); } }
#pragma unroll
        for (int x = 0; x < 2; ++x) {
            float mx = -3.0e38f;
#pragma unroll
            for (int mt = 0; mt < 16; ++mt)
#pragma unroll
                for (int jx = 0; jx < 4; ++jx) mx = fmaxf(mx, s[x][mt][jx]);
            mx = fmaxf(mx, __shfl_xor(mx, 16)); mx = fmaxf(mx, __shfl_xor(mx, 32));
            float sum = 0.f;
#pragma unroll
            for (int mt = 0; mt < 16; ++mt)
#pragma unroll
                for (int jx = 0; jx < 4; ++jx) { const float e = __expf(s[x][mt][jx] - mx); s[x][mt][jx] = e; sum += e; }
            sum += __shfl_xor(sum, 16); sum += __shfl_xor(sum, 32);
            const float inv = __builtin_amdgcn_rcpf(sum);
#pragma unroll
            for (int k8 = 0; k8 < 8; ++k8) { u32x4 w; w.x = pk2(s[x][2 * k8][0] * inv, s[x][2 * k8][1] * inv); w.y = pk2(s[x][2 * k8][2] * inv, s[x][2 * k8][3] * inv);
                w.z = pk2(s[x][2 * k8 + 1][0] * inv, s[x][2 * k8 + 1][1] * inv); w.w = pk2(s[x][2 * k8 + 1][2] * inv, s[x][2 * k8 + 1][3] * inv);
                pf[x][k8] = __builtin_bit_cast(bf16x8, w); }
        }
    }
    __syncthreads();
    {   const bf16_t* gsrc = VT + ((size_t)b * 1024 + h * 256 + (tid >> 5)) * 256 + (tid & 31) * 8; LAS bf16_t* ldst = sK + (tid >> 5) * 264 + (tid & 31) * 8;
        u32x4 stg[16];
#pragma unroll
        for (int it = 0; it < 16; ++it) stg[it] = *(const u32x4*)(gsrc + (size_t)it * 16 * 256);
#pragma unroll
        for (int it = 0; it < 16; ++it) *(LAS u32x4*)(ldst + it * 16 * 264) = stg[it]; }
    __syncthreads();
#pragma unroll 2
    for (int dt = 0; dt < 16; ++dt) {
        f32x4 o0 = {0.f, 0.f, 0.f, 0.f}, o1 = {0.f, 0.f, 0.f, 0.f};
        bf16x8 vf[8];
#pragma unroll
        for (int k8 = 0; k8 < 8; ++k8) {
            const LAS bf16_t* vp = sK + (16 * dt + r) * 264 + 32 * k8 + 4 * qd;
            const u32x2 lo = *(const LAS u32x2*)vp, hi = *(const LAS u32x2*)(vp + 16);
            u32x4 w; w.x = lo.x; w.y = lo.y; w.z = hi.x; w.w = hi.y; vf[k8] = __builtin_bit_cast(bf16x8, w);
        }
#pragma unroll
        for (int k8 = 0; k8 < 8; ++k8) { o0 = MFMA16(vf[k8], pf[0][k8], o0); o1 = MFMA16(vf[k8], pf[1][k8], o1); }
        u32x2 w0, w1; w0.x = pk2(o0[0], o0[1]); w0.y = pk2(o0[2], o0[3]); w1.x = pk2(o1[0], o1[1]); w1.y = pk2(o1[2], o1[3]);
        *(u32x2*)(CA + (q0 + r) * 1024 + h * 256 + 16 * dt + 4 * qd) = w0;
        *(u32x2*)(CA + (q0 + 16 + r) * 1024 + h * 256 + 16 * dt + 4 * qd) = w1;
    }
    __syncthreads();
}

__device__ __forceinline__ void attn_sample_item(const Ctx& C, LAS unsigned char* lds, int item) {
    const int tid = threadIdx.x, lane = tid & 63, wid = tid >> 6, r = lane & 15, qd = lane >> 4;
    const int bs = item >> 1, hp = item & 1, hl = wid & 1, h = 2 * hp + hl, kq = wid >> 1;
    LAS float* sP = (LAS float*)lds;
    LAS float* sMx = sP + 2048;
    LAS float* sSm = sMx + 32;
    LAS float* sO = sSm + 32;
    const bf16_t* HQ = C.wsb(WS_HQ); const size_t r0 = (size_t)MP + bs * 4;
    const float* Kc = C.in[4] + (size_t)bs * 262144; const float* Vc = C.in[5] + (size_t)bs * 262144;
    bf16x8 qf[8];
#pragma unroll
    for (int k8 = 0; k8 < 8; ++k8) { if (r < 4) qf[k8] = gld8(HQ + (r0 + r) * 1024 + h * 256 + k8 * 32 + qd * 8); else qf[k8] = (bf16x8){0, 0, 0, 0, 0, 0, 0, 0}; }
    f32x4 s[4];
    const float* kp = Kc + ((size_t)(kq * 64 + r) * 4 + h) * 256 + qd * 8;
    const float* vp = Vc + ((size_t)(kq * 64) * 4 + h) * 256 + lane * 4;
    f32x4 ka[16], kb[16];
#define LOADK(dst, mt) do { _Pragma("unroll") for (int k8 = 0; k8 < 8; ++k8) { dst[2 * k8] = *(const f32x4*)(kp + (size_t)(mt) * 16384 + k8 * 32); dst[2 * k8 + 1] = *(const f32x4*)(kp + (size_t)(mt) * 16384 + k8 * 32 + 4); } } while (0)
#define MMAK(src, mt) do { s[mt] = (f32x4){0.f, 0.f, 0.f, 0.f}; _Pragma("unroll") for (int k8 = 0; k8 < 8; ++k8) { u32x4 w; w.x = pk2(src[2 * k8][0], src[2 * k8][1]); w.y = pk2(src[2 * k8][2], src[2 * k8][3]); \
        w.z = pk2(src[2 * k8 + 1][0], src[2 * k8 + 1][1]); w.w = pk2(src[2 * k8 + 1][2], src[2 * k8 + 1][3]); s[mt] = MFMA16(__builtin_bit_cast(bf16x8, w), qf[k8], s[mt]); } } while (0)
#define LOADV(dst, m0) do { _Pragma("unroll") for (int m = 0; m < 16; ++m) dst[m] = *(const f32x4*)(vp + (size_t)((m0) + m) * 1024); } while (0)
#define FMAV(src, m0) do { _Pragma("unroll") for (int m = 0; m < 16; ++m) { _Pragma("unroll") for (int t = 0; t < 4; ++t) acc[t] += src[m] * sP[(wid * 4 + t) * 64 + (m0) + m]; } } while (0)
    LOADK(ka, 0); LOADK(kb, 1);
    MMAK(ka, 0); LOADK(ka, 2);
    MMAK(kb, 1); LOADK(kb, 3);
    MMAK(ka, 2); LOADV(ka, 0);
    MMAK(kb, 3); LOADV(kb, 16);
    float mx = -3.0e38f;
#pragma unroll
    for (int mt = 0; mt < 4; ++mt)
#pragma unroll
        for (int jx = 0; jx < 4; ++jx) mx = fmaxf(mx, s[mt][jx]);
    mx = fmaxf(mx, __shfl_xor(mx, 16)); mx = fmaxf(mx, __shfl_xor(mx, 32));
    float sum = 0.f;
#pragma unroll
    for (int mt = 0; mt < 4; ++mt)
#pragma unroll
        for (int jx = 0; jx < 4; ++jx) { const float e = __expf(s[mt][jx] - mx); s[mt][jx] = e; sum += e; }
    sum += __shfl_xor(sum, 16); sum += __shfl_xor(sum, 32);
    if (lane < 4) { sMx[(hl * 4 + kq) * 4 + lane] = mx; sSm[(hl * 4 + kq) * 4 + lane] = sum; }
    if (r < 4) {
#pragma unroll
        for (int mt = 0; mt < 4; ++mt)
#pragma unroll
            for (int jx = 0; jx < 4; ++jx) sP[(wid * 4 + r) * 64 + 16 * mt + 4 * qd + jx] = s[mt][jx];
    }
    {
        f32x4 acc[4];
#pragma unroll
        for (int t = 0; t < 4; ++t) acc[t] = (f32x4){0.f, 0.f, 0.f, 0.f};
        FMAV(ka, 0); LOADV(ka, 32);
        FMAV(kb, 16); LOADV(kb, 48);
        FMAV(ka, 32); FMAV(kb, 48);
#pragma unroll
        for (int t = 0; t < 4; ++t) *(LAS f32x4*)(sO + ((hl * 4 + kq) * 4 + t) * 256 + lane * 4) = acc[t];
    }
#undef LOADK
#undef MMAK
#undef LOADV
#undef FMAV
    __syncthreads();
    {
        const int e = tid * 4, hl2 = e >> 10, t = (e >> 8) & 3, d = e & 255;
        float m4[4], w4[4]; float gm = -3.0e38f, den = 0.f;
#pragma unroll
        for (int q4 = 0; q4 < 4; ++q4) { m4[q4] = sMx[(hl2 * 4 + q4) * 4 + t]; gm = fmaxf(gm, m4[q4]); }
#pragma unroll
        for (int q4 = 0; q4 < 4; ++q4) { w4[q4] = __expf(m4[q4] - gm); den += w4[q4] * sSm[(hl2 * 4 + q4) * 4 + t]; }
        const float inv = __builtin_amdgcn_rcpf(den);
        f32x4 o = {0.f, 0.f, 0.f, 0.f};
#pragma unroll
        for (int q4 = 0; q4 < 4; ++q4) o += *(const LAS f32x4*)(sO + ((hl2 * 4 + q4) * 4 + t) * 256 + d) * (w4[q4] * inv);
        u32x2 w; w.x = pk2(o[0], o[1]); w.y = pk2(o[2], o[3]);
        *(u32x2*)(C.wsb(WS_CA) + (r0 + t) * 1024 + (2 * hp + hl2) * 256 + d) = w;
    }
    __syncthreads();
}

template <class F> __device__ __forceinline__ void sgemm_tile(const bf16_t* A, const bf16_t* Bt, int K, int N, int tile, LAS unsigned char* lds, const F& epi) {
    const int tid = threadIdx.x, lane = tid & 63, wid = tid >> 6, r = lane & 15, qd = lane >> 4;
    const int ntn = N >> 6; const int mt = tile / ntn, nt = tile - mt * ntn;
    const int row0 = MP + 32 * mt, n0 = 64 * nt; const int KW = K >> 3;
    f32x4 acc[2][4];
#pragma unroll
    for (int mi = 0; mi < 2; ++mi)
#pragma unroll
        for (int ni = 0; ni < 4; ++ni) acc[mi][ni] = (f32x4){0.f, 0.f, 0.f, 0.f};
    const bf16_t* ap = A + (size_t)(row0 + r) * K + wid * KW + qd * 8;
    const bf16_t* bp = Bt + (size_t)(n0 + r) * K + wid * KW + qd * 8;
#pragma unroll 1
    for (int kc = 0; kc < KW; kc += 128) {
        bf16x8 a[2][4], b[4][4];
#pragma unroll
        for (int ks = 0; ks < 4; ++ks) {
#pragma unroll
            for (int mi = 0; mi < 2; ++mi) a[mi][ks] = gld8(ap + (size_t)mi * 16 * K + kc + ks * 32);
#pragma unroll
            for (int ni = 0; ni < 4; ++ni) b[ni][ks] = gld8(bp + (size_t)ni * 16 * K + kc + ks * 32);
        }
#pragma unroll
        for (int ks = 0; ks < 4; ++ks)
#pragma unroll
            for (int mi = 0; mi < 2; ++mi)
#pragma unroll
                for (int ni = 0; ni < 4; ++ni) acc[mi][ni] = MFMA16(a[mi][ks], b[ni][ks], acc[mi][ni]);
    }
    LAS float* red = (LAS float*)lds;
#pragma unroll
    for (int mi = 0; mi < 2; ++mi)
#pragma unroll
        for (int ni = 0; ni < 4; ++ni)
#pragma unroll
            for (int jx = 0; jx < 4; ++jx) red[(wid * 32 + 16 * mi + 4 * qd + jx) * 68 + 16 * ni + r] = acc[mi][ni][jx];
    __syncthreads();
    {
        const int row = tid >> 4, c4 = (tid & 15) * 4;
        f32x4 v = *(const LAS f32x4*)(red + row * 68 + c4);
#pragma unroll
        for (int w = 1; w < 8; ++w) v += *(const LAS f32x4*)(red + (w * 32 + row) * 68 + c4);
        epi(row0 + row, n0 + c4, v);
    }
    __syncthreads();
}
struct SEpi1 {
    bf16_t* Zb; const float* lbp; float* ln;
    __device__ __forceinline__ void operator()(int row, int col, const f32x4& v) const {
        const int sec = col >> 9, cs = col & 511; const size_t o = (size_t)row * 512 + cs;
        if (sec == 1) {
            const f32x4 p0 = *(const f32x4*)(lbp + cs), p1 = *(const f32x4*)(lbp + 512 + cs); float kk[4], lf[4];
#pragma unroll
            for (int j = 0; j < 4; ++j) { const float lb = sigm(p0[j] - p1[j]), sg = sigm(v[j]), oml = 1.0f - lb; kk[j] = oml * (1.0f - sg); lf[j] = __logf(lb + oml * sg); }
            u32x2 w; w.x = pk2(kk[0], kk[1]); w.y = pk2(kk[2], kk[3]); *(u32x2*)(Zb + ZSZ + o) = w;
            w.x = pk2(lf[0], lf[1]); w.y = pk2(lf[2], lf[3]); *(u32x2*)(Zb + 2 * ZSZ + o) = w;
        } else {
            float rr[4];
#pragma unroll
            for (int j = 0; j < 4; ++j) { const float z = v[j]; const float t = (sec >= 4) ? 1.5957691216f * (z + 0.044715f * z * z * z) : z; const float sg = sigm(t);
                rr[j] = (sec == 2) ? z : ((sec == 3) ? sg : z * sg); }
            u32x2 w; w.x = pk2(rr[0], rr[1]); w.y = pk2(rr[2], rr[3]); *(u32x2*)(Zb + (size_t)(sec == 0 ? 0 : sec + 1) * ZSZ + o) = w;
            if (sec == 5) { float a = (rr[0] + rr[1]) + (rr[2] + rr[3]), b = (rr[0] * rr[0] + rr[1] * rr[1]) + (rr[2] * rr[2] + rr[3] * rr[3]);
                a += __shfl_xor(a, 1); b += __shfl_xor(b, 1); a += __shfl_xor(a, 2); b += __shfl_xor(b, 2); a += __shfl_xor(a, 4); b += __shfl_xor(b, 4); a += __shfl_xor(a, 8); b += __shfl_xor(b, 8);
                if ((threadIdx.x & 15) == 0) { atomicAdd(ln + row, a); atomicAdd(ln + MT + row, b); } }
        }
    }
};
template <bool RB> struct SEpiRes {
    const float* resf; bf16_t* xb; float* ss;
    __device__ __forceinline__ void operator()(int row, int col, const f32x4& a) const {
        const size_t o = (size_t)row * 1024 + col; f32x4 v;
        if (RB) { const u32x2 rr = *(const u32x2*)(xb + o); v = (f32x4){bflo(rr.x), bfhi(rr.x), bflo(rr.y), bfhi(rr.y)} + a; }
        else v = *(const f32x4*)(resf + o) + a;
        u32x2 w; w.x = pk2(v[0], v[1]); w.y = pk2(v[2], v[3]); *(u32x2*)(xb + o) = w;
        float s = (v[0] * v[0] + v[1] * v[1]) + (v[2] * v[2] + v[3] * v[3]);
        s += __shfl_xor(s, 1); s += __shfl_xor(s, 2); s += __shfl_xor(s, 4); s += __shfl_xor(s, 8);
        if ((threadIdx.x & 15) == 0) atomicAdd(ss + row, s);
    }
};
template <int ACT> struct SEpiScale {
    bf16_t* O; int ldc; const float* ss; float scale;
    __device__ __forceinline__ void operator()(int row, int col, const f32x4& a) const {
        const float rs = rsqrtf(ss[row] * (1.0f / 1024.0f) + EPS) * scale; f32x4 v = a * rs;
        if (ACT == 1) {
#pragma unroll
            for (int j = 0; j < 4; ++j) { const float x = fmaxf(v[j], 0.f); v[j] = x * x; } }
        u32x2 w; w.x = pk2(v[0], v[1]); w.y = pk2(v[2], v[3]); *(u32x2*)(O + (size_t)row * ldc + col) = w;
    }
};


__device__ __forceinline__ void panel_wait(unsigned* cnt, unsigned want) {
    if (threadIdx.x == 0) {
        __hip_atomic_fetch_add(cnt, 1u, __ATOMIC_RELAXED, __HIP_MEMORY_SCOPE_AGENT);
        unsigned sp = 0;
        while (__hip_atomic_load(cnt, __ATOMIC_RELAXED, __HIP_MEMORY_SCOPE_AGENT) < want) { __builtin_amdgcn_s_sleep(2); if (++sp > (1u << 22)) break; }
        __builtin_amdgcn_fence(__ATOMIC_ACQUIRE, "agent");
        asm volatile("s_waitcnt vmcnt(0)" ::: "memory");
    }
}
struct EpiFinal {
    static constexpr bool PERM = false, AFTER_DRAIN = true;
    const bf16_t* res; float* out; float* ss; unsigned* cnt; const float* gfin;
    __device__ __forceinline__ void fused(f32x4 (&acc)[2][2][4][2], const pg8::Unit& u, int wr, int wc, int fr, int fq, LAS unsigned char* lds, int wid, int lane) const {
        const int row0 = u.pm * 256 + wr * 64 + fr, col0 = u.pn * 256 + wc * 32 + 4 * fq;
#pragma unroll
        for (int ai = 0; ai < 2; ++ai)
#pragma unroll
            for (int m = 0; m < 4; ++m) {
                const int row = row0 + ai * 128 + m * 16; const size_t o = (size_t)row * 1024 + col0; float s = 0.f;
#pragma unroll
                for (int bj = 0; bj < 2; ++bj)
#pragma unroll
                    for (int n = 0; n < 2; ++n) { const u32x2 rr = *(const u32x2*)(res + o + bj * 128 + n * 16); const f32x4 v = (f32x4){bflo(rr.x), bfhi(rr.x), bflo(rr.y), bfhi(rr.y)} + acc[ai][bj][m][n]; acc[ai][bj][m][n] = v;
                        s += (v[0] * v[0] + v[1] * v[1]) + (v[2] * v[2] + v[3] * v[3]); }
                s += __shfl_xor(s, 16); s += __shfl_xor(s, 32);
                if (fq == 0) atomicAdd(ss + row, s);
            }
        asm volatile("s_waitcnt vmcnt(0)" ::: "memory");
        __syncthreads();
        panel_wait(cnt + 64 * u.pm, 4u);
        __syncthreads();
        f32x4 gv[2][2];
#pragma unroll
        for (int bj = 0; bj < 2; ++bj)
#pragma unroll
            for (int n = 0; n < 2; ++n) gv[bj][n] = *(const f32x4*)(gfin + col0 + bj * 128 + n * 16);
        float ssv[2][4];
#pragma unroll
        for (int ai = 0; ai < 2; ++ai)
#pragma unroll
            for (int m = 0; m < 4; ++m) ssv[ai][m] = __hip_atomic_load(ss + row0 + ai * 128 + m * 16, __ATOMIC_RELAXED, __HIP_MEMORY_SCOPE_AGENT);
#pragma unroll
        for (int ai = 0; ai < 2; ++ai)
#pragma unroll
            for (int m = 0; m < 4; ++m) {
                const int row = row0 + ai * 128 + m * 16; const size_t o = (size_t)row * 1024 + col0;
                const float rs = rsqrtf(ssv[ai][m] * (1.0f / 1024.0f) + EPS);
#pragma unroll
                for (int bj = 0; bj < 2; ++bj)
#pragma unroll
                    for (int n = 0; n < 2; ++n) *(f32x4*)(out + o + bj * 128 + n * 16) = acc[ai][bj][m][n] * rs * gv[bj][n];
            }
    }
};
struct SEpiFinal {
    const bf16_t* res; float* out; float* ss; unsigned* cnt; const float* gfin;
    __device__ __forceinline__ void operator()(int row, int col, const f32x4& a) const {
        const size_t o = (size_t)row * 1024 + col; const u32x2 rr = *(const u32x2*)(res + o); const f32x4 v = (f32x4){bflo(rr.x), bfhi(rr.x), bflo(rr.y), bfhi(rr.y)} + a;
        float s = (v[0] * v[0] + v[1] * v[1]) + (v[2] * v[2] + v[3] * v[3]);
        s += __shfl_xor(s, 1); s += __shfl_xor(s, 2); s += __shfl_xor(s, 4); s += __shfl_xor(s, 8);
        if ((threadIdx.x & 15) == 0) atomicAdd(ss + row, s);
        asm volatile("s_waitcnt vmcnt(0)" ::: "memory");
        __syncthreads();
        panel_wait(cnt + 64 * ((row - MP) >> 5), 16u);
        __syncthreads();
        const float rs = rsqrtf(__hip_atomic_load(ss + row, __ATOMIC_RELAXED, __HIP_MEMORY_SCOPE_AGENT) * (1.0f / 1024.0f) + EPS);
        *(f32x4*)(out + o) = v * rs * *(const f32x4*)(gfin + col);
    }
};

#define XB_TMO      128
#define XB_XCNT(j)  (256  + 64 * (j))
#define XB_XSUB(j)  (1280 + 64 * (j))
#define XB_XGEN(j)  (2304 + 64 * (j))
#define XB_TOP      3328
#define XB_TOPGEN   3392
#define XCD_BAR_WORDS 3456
#define XB_SPIN_CAP (1u << 18)

__device__ __forceinline__ unsigned xb_ld(unsigned* p)              { return __hip_atomic_load(p, __ATOMIC_RELAXED, __HIP_MEMORY_SCOPE_AGENT); }
__device__ __forceinline__ unsigned xb_add(unsigned* p, unsigned v) { return __hip_atomic_fetch_add(p, v, __ATOMIC_RELAXED, __HIP_MEMORY_SCOPE_AGENT); }
__device__ __forceinline__ unsigned xb_xcc_id() { return (unsigned)__builtin_amdgcn_s_getreg((3 << 11) | 20) & 0xFu; }
#define XB_SPIN(cond, bar) do { unsigned _sp = 0; while (cond) { __builtin_amdgcn_s_sleep(1); \
    if ((++_sp & 255u) == 0u) { if (xb_ld(&(bar)[XB_TMO])) break; if (_sp > XB_SPIN_CAP) { atomicAdd(&(bar)[XB_TMO], 1u); break; } } } } while (0)

struct XcdBarrier {
    unsigned* bar; unsigned x;
    volatile LAS unsigned* st;
};

__device__ __forceinline__ XcdBarrier xcd_barrier_post(unsigned* bar, volatile LAS unsigned* st) {
    XcdBarrier b; b.bar = bar; b.x = xb_xcc_id(); b.st = st;
    if (threadIdx.x == 0) (void)xb_add(&bar[XB_XCNT(b.x)], 1u);
    return b;
}
__device__ __forceinline__ void xcd_barrier_complete(unsigned* bar, unsigned x, unsigned& nloc, unsigned& nx) {
    const unsigned G = gridDim.x * gridDim.y * gridDim.z;
    unsigned sum, cnt, mine, sp = 0u;
    for (;;) {
        sum = 0u; cnt = 0u; mine = 0u;
#pragma unroll
        for (unsigned j = 0; j < 16; ++j) { const unsigned c = xb_ld(&bar[XB_XCNT(j)]); sum += c; cnt += (c > 0u) ? 1u : 0u; mine = (j == x) ? c : mine; }
        if (sum == G) break;
        __builtin_amdgcn_s_sleep(1);
        if ((++sp & 255u) == 0u) { if (xb_ld(&bar[XB_TMO])) break; if (sp > XB_SPIN_CAP) { atomicAdd(&bar[XB_TMO], 1u); break; } }
    }
    nloc = mine > 0u ? mine : 1u; nx = cnt > 0u ? cnt : 1u;
}

__device__ __forceinline__ void xcd_barrier(const XcdBarrier& b) {
    asm volatile("s_waitcnt vmcnt(0)" ::: "memory");
    __syncthreads();
    if (threadIdx.x == 0) {
        unsigned* bar = b.bar;
        __builtin_amdgcn_s_waitcnt(0);
        unsigned nloc = b.st[0], nx = b.st[1];
        if (nloc == 0u) { xcd_barrier_complete(bar, b.x, nloc, nx); b.st[0] = nloc; b.st[1] = nx; }
        const unsigned old = xb_add(&bar[XB_XSUB(b.x)], 1u);
        const unsigned gen = old / nloc;
        if (old + 1u == (gen + 1u) * nloc) {
            __builtin_amdgcn_fence(__ATOMIC_RELEASE, "agent");
            asm volatile("s_waitcnt vmcnt(0)" ::: "memory");
            const unsigned og = xb_add(&bar[XB_TOP], 1u);
            const unsigned tg = og / nx;
            if (og + 1u == (tg + 1u) * nx) xb_add(&bar[XB_TOPGEN], 1u);
            else XB_SPIN(xb_ld(&bar[XB_TOPGEN]) == tg, bar);
            __builtin_amdgcn_fence(__ATOMIC_ACQUIRE, "agent");
            xb_add(&bar[XB_XGEN(b.x)], 1u);
            asm volatile("s_waitcnt vmcnt(0)" ::: "memory");
        } else {
            XB_SPIN(xb_ld(&bar[XB_XGEN(b.x)]) == gen, bar);
            __builtin_amdgcn_fence(__ATOMIC_ACQUIRE, "agent");
            asm volatile("s_waitcnt vmcnt(0)" ::: "memory");
        }
    }
    __syncthreads();
}


constexpr int NPH = 11;
constexpr size_t WS_BAR = WS_END + 4096 - (WS_END % 4096);
constexpr int BAR_BYTES = 65536;
constexpr int LDS_ST_OFF = LDS_BYTES - 16;
static_assert(WS_BAR + BAR_BYTES < 512 * MB && XCD_BAR_WORDS <= 4096 && (4096 + 80 * 64) * 4 <= BAR_BYTES, "barrier words");
__global__ void __launch_bounds__(NTHR, 2) mega(Params P) {
    extern __shared__ __attribute__((aligned(16))) unsigned char smem[];
    LAS unsigned char* lds = (LAS unsigned char*)smem;
    cg::grid_group grid = cg::this_grid();
    const Ctx& C = P;
    const int lo = P.ph_lo, hi = P.ph_hi; const int G = gridDim.x, bx = blockIdx.x;
    if (threadIdx.x < 4) ((LAS unsigned*)(lds + LDS_ST_OFF))[threadIdx.x] = 0u;
    __syncthreads();
    XcdBarrier bar = xcd_barrier_post((unsigned*)(P.ws + WS_BAR), (volatile LAS unsigned*)(lds + LDS_ST_OFF));
    if (lo < 0) grid.sync();
#define IN(k) (lo <= (k) && (k) < hi)
#ifndef REP_PHASE
#define REP_PHASE -1
#endif
#define REPEAT(k) for (int rep_ = 0; rep_ < ((REP_PHASE == (k)) ? 2 : 1); ++rep_, (REP_PHASE == (k) && rep_ == 1) ? xcd_barrier(bar) : (void)0)
#define SEAM(k) do { if (IN(k) && IN((k) + 1)) xcd_barrier(bar); } while (0)
    if (IN(0)) REPEAT(0) phase_prep(C, lds);
    SEAM(0);
#define P1_MEM() do { pg8::Gemm g{C.wsb(WS_MEMN), C.wsb(WS_WCKV), NMR, 2048, DM}; pg8::StaticOrder S; S.init(NMR, 2048, G, bx); \
          EpiMem E{C.out + OUT_MK, C.out + OUT_MV, C.wsb(WS_KB), C.wsb(WS_VT)}; pg8::gemm_phase<EpiMem, pg8::StaticOrder>(lds, g, S, E, nullptr); } while (0)
#define P1_BIG() do { pg8::Gemm g{C.wsb(WS_HN), C.wsb(WS_WIN), MP, NIN, DM}; pg8::StaticOrder S; S.init(MP, NIN, G, bx); \
        Epi1 E{C.Z(0), C.in[6], C.wsf(WS_LN)}; pg8::gemm_phase<Epi1, pg8::StaticOrder>(lds, g, S, E, nullptr); } while (0)
    if (IN(1)) {
        const int grp = (bx >> 3) & 3; SEpi1 SE{C.Z(0), C.in[6], C.wsf(WS_LN)};
        const int t0 = (G > 128) ? bx - 64 : bx, tstep = (G > 128) ? G - 64 : G; const bool tiles = (G <= 128) || bx >= 64;
        int t = t0, k = 0;
        if (tiles) for (; t < 768 && k < grp; t += tstep, ++k) sgemm_tile(C.wsb(WS_HN), C.wsb(WS_WIN), DM, NIN, t, lds, SE);
        if (grp & 1) { P1_MEM(); P1_BIG(); } else { P1_BIG(); P1_MEM(); }
        if (tiles) for (; t < 768; t += tstep) sgemm_tile(C.wsb(WS_HN), C.wsb(WS_WIN), DM, NIN, t, lds, SE);
    }
    SEAM(1);
    if (IN(2)) {
        unsigned rq[16], rk[16], rl[16], rv[16];
        if (bx < 1024) hg_load(C, bx, rq, rk, rl, rv);
        for (int it = bx; it < 1024; it += G) hg_intra(C, lds, it, it + G, rq, rk, rl, rv);
    }
    SEAM(2);
    if (IN(3)) REPEAT(3) {
        hg_scan(C);
        if ((bx >> 3) & 1) { for (int it = bx; it < 512; it += G) hg_sample_item(C, lds, it); for (int it = bx; it < 512; it += G) gmlp_item(C, lds, it); }
        else { for (int it = bx; it < 512; it += G) gmlp_item(C, lds, it); for (int it = bx; it < 512; it += G) hg_sample_item(C, lds, it); }
        for (int it = bx; it < 128; it += G) gmlp_sample_item(C, lds, it);
    }
    SEAM(3);
    if (IN(4)) REPEAT(4) hg_out(C, lds);
    SEAM(4);
    if (IN(5)) {
#define PBIG() do { pg8::Gemm g{C.wsb(WS_O), C.wsb(WS_WOUT), MP, DM, DM}; pg8::StaticOrder S; S.init(MP, DM, G, bx); EpiRes<false> E{C.in[0], C.wsb(WS_XB), C.wsf(WS_SS)}; pg8::gemm_phase<EpiRes<false>, pg8::StaticOrder>(lds, g, S, E, nullptr); } while (0)
#define PTILE() do { SEpiRes<false> SE{C.in[1] - (size_t)MP * 1024, C.wsb(WS_XB), C.wsf(WS_SS)}; for (int t = bx; t < 256; t += G) sgemm_tile(C.wsb(WS_O), C.wsb(WS_WOUT), DM, DM, t, lds, SE); } while (0)
        if ((bx >> 3) & 1) { PTILE(); PBIG(); } else { PBIG(); PTILE(); }
#undef PBIG
#undef PTILE
    }
    SEAM(5);
    if (IN(6)) {
#define PBIG() do { pg8::Gemm g{C.wsb(WS_XB), C.wsb(WS_WCQ), MP, DM, DM}; pg8::StaticOrder S; S.init(MP, DM, G, bx); EpiScale<0> E{C.wsb(WS_HQ), DM, C.wsf(WS_SS), 0.0625f}; pg8::gemm_phase<EpiScale<0>, pg8::StaticOrder>(lds, g, S, E, nullptr); } while (0)
#define PTILE() do { SEpiScale<0> SE{C.wsb(WS_HQ), DM, C.wsf(WS_SS), 0.0625f}; for (int t = bx; t < 256; t += G) sgemm_tile(C.wsb(WS_XB), C.wsb(WS_WCQ), DM, DM, t, lds, SE); } while (0)
        if ((bx >> 3) & 1) { PTILE(); PBIG(); } else { PBIG(); PTILE(); }
#undef PBIG
#undef PTILE
    }
    SEAM(6);
    if (IN(7)) REPEAT(7) {
        if ((bx >> 3) & 1) { for (int it = bx; it < 256; it += G) attn_sample_item(C, lds, it); for (int it = bx; it < 256; it += G) attn_prompt_item(C, lds, it); }
        else { for (int it = bx; it < 256; it += G) attn_prompt_item(C, lds, it); for (int it = bx; it < 256; it += G) attn_sample_item(C, lds, it); }
    }
    SEAM(7);
    if (IN(8)) {
#define PBIG() do { pg8::Gemm g{C.wsb(WS_CA), C.wsb(WS_WCO), MP, DM, DM}; pg8::StaticOrder S; S.init(MP, DM, G, bx); EpiRes<true> E{nullptr, C.wsb(WS_XB), C.wsf(WS_SS) + MT}; pg8::gemm_phase<EpiRes<true>, pg8::StaticOrder>(lds, g, S, E, nullptr); } while (0)
#define PTILE() do { SEpiRes<true> SE{nullptr, C.wsb(WS_XB), C.wsf(WS_SS) + MT}; for (int t = bx; t < 256; t += G) sgemm_tile(C.wsb(WS_CA), C.wsb(WS_WCO), DM, DM, t, lds, SE); } while (0)
        if ((bx >> 3) & 1) { PTILE(); PBIG(); } else { PBIG(); PTILE(); }
#undef PBIG
#undef PTILE
    }
    SEAM(8);
    if (IN(9)) {
        const int grp = (bx >> 3) & 3; SEpiScale<1> SE{C.wsb(WS_H), DFF, C.wsf(WS_SS) + MT, 1.0f};
        int t = bx, k = 0;
        for (; t < 1024 && k < grp; t += G, ++k) sgemm_tile(C.wsb(WS_XB), C.wsb(WS_WUP), DM, DFF, t, lds, SE);
        { pg8::Gemm g{C.wsb(WS_XB), C.wsb(WS_WUP), MP, DFF, DM}; pg8::StaticOrder S; S.init(MP, DFF, G, bx);
          EpiScale<1> E{C.wsb(WS_H), DFF, C.wsf(WS_SS) + MT, 1.0f}; pg8::gemm_phase<EpiScale<1>, pg8::StaticOrder>(lds, g, S, E, nullptr); }
        for (; t < 1024; t += G) sgemm_tile(C.wsb(WS_XB), C.wsb(WS_WUP), DM, DFF, t, lds, SE);
    }
    SEAM(9);
    if (IN(10)) { pg8::Gemm g{C.wsb(WS_H), C.wsb(WS_WDN), MP, DM, DFF}; pg8::StaticOrder S; S.init(MP, DM, G, bx);
        unsigned* pc = (unsigned*)(P.ws + WS_BAR) + 4096;
        EpiFinal E{C.wsb(WS_XB), C.out + OUT_YP, C.wsf(WS_SS) + 2 * MT, pc, C.in[24]}; pg8::gemm_phase<EpiFinal, pg8::StaticOrder>(lds, g, S, E, nullptr);
        SEpiFinal SE{C.wsb(WS_XB), C.out + OUT_YP, C.wsf(WS_SS) + 2 * MT, pc + 64 * 64, C.in[24]};
        for (int t = bx; t < 256; t += G) sgemm_tile(C.wsb(WS_H), C.wsb(WS_WDN), DFF, DM, t, lds, SE); }
#undef IN
#undef SEAM
}

#ifndef MULTI_LAUNCH
#define MULTI_LAUNCH 0
#endif
extern "C" void kernel_launch(void* const* d_in, const int* in_sizes, int n_in, void* d_out, int out_size, void* d_ws, size_t ws_size, hipStream_t stream) {
    static int grid = 0;
    if (grid == 0) {
        int dev = 0, cus = 0, per_cu = 0;
        (void)hipGetDevice(&dev);
        (void)hipDeviceGetAttribute(&cus, hipDeviceAttributeMultiprocessorCount, dev);
        if (hipFuncSetAttribute((const void*)mega, hipFuncAttributeMaxDynamicSharedMemorySize, LDS_BYTES) != hipSuccess) fprintf(stderr, "hipFuncSetAttribute failed\n");
        if (hipOccupancyMaxActiveBlocksPerMultiprocessor(&per_cu, (const void*)mega, NTHR, LDS_BYTES) != hipSuccess || per_cu < 1) { fprintf(stderr, "occupancy query: %d\n", per_cu); per_cu = 1; }
        (void)hipGetLastError();
        grid = cus * per_cu;
        if (grid <= 0) grid = 256;
    }
    Params p{};
    for (int i = 0; i < 25; ++i) p.in[i] = (const float*)d_in[i];
    p.out = (float*)d_out; p.ws = (unsigned char*)d_ws;
    (void)hipMemsetAsync((unsigned char*)d_ws + WS_BAR, 0, BAR_BYTES, stream);
#if MULTI_LAUNCH
    for (int ph = 0; ph < NPH; ++ph) { p.ph_lo = ph; p.ph_hi = ph + 1; hipLaunchKernelGGL(mega, dim3(grid), dim3(NTHR), LDS_BYTES, stream, p); }
#else
    p.ph_lo = 0; p.ph_hi = NPH;
    void* args[] = {&p};
    hipError_t e = hipLaunchCooperativeKernel((const void*)mega, dim3(grid), dim3(NTHR), args, LDS_BYTES, stream);
    if (e != hipSuccess) fprintf(stderr, "cooperative launch failed: %s (grid %d)\n", hipGetErrorString(e), grid);
#endif
}
```
